# Optimizing an MI355X kernel written in HIP

```python
import math
import jax
import jax.numpy as jnp
from jax import lax
import numpy as np


D_MODEL = 1024
BATCH = 1
SEQ = 16384
DEPTH = 4

GRID_W = 64
CTX_LEN = 256
EPS = 1e-6
ROPE_THETA = 10000.0
Q_BLOCK = 128

MLA_HEADS = 8
MLA_NOPE = 64
MLA_ROPE = 32
MLA_V = 64
MLA_Q_RANK = 384
MLA_KV_RANK = 256
MLA_QK = MLA_NOPE + MLA_ROPE
MLA_WIDTH = MLA_HEADS * MLA_V

NA_HEADS = 8
NA_DIM = 64
NA_KH = 8
NA_KW = 16
NA_WIDTH = NA_HEADS * NA_DIM

S5_GROUPS = 32
S5_GCH = 16
S5_STATE = 64
S5_WIDTH = S5_GROUPS * S5_GCH

N_BRANCH = 3
D_FF = 2816
N_EXPERTS = 8
TOP_K = 2

IN_SPLITS = (MLA_Q_RANK, MLA_KV_RANK, MLA_ROPE, NA_WIDTH, NA_WIDTH, NA_WIDTH, S5_WIDTH, N_BRANCH * D_MODEL)
D_IN = sum(IN_SPLITS)

kernel_name = 'hybrid_mla_natten_s5_moe_dit'

F32 = jnp.float32


def rms_norm(x, g):
    xf = x.astype(F32)
    y = xf * lax.rsqrt(jnp.mean(xf * xf, axis=-1, keepdims=True) + EPS)
    return (y * g.astype(F32)).astype(x.dtype)


def modulate(h, shift, scale):
    return h * (1.0 + scale) + shift


def axial_rope_tables(n_tokens, dim):
    t = jnp.arange(n_tokens, dtype=jnp.int32)
    row = (t // GRID_W).astype(F32)
    col = (t % GRID_W).astype(F32)
    n_freq = dim // 4
    inv = ROPE_THETA ** (-jnp.arange(n_freq, dtype=F32) / n_freq)
    ang = jnp.concatenate([row[:, None] * inv[None], col[:, None] * inv[None]], axis=-1)
    return jnp.cos(ang), jnp.sin(ang)


def apply_rope(x, cos, sin):
    half = x.shape[-1] // 2
    xf = x.astype(F32)
    x1, x2 = xf[..., :half], xf[..., half:]
    cs, sn = cos[None, :, None, :], sin[None, :, None, :]
    return jnp.concatenate([x1 * cs - x2 * sn, x1 * sn + x2 * cs], axis=-1).astype(x.dtype)


def rope_tail(x, cos, sin):
    return jnp.concatenate([x[..., :MLA_NOPE], apply_rope(x[..., MLA_NOPE:], cos, sin)], axis=-1)


def softmax_attend(q, k, v, scale):
    s = jnp.einsum('bqhd,bkhd->bhqk', q, k).astype(F32) * scale
    w = jax.nn.softmax(s, axis=-1).astype(v.dtype)
    return jnp.einsum('bhqk,bkhd->bqhd', w, v)


def blocked_attend(q, k, v, scale):
    b, n, h, d = q.shape
    nb = n // Q_BLOCK
    qb = jnp.moveaxis(q.reshape(b, nb, Q_BLOCK, h, d), 1, 0)
    out = lax.map(lambda qi: softmax_attend(qi, k, v, scale), qb)
    return jnp.moveaxis(out, 0, 1).reshape(b, n, h, v.shape[-1])


def mla_project(p_q, p_kv, p_kr, g_q, g_kv, w_uq, w_ukv, g_qn, g_kn):
    b, l = p_q.shape[:2]
    q = (rms_norm(p_q, g_q) @ w_uq).reshape(b, l, MLA_HEADS, MLA_QK)
    kv = (rms_norm(p_kv, g_kv) @ w_ukv).reshape(b, l, MLA_HEADS, MLA_NOPE + MLA_V)
    k_nope, v = kv[..., :MLA_NOPE], kv[..., MLA_NOPE:]
    k_rope = jnp.broadcast_to(p_kr[:, :, None, :], (b, l, MLA_HEADS, MLA_ROPE))
    k = jnp.concatenate([k_nope, k_rope], axis=-1)
    return rms_norm(q, g_qn), rms_norm(k, g_kn), v


def neighbourhood_attend(q, k, v, k_ctx, v_ctx, rpb, scale):
    b, n, h, d = q.shape
    n_ctx = k_ctx.shape[1]
    rows = n // GRID_W
    kh = min(NA_KH, rows)
    grid = lambda t: t.reshape(b, rows, GRID_W, h, t.shape[-1])
    kg, vg = grid(k), grid(v)
    qrows = jnp.moveaxis(grid(q), 1, 0)
    cols = np.arange(GRID_W)
    c0 = np.clip(cols - NA_KW // 2, 0, GRID_W - NA_KW)
    cidx = c0[:, None] + np.arange(NA_KW)[None, :]
    dc = cidx - cols[:, None] + (NA_KW - 1)
    bias_c = rpb.astype(F32)[:, :, dc]

    def one_row(args):
        r, qr = args
        r0 = jnp.clip(r - kh // 2, 0, rows - kh)
        kb = lax.dynamic_slice_in_dim(kg, r0, kh, axis=1)
        vb = lax.dynamic_slice_in_dim(vg, r0, kh, axis=1)
        kn = jnp.take(kb, cidx, axis=2)
        vn = jnp.take(vb, cidx, axis=2)
        dr = r0 + jnp.arange(kh) - r + (NA_KH - 1)
        bias = jnp.take(bias_c, dr, axis=1).transpose(0, 2, 1, 3)
        s_win = jnp.einsum('bqhd,brqjhd->bhqrj', qr, kn).astype(F32) * scale + bias[None]
        s_ctx = jnp.einsum('bqhd,bkhd->bhqk', qr, k_ctx).astype(F32) * scale
        s = jnp.concatenate([s_ctx, s_win.reshape(b, h, GRID_W, kh * NA_KW)], axis=-1)
        w = jax.nn.softmax(s, axis=-1).astype(v.dtype)
        w_ctx = w[..., :n_ctx]
        w_win = w[..., n_ctx:].reshape(b, h, GRID_W, kh, NA_KW)
        return (jnp.einsum('bhqk,bkhd->bqhd', w_ctx, v_ctx)
                + jnp.einsum('bhqrj,brqjhd->bqhd', w_win, vn))

    out = lax.map(one_row, (jnp.arange(rows), qrows))
    return jnp.moveaxis(out, 0, 1).reshape(b, n, h, d)


def s5_discretise(a_re, a_im, log_dt, b_re, b_im):
    a = lax.complex(a_re.astype(F32), a_im.astype(F32))
    a_dt = a * jnp.exp(log_dt.astype(F32))[:, None]
    a_bar = jnp.exp(a_dt)
    b_bar = ((a_bar - 1.0) / a)[..., None] * lax.complex(b_re.astype(F32), b_im.astype(F32))
    return a_dt, a_bar, b_bar


def s5_states(u, a_dt, a_bar, b_bar, s0, reverse):
    bu = jnp.einsum('gpc,blgc->blgp', b_bar, u.astype(jnp.complex64))
    a_seq = jnp.broadcast_to(a_bar, bu.shape)

    def combine(e1, e2):
        a1, b1 = e1
        a2, b2 = e2
        return a1 * a2, a2 * b1 + b2

    _, s = lax.associative_scan(combine, (a_seq, bu), reverse=reverse, axis=1)
    if s0 is not None:
        length = u.shape[1]
        steps = (jnp.arange(length, 0, -1) if reverse else jnp.arange(1, length + 1)).astype(F32)
        decay = jnp.exp(a_dt[None] * steps[:, None, None])
        s = s + decay[None] * s0[:, None]
    return s


def s5_readout(s, c_re, c_im):
    cm = lax.complex(c_re.astype(F32), c_im.astype(F32))
    return jnp.real(jnp.einsum('gcp,blgp->blgc', cm, s))


def s5_mixer(u_ctx, u_lat, a_re, a_im, log_dt, b_re, b_im, c_re, c_im, d_skip, w_glu, b_glu, need_ctx):
    b = u_lat.shape[0]
    groups = lambda u: u.astype(F32).reshape(b, u.shape[1], S5_GROUPS, S5_GCH)
    uc, ul = groups(u_ctx), groups(u_lat)
    d_g = d_skip.astype(F32).reshape(S5_GROUPS, S5_GCH)
    y_l = d_g * ul
    y_c = d_g * uc if need_ctx else None
    for dirn in range(2):
        rev = dirn == 1
        a_dt, a_bar, b_bar = s5_discretise(a_re[dirn], a_im[dirn], log_dt[dirn], b_re[dirn], b_im[dirn])
        s_c = s5_states(uc, a_dt, a_bar, b_bar, None, rev)
        s_c_final = s_c[:, 0] if rev else s_c[:, -1]
        s_l = s5_states(ul, a_dt, a_bar, b_bar, s_c_final, rev)
        y_l = y_l + s5_readout(s_l, c_re[dirn], c_im[dirn])
        if need_ctx:
            y_c = y_c + s5_readout(s_c, c_re[dirn], c_im[dirn])

    def glu(y):
        y = jax.nn.gelu(y.reshape(b, y.shape[1], S5_WIDTH))
        return (y * jax.nn.sigmoid(y @ w_glu.astype(F32) + b_glu.astype(F32))).astype(u_lat.dtype)

    return glu(y_l), (glu(y_c) if need_ctx else None)


def branch_merge(o_a, o_b, o_c, gate_logits, w_a, w_b, w_c, w_o):
    g_a, g_b, g_c = jnp.split(jax.nn.sigmoid(gate_logits), N_BRANCH, axis=-1)
    return (g_a * (o_a @ w_a) + g_b * (o_b @ w_b) + g_c * (o_c @ w_c)) @ w_o


def swiglu(h, w_g, w_u, w_d):
    return (jax.nn.silu(h @ w_g) * (h @ w_u)) @ w_d


def moe_swiglu(h, w_router, w_g, w_u, w_d):
    logits = (h @ w_router).astype(F32)
    top_v, top_i = lax.top_k(logits, TOP_K)
    top_w = jax.nn.softmax(top_v, axis=-1)
    comb = jnp.sum(jax.nn.one_hot(top_i, N_EXPERTS, dtype=F32) * top_w[..., None], axis=-2)
    out = jnp.zeros_like(h)
    for e in range(N_EXPERTS):
        out = out + comb[..., e:e + 1].astype(h.dtype) * swiglu(h, w_g[e], w_u[e], w_d[e])
    return out


def setup_inputs(seed: int = 0) -> dict:
    key = jax.random.key(seed)
    ks = iter(jax.random.split(key, 64))
    L = DEPTH
    n_dense = (DEPTH + 1) // 2
    n_moe = DEPTH // 2
    G, P, Cg, D = S5_GROUPS, S5_STATE, S5_GCH, D_MODEL

    def nrm(shape, fan_in):
        return jax.random.normal(next(ks), shape, F32) * (fan_in ** -0.5)

    def small(shape, s):
        return s * jax.random.normal(next(ks), shape, F32)

    def gain(shape):
        return 1.0 + 0.02 * jax.random.normal(next(ks), shape, F32)

    n_idx = jnp.arange(P, dtype=F32)
    return {
        'x': jax.random.normal(next(ks), (BATCH, SEQ, D), F32),
        'c': jax.random.normal(next(ks), (BATCH, D), F32),
        'ctx': jax.random.normal(next(ks), (BATCH, CTX_LEN, D), F32),
        'c_ctx': jax.random.normal(next(ks), (D,), F32),
        'w_mod': nrm((L, D, 6 * D), D),
        'b_mod': small((L, 6 * D), 0.02),
        'g_norm1': gain((L, D)),
        'g_norm2': gain((L, D)),
        'w_in': nrm((L, D, D_IN), D),
        'g_mla_q': gain((L, MLA_Q_RANK)),
        'g_mla_kv': gain((L, MLA_KV_RANK)),
        'w_mla_uq': nrm((L, MLA_Q_RANK, MLA_HEADS * MLA_QK), MLA_Q_RANK),
        'w_mla_ukv': nrm((L, MLA_KV_RANK, MLA_HEADS * (MLA_NOPE + MLA_V)), MLA_KV_RANK),
        'g_mla_qn': gain((L, MLA_QK)),
        'g_mla_kn': gain((L, MLA_QK)),
        'g_na_qn': gain((L, NA_DIM)),
        'g_na_kn': gain((L, NA_DIM)),
        'na_rpb': small((L, NA_HEADS, 2 * NA_KH - 1, 2 * NA_KW - 1), 0.1),
        's5_a_re': -0.5 + small((L, 2, G, P), 0.01),
        's5_a_im': math.pi * n_idx + small((L, 2, G, P), 0.01),
        's5_log_dt': jax.random.uniform(next(ks), (L, 2, G), F32, math.log(1e-3), math.log(1e-1)),
        's5_b_re': small((L, 2, G, P, Cg), (2.0 * Cg) ** -0.5),
        's5_b_im': small((L, 2, G, P, Cg), (2.0 * Cg) ** -0.5),
        's5_c_re': small((L, 2, G, Cg, P), (2.0 * P) ** -0.5),
        's5_c_im': small((L, 2, G, Cg, P), (2.0 * P) ** -0.5),
        's5_d': jax.random.normal(next(ks), (L, S5_WIDTH), F32),
        'w_glu': nrm((L, S5_WIDTH, S5_WIDTH), S5_WIDTH),
        'b_glu': small((L, S5_WIDTH), 0.02),
        'w_br_mla': nrm((L, MLA_WIDTH, D), MLA_WIDTH),
        'w_br_na': nrm((L, NA_WIDTH, D), NA_WIDTH),
        'w_br_s5': nrm((L, S5_WIDTH, D), S5_WIDTH),
        'w_out': nrm((L, D, D), D),
        'w_ffn_gate': nrm((n_dense, D, D_FF), D),
        'w_ffn_up': nrm((n_dense, D, D_FF), D),
        'w_ffn_down': nrm((n_dense, D_FF, D), D_FF),
        'w_router': nrm((n_moe, D, N_EXPERTS), D),
        'w_exp_gate': nrm((n_moe, N_EXPERTS, D, D_FF), D),
        'w_exp_up': nrm((n_moe, N_EXPERTS, D, D_FF), D),
        'w_exp_down': nrm((n_moe, N_EXPERTS, D_FF, D), D_FF),
    }


def reference(x, c, ctx, c_ctx, w_mod, b_mod, g_norm1, g_norm2, w_in, g_mla_q, g_mla_kv, w_mla_uq, w_mla_ukv,
              g_mla_qn, g_mla_kn, g_na_qn, g_na_kn, na_rpb, s5_a_re, s5_a_im, s5_log_dt, s5_b_re, s5_b_im,
              s5_c_re, s5_c_im, s5_d, w_glu, b_glu, w_br_mla, w_br_na, w_br_s5, w_out, w_ffn_gate, w_ffn_up,
              w_ffn_down, w_router, w_exp_gate, w_exp_up, w_exp_down):
    b, n, _ = x.shape
    n_ctx = ctx.shape[1]
    cos, sin = axial_rope_tables(n, MLA_ROPE)
    split_idx = np.cumsum(IN_SPLITS)[:-1].tolist()
    mla_scale = MLA_QK ** -0.5
    na_scale = NA_DIM ** -0.5
    xl, xc = x, ctx
    for i in range(DEPTH):
        need_ctx = i < DEPTH - 1
        mod_l = (jax.nn.silu(c) @ w_mod[i] + b_mod[i])[:, None, :]
        mod_c = jax.nn.silu(c_ctx) @ w_mod[i] + b_mod[i]
        sh1_l, sc1_l, ga1_l, sh2_l, sc2_l, ga2_l = jnp.split(mod_l, 6, axis=-1)
        sh1_c, sc1_c, ga1_c, sh2_c, sc2_c, ga2_c = jnp.split(mod_c, 6, axis=-1)

        h = jnp.concatenate([modulate(rms_norm(xc, g_norm1[i]), sh1_c, sc1_c),
                             modulate(rms_norm(xl, g_norm1[i]), sh1_l, sc1_l)], axis=1)
        p_q, p_kv, p_kr, p_nq, p_nk, p_nv, p_u, p_gate = jnp.split(h @ w_in[i], split_idx, axis=-1)

        q, k, v = mla_project(p_q, p_kv, p_kr, g_mla_q[i], g_mla_kv[i], w_mla_uq[i], w_mla_ukv[i],
                              g_mla_qn[i], g_mla_kn[i])
        q_lat = rope_tail(q[:, n_ctx:], cos, sin)
        k_all = jnp.concatenate([k[:, :n_ctx], rope_tail(k[:, n_ctx:], cos, sin)], axis=1)
        o_a_l = blocked_attend(q_lat, k_all, v, mla_scale).reshape(b, n, MLA_WIDTH)

        heads = lambda t: t.reshape(b, n_ctx + n, NA_HEADS, NA_DIM)
        nq = rms_norm(heads(p_nq), g_na_qn[i])
        nk = rms_norm(heads(p_nk), g_na_kn[i])
        nv = heads(p_nv)
        o_b_l = neighbourhood_attend(nq[:, n_ctx:], nk[:, n_ctx:], nv[:, n_ctx:], nk[:, :n_ctx], nv[:, :n_ctx],
                                     na_rpb[i], na_scale).reshape(b, n, NA_WIDTH)

        o_c_l, o_c_c = s5_mixer(p_u[:, :n_ctx], p_u[:, n_ctx:], s5_a_re[i], s5_a_im[i], s5_log_dt[i],
                                s5_b_re[i], s5_b_im[i], s5_c_re[i], s5_c_im[i], s5_d[i], w_glu[i], b_glu[i],
                                need_ctx)

        mix_l = branch_merge(o_a_l, o_b_l, o_c_l, p_gate[:, n_ctx:], w_br_mla[i], w_br_na[i], w_br_s5[i], w_out[i])
        xl_new = xl + ga1_l * mix_l
        if need_ctx:
            o_a_c = softmax_attend(q[:, :n_ctx], k[:, :n_ctx], v[:, :n_ctx], mla_scale).reshape(b, n_ctx, MLA_WIDTH)
            o_b_c = softmax_attend(nq[:, :n_ctx], nk[:, :n_ctx], nv[:, :n_ctx], na_scale).reshape(b, n_ctx, NA_WIDTH)
            mix_c = branch_merge(o_a_c, o_b_c, o_c_c, p_gate[:, :n_ctx], w_br_mla[i], w_br_na[i], w_br_s5[i],
                                 w_out[i])
            xc = xc + ga1_c * mix_c
        xl = xl_new

        h2 = modulate(rms_norm(xl, g_norm2[i]), sh2_l, sc2_l)
        if need_ctx:
            h2 = jnp.concatenate([modulate(rms_norm(xc, g_norm2[i]), sh2_c, sc2_c), h2], axis=1)
        j = i // 2
        if i % 2 == 0:
            f = swiglu(h2, w_ffn_gate[j], w_ffn_up[j], w_ffn_down[j])
        else:
            f = moe_swiglu(h2, w_router[j], w_exp_gate[j], w_exp_up[j], w_exp_down[j])
        if need_ctx:
            xc = xc + ga2_c * f[:, :n_ctx]
        xl = xl + ga2_l * f[:, f.shape[1] - n:]
    return xl
```

```cpp
#include <hip/hip_runtime.h>
#include <cstdio>
#include <cstdint>

#define DBG_REPA 0
#ifndef DBG_THRASH
#define DBG_THRASH 0
#endif
#ifdef DBG_LDSZERO
#define DBG_LDSCLR { for (int u_ = threadIdx.x; u_ < RING_BYTES / 16; u_ += 512) ((LAS u32x4*)F.lds)[u_] = (u32x4){0u, 0u, 0u, 0u}; __syncthreads(); }
#else
#define DBG_LDSCLR
#endif
#ifndef DBG_XB
#define DBG_XB 0
#endif
#ifndef DBG_SP
#define DBG_SP 99
#endif
#ifndef DBG_DUMP
#define DBG_DUMP 0
#endif
#ifndef DBG_REPMASK
#define DBG_REPMASK 0
#endif
#define LPH(k) for (int rep_ = 0; rep_ < 1 + ((DBG_REPMASK >> (k)) & 1); ++rep_)
#ifndef DBG_YSRC
#define DBG_YSRC WS_Y
#endif
#ifndef DBG_NOMOE
#define DBG_NOMOE 0
#endif
#ifndef DBG_NLAYERS
#define DBG_NLAYERS 4
#endif
#ifndef ONE_LAUNCH
#define ONE_LAUNCH 1
#endif

#define GAS __attribute__((address_space(1)))
#define LAS __attribute__((address_space(3)))
typedef unsigned short bf16;
typedef short bf16x8 __attribute__((ext_vector_type(8)));
typedef short s16x4 __attribute__((ext_vector_type(4)));
typedef float f32x4 __attribute__((ext_vector_type(4)));
typedef float f32x16 __attribute__((ext_vector_type(16)));
typedef unsigned u32x4 __attribute__((ext_vector_type(4)));
typedef unsigned u32x2 __attribute__((ext_vector_type(2)));
typedef int i32x8 __attribute__((ext_vector_type(8)));

constexpr int D = 1024, NL = 16384, NC = 256, NT = NL + NC, DEPTH = 4;
constexpr int DINP = 5888;
constexpr int FF = 2816, FF2 = 5632, NEXP = 8;
constexpr float EPS = 1e-6f;
constexpr int S5T = 32, S5ROWS = 768, S5K = 768;
constexpr int MOE_ROWS = 35328;

constexpr size_t MiB = 1u << 20;
constexpr size_t WS_CTL = 0, CTL_BYTES = 1 * MiB;
constexpr size_t WS_MOD = 1 * MiB;
constexpr size_t WS_ROPE = 2 * MiB;
constexpr size_t WS_S5P = 4 * MiB;
constexpr size_t WS_KTAB = 11 * MiB;
constexpr size_t WS_REC = 19 * MiB;
constexpr size_t WS_WIN = 20 * MiB;
constexpr size_t WS_WUQ = 32 * MiB;
constexpr size_t WS_WUKV = 33 * MiB;
constexpr size_t WS_WGLU = 34 * MiB;
constexpr size_t WS_WBR = 35 * MiB;
constexpr size_t WS_WOUT = 38 * MiB;
constexpr size_t WS_WGU = 40 * MiB;
constexpr size_t WS_WD = 128 * MiB;
constexpr size_t WS_WY = 172 * MiB;
constexpr size_t WS_WEND = 196 * MiB;
constexpr size_t WS_AG = 204 * MiB;
constexpr size_t WS_E = 240 * MiB;
constexpr size_t WS_Z = 264 * MiB;
constexpr size_t WS_M1 = 240 * MiB;
constexpr size_t WS_XS = 281 * MiB;
constexpr size_t WS_OA = 346 * MiB;
constexpr size_t WS_OB = WS_OA + (size_t)NT * 512 * 2;
constexpr size_t WS_OC = WS_OB + (size_t)NT * 512 * 2;
constexpr size_t WS_H = 346 * MiB;
constexpr size_t WS_R1 = 395 * MiB;
constexpr size_t WS_G = WS_R1;
constexpr size_t WS_PN = WS_G + (size_t)NT * 3072 * 2;
constexpr size_t WS_PA = WS_PN + (size_t)NT * 1536 * 2;
constexpr size_t WS_QRAW = WS_PA + (size_t)NT * 768 * 2;
constexpr size_t WS_KVRAW = WS_QRAW + (size_t)NT * 768 * 2;
constexpr size_t WS_ACT = WS_R1;
constexpr size_t WS_R2 = 623 * MiB;
constexpr size_t WS_QF = WS_R2;
constexpr size_t WS_KF = WS_QF + (size_t)8 * NT * 96 * 2;
constexpr size_t WS_VF = WS_KF + (size_t)8 * NT * 96 * 2;
constexpr size_t WS_NQ = WS_VF + (size_t)8 * NT * 64 * 2;
constexpr size_t WS_NK = WS_NQ + (size_t)8 * NT * 64 * 2;
constexpr size_t WS_HS = WS_R2;
constexpr size_t WS_Y = WS_HS + (size_t)MOE_ROWS * 1024 * 2;
constexpr size_t WS_PART = 762 * MiB;
constexpr size_t WS_Y2 = 774 * MiB;
constexpr size_t WS_M1C = 843 * MiB;
constexpr size_t WS_END = 845 * MiB;
static_assert(WS_KVRAW + (size_t)NT * 1024 * 2 <= WS_R2 && WS_ACT + (size_t)MOE_ROWS * 2816 * 2 <= WS_R2, "region 1");
static_assert(WS_NK + (size_t)8 * NT * 64 * 2 <= WS_END && WS_Y + (size_t)MOE_ROWS * 1024 * 2 <= WS_END, "region 2");
static_assert(WS_OC + (size_t)NT * 512 * 2 <= WS_R1 && WS_Z + (size_t)NT * 512 * 2 <= WS_XS && WS_M1 + (size_t)NT * 1024 * 2 <= WS_XS, "map");
constexpr int CW_BAR = 4096;
constexpr int CW_CNT = 16384;

constexpr int RING_BYTES = 131072, MISC_OFF = RING_BYTES + 320, LDS_BYTES = 147456;

#define LDS_WAIT() asm volatile("s_waitcnt lgkmcnt(0)" ::: "memory")
#define VM_WAIT() asm volatile("s_waitcnt vmcnt(0)" ::: "memory")
#define SBAR() __builtin_amdgcn_sched_barrier(0)
__device__ __forceinline__ unsigned cvtpk(float lo, float hi) { unsigned r; asm volatile("v_cvt_pk_bf16_f32 %0, %1, %2" : "=v"(r) : "v"(lo), "v"(hi)); return r; }
__device__ __forceinline__ float bflo(unsigned w) { return __uint_as_float(w << 16); }
__device__ __forceinline__ float bfhi(unsigned w) { return __uint_as_float(w & 0xffff0000u); }
__device__ __forceinline__ bf16 f2bf(float f) { return (bf16)(cvtpk(f, 0.f) & 0xffffu); }
__device__ __forceinline__ float bf2f(bf16 b) { return __uint_as_float(((unsigned)b) << 16); }
__device__ __forceinline__ void unpack8(const u32x4 w, float (&f)[8]) { f[0] = bflo(w.x); f[1] = bfhi(w.x); f[2] = bflo(w.y); f[3] = bfhi(w.y); f[4] = bflo(w.z); f[5] = bfhi(w.z); f[6] = bflo(w.w); f[7] = bfhi(w.w); }
__device__ __forceinline__ u32x4 pack8(const f32x4 a, const f32x4 b) { u32x4 w; w.x = cvtpk(a[0], a[1]); w.y = cvtpk(a[2], a[3]); w.z = cvtpk(b[0], b[1]); w.w = cvtpk(b[2], b[3]); return w; }
__device__ __forceinline__ f32x4 ld4bf(const bf16* p) { const u32x2 w = *(const u32x2*)p; return (f32x4){bflo(w.x), bfhi(w.x), bflo(w.y), bfhi(w.y)}; }
__device__ __forceinline__ void st4bf(bf16* p, const f32x4 v) { u32x2 w; w.x = cvtpk(v[0], v[1]); w.y = cvtpk(v[2], v[3]); *(u32x2*)p = w; }
__device__ __forceinline__ float fsigmoid(float x) { return __builtin_amdgcn_rcpf(1.f + __builtin_amdgcn_exp2f(-1.4426950408889634f * x)); }
__device__ __forceinline__ float fsilu(float x) { return x * fsigmoid(x); }
__device__ __forceinline__ float fgelu_tanh(float x) { return x * fsigmoid(1.5957691216057308f * (x + 0.044715f * x * x * x)); }
__device__ __forceinline__ float wave_sum(float v) {
#pragma unroll
    for (int o = 1; o < 64; o <<= 1) v += __shfl_xor(v, o);
    return v;
}
__device__ __forceinline__ void sincos_rad(float a, float& s, float& c) {
    float rev = a * 0.15915494309189535f; rev = rev - floorf(rev);
    s = __builtin_amdgcn_sinf(rev); c = __builtin_amdgcn_cosf(rev);
}

#define XB_TMO      128
#define XB_XCNT(j)  (256  + 64 * (j))
#define XB_XSUB(j)  (1280 + 64 * (j))
#define XB_XGEN(j)  (2304 + 64 * (j))
#define XB_TOP      3328
#define XB_TOPGEN   3392
#define XCD_BAR_WORDS 3456
#define XB_SPIN_CAP (1u << 22)

__device__ __forceinline__ unsigned xb_ld(unsigned* p)              { return __hip_atomic_load(p, __ATOMIC_RELAXED, __HIP_MEMORY_SCOPE_AGENT); }
__device__ __forceinline__ unsigned xb_add(unsigned* p, unsigned v) { return __hip_atomic_fetch_add(p, v, __ATOMIC_RELAXED, __HIP_MEMORY_SCOPE_AGENT); }
__device__ __forceinline__ unsigned xb_xcc_id() { return (unsigned)__builtin_amdgcn_s_getreg((3 << 11) | 20) & 0xFu; }
#define XB_SPIN(cond, bar) do { unsigned _sp = 0; while (cond) { __builtin_amdgcn_s_sleep(1); \
    if ((++_sp & 255u) == 0u) { if (xb_ld(&(bar)[XB_TMO])) break; if (_sp > XB_SPIN_CAP) { atomicAdd(&(bar)[XB_TMO], 1u); break; } } } } while (0)

struct XcdBarrier { unsigned* bar; unsigned x; volatile LAS unsigned* st; };
__device__ __forceinline__ XcdBarrier xcd_barrier_post(unsigned* bar, volatile LAS unsigned* st) {
    XcdBarrier b; b.bar = bar; b.x = xb_xcc_id(); b.st = st;
    if (threadIdx.x == 0) (void)xb_add(&bar[XB_XCNT(b.x)], 1u);
    return b;
}
__device__ __forceinline__ void xcd_barrier_complete(unsigned* bar, unsigned x, unsigned& nloc, unsigned& nx) {
    const unsigned G = gridDim.x * gridDim.y * gridDim.z;
    unsigned sum, cnt, mine, sp = 0u;
    for (;;) {
        sum = 0u; cnt = 0u; mine = 0u;
#pragma unroll
        for (unsigned j = 0; j < 16; ++j) { const unsigned c = xb_ld(&bar[XB_XCNT(j)]); sum += c; cnt += (c > 0u) ? 1u : 0u; mine = (j == x) ? c : mine; }
        if (sum == G) break;
        __builtin_amdgcn_s_sleep(1);
        if ((++sp & 255u) == 0u) { if (xb_ld(&bar[XB_TMO])) break; if (sp > XB_SPIN_CAP) { atomicAdd(&bar[XB_TMO], 1u); break; } }
    }
    nloc = mine > 0u ? mine : 1u; nx = cnt > 0u ? cnt : 1u;
}
__device__ __forceinline__ void xcd_barrier(const XcdBarrier& b) {
    asm volatile("s_waitcnt vmcnt(0)" ::: "memory");
    __syncthreads();
    if (threadIdx.x == 0) {
        unsigned* bar = b.bar;
        __builtin_amdgcn_s_waitcnt(0);
        unsigned nloc = b.st[0], nx = b.st[1];
        if (nloc == 0u) { xcd_barrier_complete(bar, b.x, nloc, nx); b.st[0] = nloc; b.st[1] = nx; }
        const unsigned old = xb_add(&bar[XB_XSUB(b.x)], 1u);
        const unsigned gen = old / nloc;
        if (old + 1u == (gen + 1u) * nloc) {
            __builtin_amdgcn_fence(__ATOMIC_RELEASE, "agent");
            asm volatile("s_waitcnt vmcnt(0)" ::: "memory");
            const unsigned og = xb_add(&bar[XB_TOP], 1u);
            const unsigned tg = og / nx;
            if (og + 1u == (tg + 1u) * nx) xb_add(&bar[XB_TOPGEN], 1u);
            else XB_SPIN(xb_ld(&bar[XB_TOPGEN]) == tg, bar);
            __builtin_amdgcn_fence(__ATOMIC_ACQUIRE, "agent");
            xb_add(&bar[XB_XGEN(b.x)], 1u);
            asm volatile("s_waitcnt vmcnt(0)" ::: "memory");
        } else {
            XB_SPIN(xb_ld(&bar[XB_XGEN(b.x)]) == gen, bar);
            __builtin_amdgcn_fence(__ATOMIC_ACQUIRE, "agent");
            asm volatile("s_waitcnt vmcnt(0)" ::: "memory");
        }
    }
    __syncthreads();
}

namespace pg8 {
constexpr int BM = 256, BK = 64, HALF = 128, HTB = HALF * BK * 2, NXCD = 8, WGM = 8;
__host__ __device__ __forceinline__ int lds_byte(int r, int c) { const int st = (r >> 4) * 2 + (c >> 5), rr = r & 15, cc = c & 31, ob = rr * 64 + cc * 2; return st * 1024 + (ob ^ (((ob >> 9) & 1) << 5)); }
__host__ __device__ __forceinline__ void stage_rc(int b, int& R, int& C) { const int st = b / 1024, sb = b % 1024, swz = sb ^ (((sb >> 9) & 1) << 5); R = (st >> 1) * 16 + swz / 64; C = (st & 1) * 32 + (swz % 64) / 2; }
__host__ __device__ __forceinline__ int perm32(int rho) { const int n = rho >> 4, i = rho & 15; return 8 * (i >> 2) + 4 * n + (i & 3); }
struct Unit { int pm, pn, aux; };

struct TileOrder {
    int nM, nN, nwg, G, c;
    __device__ __forceinline__ void init(int nM_, int nN_, int G_, int c_) { nM = nM_; nN = nN_; nwg = nM * nN; G = G_; c = c_; }
    __device__ __forceinline__ bool tile(int i, int& pm, int& pn) const {
        const long L = (long)i * G + c; if (L >= nwg) return false;
        int wgid = (int)L; { const int q = nwg / NXCD, r = nwg % NXCD, xcd = wgid % NXCD, off = wgid / NXCD; wgid = (xcd < r ? xcd * (q + 1) : r * (q + 1) + (xcd - r) * q) + off; }
        const int nig = WGM * nN, gid = wgid / nig, fm = gid * WGM, gsz = (nM - fm) < WGM ? (nM - fm) : WGM;
        pm = fm + ((wgid % nig) % gsz); pn = (wgid % nig) / gsz; return true;
    }
};

template <class Epi, class Sched>
__device__ __forceinline__ void gemm_phase(LAS unsigned char* lds, const int K, const int lda, const int ldb, const Sched& S, const Epi& E) {
    int tid_ = threadIdx.x; asm volatile("" : "+v"(tid_));
    const int tid = tid_, wid = __builtin_amdgcn_readfirstlane(tid >> 6), lane = tid & 63, wr = wid >> 2, wc = wid & 3, fr = lane & 15, fq = lane >> 4;
    const int nt = K / BK;
    unsigned voffA[2], voffB[2];
#pragma unroll
    for (int i = 0; i < 2; ++i) { int R, C; stage_rc(tid * 16 + i * 8192, R, C); const int Rb = (R & ~31) + perm32(R & 31);
        voffA[i] = (unsigned)(R * lda + C) * 2u; voffB[i] = (unsigned)(Rb * ldb + C) * 2u; }
    const size_t kstep = (size_t)(BK * 2);
    const size_t hstepA = (size_t)HALF * lda * 2, hstepB = (size_t)HALF * ldb * 2;
    const unsigned ldsw = (unsigned)wid * 1024u;
    const int aoff = lds_byte(wr * 64 + fr, fq * 8), boff = lds_byte(wc * 32 + fr, fq * 8);
#define PG8_SA(b, h) (((b) * 2 + (h)) * HTB)
#define PG8_SB(b, h) ((4 + (b) * 2 + (h)) * HTB)
#define PG8_STAGE(bufoff, gbase, voff) do { _Pragma("unroll") for (int _i = 0; _i < 2; ++_i) \
        __builtin_amdgcn_global_load_lds((const unsigned*)((const char*)(gbase) + (voff)[_i]), (LAS unsigned*)(lds + (bufoff) + ldsw + _i * 8192), 16, 0, 0); } while (0)
#define PG8_LDA(dst, b, h) do { _Pragma("unroll") for (int m = 0; m < 4; ++m) _Pragma("unroll") for (int k = 0; k < 2; ++k) dst[m][k] = *(const LAS bf16x8*)(lds + PG8_SA(b, h) + aoff + m * 2048 + k * 1024); } while (0)
#define PG8_LDB(dst, b, h) do { _Pragma("unroll") for (int n = 0; n < 2; ++n) _Pragma("unroll") for (int k = 0; k < 2; ++k) dst[n][k] = *(const LAS bf16x8*)(lds + PG8_SB(b, h) + boff + n * 2048 + k * 1024); } while (0)
#define PG8_MMA(ai, bj, At, Bt) do { __builtin_amdgcn_s_setprio(1); _Pragma("unroll") for (int m = 0; m < 4; ++m) _Pragma("unroll") for (int n = 0; n < 2; ++n) _Pragma("unroll") for (int k = 0; k < 2; ++k) \
        acc[ai][bj][m][n] = __builtin_amdgcn_mfma_f32_16x16x32_bf16(Bt[n][k], At[m][k], acc[ai][bj][m][n], 0, 0, 0); __builtin_amdgcn_s_setprio(0); } while (0)
#define PG8_WAIT_V(n) asm volatile("s_waitcnt vmcnt(" #n ")" ::: "memory")
#define PG8_WAIT_L(n) asm volatile("s_waitcnt lgkmcnt(" #n ")" ::: "memory")
#define PG8_BAR __builtin_amdgcn_s_barrier()
#define PG8_SCHED __builtin_amdgcn_sched_barrier(0)
    Unit cur, nxt; int ui = 0;
    if (!S.next(0, cur)) return;
    f32x4 acc[2][2][4][2];
#pragma unroll
    for (int a = 0; a < 2; ++a)
#pragma unroll
        for (int b = 0; b < 2; ++b)
#pragma unroll
            for (int m = 0; m < 4; ++m)
#pragma unroll
                for (int n = 0; n < 2; ++n) acc[a][b][m][n] = (f32x4){0.f, 0.f, 0.f, 0.f};
    bf16x8 At[4][2], B0[2][2], B1[2][2];
    const char* cA = S.abase(cur); const char* cB = S.bbase(cur);
    PG8_STAGE(PG8_SB(0, 0), cB, voffB); PG8_STAGE(PG8_SB(0, 1), cB + hstepB, voffB); PG8_STAGE(PG8_SA(0, 0), cA, voffA); PG8_STAGE(PG8_SA(0, 1), cA + hstepA, voffA);
    if (wr == 1) PG8_BAR;
    PG8_WAIT_V(2); PG8_BAR;
    PG8_STAGE(PG8_SB(1, 0), cB + kstep, voffB); PG8_STAGE(PG8_SA(1, 0), cA + kstep, voffA); PG8_STAGE(PG8_SB(1, 1), cB + hstepB + kstep, voffB);
    PG8_WAIT_V(6); PG8_BAR;
    for (;;) {
        const bool has_next = S.next(ui + 1, nxt);
        const char* nA = has_next ? S.abase(nxt) : cA; const char* nB = has_next ? S.bbase(nxt) : cB;
#pragma clang loop unroll(disable)
        for (int t = 0; t < nt; t += 2) {
            const bool last = (t == nt - 2);
            const char* a1 = cA + (size_t)(t + 1) * kstep;
            const char* a2 = last ? nA : cA + (size_t)(t + 2) * kstep; const char* b2 = last ? nB : cB + (size_t)(t + 2) * kstep;
            const char* a3 = a2 + kstep; const char* b3 = b2 + kstep;
            PG8_LDB(B0, 0, 0); PG8_LDB(B1, 0, 1); PG8_SCHED; PG8_LDA(At, 0, 0); PG8_STAGE(PG8_SA(1, 1), a1 + hstepA, voffA);
            PG8_WAIT_V(8); PG8_WAIT_L(0); PG8_BAR; PG8_MMA(0, 0, At, B0); PG8_MMA(0, 1, At, B1); PG8_BAR; PG8_SCHED;
            PG8_LDA(At, 0, 1); PG8_STAGE(PG8_SB(0, 0), b2, voffB); PG8_STAGE(PG8_SB(0, 1), b2 + hstepB, voffB); PG8_STAGE(PG8_SA(0, 0), a2, voffA);
            PG8_WAIT_V(8); PG8_WAIT_L(0); PG8_BAR; PG8_MMA(1, 0, At, B0); PG8_MMA(1, 1, At, B1); PG8_BAR; PG8_SCHED;
            PG8_LDB(B0, 1, 0); PG8_LDB(B1, 1, 1); PG8_SCHED; PG8_LDA(At, 1, 0); PG8_STAGE(PG8_SA(0, 1), a2 + hstepA, voffA);
            PG8_WAIT_V(8); PG8_WAIT_L(0); PG8_BAR; PG8_MMA(0, 0, At, B0); PG8_MMA(0, 1, At, B1); PG8_BAR; PG8_SCHED;
            PG8_LDA(At, 1, 1); PG8_STAGE(PG8_SB(1, 0), b3, voffB); PG8_STAGE(PG8_SB(1, 1), b3 + hstepB, voffB); PG8_STAGE(PG8_SA(1, 0), a3, voffA);
            PG8_WAIT_V(8); PG8_WAIT_L(0); PG8_BAR; PG8_MMA(1, 0, At, B0); PG8_MMA(1, 1, At, B1); PG8_BAR; PG8_SCHED;
        }
        if (wr == 0) PG8_BAR;
        E(acc, cur, wr, wc, fr, fq);
        if (!has_next) break;
#pragma unroll
        for (int a = 0; a < 2; ++a)
#pragma unroll
            for (int b = 0; b < 2; ++b)
#pragma unroll
                for (int m = 0; m < 4; ++m)
#pragma unroll
                    for (int n = 0; n < 2; ++n) acc[a][b][m][n] = (f32x4){0.f, 0.f, 0.f, 0.f};
        cur = nxt; cA = nA; cB = nB; ++ui;
        if (wr == 1) PG8_BAR;
    }
    PG8_WAIT_V(0);
    PG8_BAR;
#undef PG8_SA
#undef PG8_SB
#undef PG8_STAGE
#undef PG8_LDA
#undef PG8_LDB
#undef PG8_MMA
#undef PG8_WAIT_V
#undef PG8_WAIT_L
#undef PG8_BAR
#undef PG8_SCHED
}

struct SchedPlain {
    TileOrder T; const bf16* A; const bf16* Bt; int lda, ldb, pm0;
    __device__ __forceinline__ bool next(int i, Unit& u) const { int pm, pn; if (!T.tile(i, pm, pn)) return false; u.pm = pm + pm0; u.pn = pn; u.aux = 0; return true; }
    __device__ __forceinline__ const char* abase(const Unit& u) const { return (const char*)(A + (size_t)u.pm * 256 * lda); }
    __device__ __forceinline__ const char* bbase(const Unit& u) const { return (const char*)(Bt + (size_t)u.pn * 256 * ldb); }
};
struct SchedMerge {
    TileOrder T; const bf16* O; const bf16* W; int pm0;
    __device__ __forceinline__ bool next(int i, Unit& u) const { int pm, pn; if (!T.tile(i / 3, pm, pn)) return false; u.pm = pm + pm0; u.pn = pn; u.aux = i % 3; return true; }
    __device__ __forceinline__ const char* abase(const Unit& u) const { return (const char*)(O + ((size_t)u.aux * NT + (size_t)u.pm * 256) * 512); }
    __device__ __forceinline__ const char* bbase(const Unit& u) const { return (const char*)(W + ((size_t)u.aux * 1024 + (size_t)u.pn * 256) * 512); }
};
struct SchedS5 {
    int nrt, nct, G, c; const bf16* A; const bf16* W; int brows, ldb;
    __device__ __forceinline__ bool next(int i, Unit& u) const { const int L = i * G + c; if (L >= 32 * nrt * nct) return false; u.aux = L / (nrt * nct); const int r = L % (nrt * nct); u.pm = r / nct; u.pn = r % nct; return true; }
    __device__ __forceinline__ const char* abase(const Unit& u) const { return (const char*)(A + ((size_t)u.aux * S5ROWS + (size_t)u.pm * 256) * S5K); }
    __device__ __forceinline__ const char* bbase(const Unit& u) const { return (const char*)(W + ((size_t)u.aux * brows + (size_t)u.pn * 256) * ldb); }
};
struct SchedMoe {
    TileOrder T; const bf16* A; const bf16* W; int lda, ldb; size_t wstride; const LAS int* tstart;
    __device__ __forceinline__ bool next(int i, Unit& u) const { int pm, pn; if (!T.tile(i, pm, pn)) return false; u.pm = pm; u.pn = pn; u.aux = __builtin_amdgcn_readfirstlane(tstart[pm]); return true; }
    __device__ __forceinline__ const char* abase(const Unit& u) const { return (const char*)(A + (size_t)u.pm * 256 * lda); }
    __device__ __forceinline__ const char* bbase(const Unit& u) const { return (const char*)(W + (size_t)u.aux * wstride + (size_t)u.pn * 256 * ldb); }
};

#define EPI_ROWS(u) const int row0 = (u).pm * 256 + wr * 64 + fr; const int cw0 = wc * 32 + 8 * fq;
struct EpiWin {
    bf16 *pA, *pN, *AG, *Gt;
    __device__ __forceinline__ void operator()(const f32x4 (&acc)[2][2][4][2], const Unit& u, int wr, int wc, int fr, int fq) const {
        EPI_ROWS(u) const int pn = u.pn;
#pragma unroll
        for (int ai = 0; ai < 2; ++ai)
#pragma unroll
            for (int m = 0; m < 4; ++m) { const int row = row0 + ai * 128 + m * 16;
#pragma unroll
                for (int bj = 0; bj < 2; ++bj) { const int cw = cw0 + bj * 128; const f32x4 v0 = acc[ai][bj][m][0], v1 = acc[ai][bj][m][1];
                    if (pn < 3) *(u32x4*)(pA + (size_t)row * 768 + pn * 256 + cw) = pack8(v0, v1);
                    else if (pn < 9) *(u32x4*)(pN + (size_t)row * 1536 + (pn - 3) * 256 + cw) = pack8(v0, v1);
                    else if (pn < 11) { const int ucol = (pn - 9) * 256 + cw, g = ucol >> 4, c = ucol & 15;
                        const int tk = row < NC ? row : row - NC; const int cr = (row < NC ? 512 : 0) + (tk >> 5), j = tk & 31;
                        *(u32x4*)(AG + ((size_t)g * S5ROWS + cr) * S5K + j * 16 + c) = pack8(v0, v1); }
                    else { f32x4 s0, s1;
#pragma unroll
                        for (int q = 0; q < 4; ++q) { s0[q] = fsigmoid(v0[q]); s1[q] = fsigmoid(v1[q]); }
                        *(u32x4*)(Gt + (size_t)row * 3072 + (pn - 11) * 256 + cw) = pack8(s0, s1); } } }
    }
};
struct EpiBf16 {
    bf16* O; int ldc;
    __device__ __forceinline__ void operator()(const f32x4 (&acc)[2][2][4][2], const Unit& u, int wr, int wc, int fr, int fq) const {
        EPI_ROWS(u)
#pragma unroll
        for (int ai = 0; ai < 2; ++ai)
#pragma unroll
            for (int m = 0; m < 4; ++m) { const int row = row0 + ai * 128 + m * 16;
#pragma unroll
                for (int bj = 0; bj < 2; ++bj) *(u32x4*)(O + (size_t)row * ldc + u.pn * 256 + cw0 + bj * 128) = pack8(acc[ai][bj][m][0], acc[ai][bj][m][1]); }
    }
};
struct EpiS5E {
    float* Eo;
    __device__ __forceinline__ void operator()(const f32x4 (&acc)[2][2][4][2], const Unit& u, int wr, int wc, int fr, int fq) const {
        EPI_ROWS(u)
#pragma unroll
        for (int ai = 0; ai < 2; ++ai)
#pragma unroll
            for (int m = 0; m < 4; ++m) { const int row = row0 + ai * 128 + m * 16;
#pragma unroll
                for (int bj = 0; bj < 2; ++bj) { float* p = Eo + ((size_t)u.aux * S5ROWS + row) * 256 + cw0 + bj * 128; *(f32x4*)p = acc[ai][bj][m][0]; *(f32x4*)(p + 4) = acc[ai][bj][m][1]; } }
    }
};
struct EpiS5Y {
    bf16* Z;
    __device__ __forceinline__ void operator()(const f32x4 (&acc)[2][2][4][2], const Unit& u, int wr, int wc, int fr, int fq) const {
        EPI_ROWS(u)
#pragma unroll
        for (int ai = 0; ai < 2; ++ai)
#pragma unroll
            for (int m = 0; m < 4; ++m) { const int cr = row0 + ai * 128 + m * 16;
                if (cr < 520) {
#pragma unroll
                for (int bj = 0; bj < 2; ++bj) { const int n = u.pn * 256 + cw0 + bj * 128, t = n >> 4, c = n & 15;
                    const int tok = cr < 512 ? NC + cr * 32 + t : (cr - 512) * 32 + t; f32x4 a, b;
#pragma unroll
                    for (int q = 0; q < 4; ++q) { a[q] = fgelu_tanh(acc[ai][bj][m][0][q]); b[q] = fgelu_tanh(acc[ai][bj][m][1][q]); }
                    *(u32x4*)(Z + (size_t)tok * 512 + u.aux * 16 + c) = pack8(a, b); } } }
    }
};
struct EpiGlu {
    const bf16* Z; bf16* O; const float* bias;
    __device__ __forceinline__ void operator()(const f32x4 (&acc)[2][2][4][2], const Unit& u, int wr, int wc, int fr, int fq) const {
        EPI_ROWS(u)
#pragma unroll
        for (int bj = 0; bj < 2; ++bj) { const int col = u.pn * 256 + cw0 + bj * 128; const f32x4 b0 = *(const f32x4*)(bias + col), b1 = *(const f32x4*)(bias + col + 4);
#pragma unroll
            for (int ai = 0; ai < 2; ++ai)
#pragma unroll
                for (int m = 0; m < 4; ++m) { const int row = row0 + ai * 128 + m * 16; float z[8]; unpack8(*(const u32x4*)(Z + (size_t)row * 512 + col), z); f32x4 a, b;
#pragma unroll
                    for (int q = 0; q < 4; ++q) { a[q] = z[q] * fsigmoid(acc[ai][bj][m][0][q] + b0[q]); b[q] = z[4 + q] * fsigmoid(acc[ai][bj][m][1][q] + b1[q]); }
                    *(u32x4*)(O + (size_t)row * 512 + col) = pack8(a, b); } }
    }
};
struct EpiMerge {
    const bf16* Gt; bf16* M1;
    __device__ __forceinline__ void operator()(const f32x4 (&acc)[2][2][4][2], const Unit& u, int wr, int wc, int fr, int fq) const {
        EPI_ROWS(u) const int br = u.aux;
#pragma unroll
        for (int ai = 0; ai < 2; ++ai)
#pragma unroll
            for (int m = 0; m < 4; ++m) { const int row = row0 + ai * 128 + m * 16;
#pragma unroll
                for (int bj = 0; bj < 2; ++bj) { const int col = u.pn * 256 + cw0 + bj * 128; float g[8]; unpack8(*(const u32x4*)(Gt + (size_t)row * 3072 + br * 1024 + col), g);
                    f32x4 a, b;
#pragma unroll
                    for (int q = 0; q < 4; ++q) { a[q] = g[q] * acc[ai][bj][m][0][q]; b[q] = g[4 + q] * acc[ai][bj][m][1][q]; }
                    bf16* mp = M1 + (size_t)row * 1024 + col;
                    if (br) { float o[8]; unpack8(*(const u32x4*)mp, o);
#pragma unroll
                        for (int q = 0; q < 4; ++q) { a[q] += o[q]; b[q] += o[4 + q]; } }
                    *(u32x4*)mp = pack8(a, b); } }
    }
};
struct EpiResid {
    bf16* xs; const float* ga_l; const float* ga_c;
    __device__ __forceinline__ void operator()(const f32x4 (&acc)[2][2][4][2], const Unit& u, int wr, int wc, int fr, int fq) const {
        EPI_ROWS(u) const float* ga = u.pm == 0 ? ga_c : ga_l;
#pragma unroll
        for (int bj = 0; bj < 2; ++bj) { const int col = u.pn * 256 + cw0 + bj * 128; const f32x4 g0 = *(const f32x4*)(ga + col), g1 = *(const f32x4*)(ga + col + 4);
#pragma unroll
            for (int ai = 0; ai < 2; ++ai)
#pragma unroll
                for (int m = 0; m < 4; ++m) { const int row = row0 + ai * 128 + m * 16; bf16* p = xs + (size_t)row * 1024 + col;
                    float x[8]; unpack8(*(const u32x4*)p, x); const f32x4 x0 = {x[0], x[1], x[2], x[3]}, x1 = {x[4], x[5], x[6], x[7]};
                    *(u32x4*)p = pack8(x0 + g0 * acc[ai][bj][m][0], x1 + g1 * acc[ai][bj][m][1]); } }
    }
};
struct SchedMoeDown {
    TileOrder T; const bf16* A; const bf16* W; const LAS int* tstart;
    __device__ __forceinline__ bool next(int i, Unit& u) const { int pm, pn; if (!T.tile(i, pm, pn)) return false; u.pm = pm; u.pn = pn; u.aux = __builtin_amdgcn_readfirstlane(tstart[pm]); return true; }
    __device__ __forceinline__ const char* abase(const Unit& u) const { return (const char*)(A + (size_t)u.pm * 256 * FF + (u.pn >> 2) * 1408); }
    __device__ __forceinline__ const char* bbase(const Unit& u) const { return (const char*)(W + (size_t)u.aux * D * FF + (size_t)(u.pn & 3) * 256 * FF + (u.pn >> 2) * 1408); }
};
struct EpiMoeY {
    bf16* Y0; bf16* Y1;
    __device__ __forceinline__ void operator()(const f32x4 (&acc)[2][2][4][2], const Unit& u, int wr, int wc, int fr, int fq) const {
        EPI_ROWS(u) bf16* O = (u.pn >> 2) ? Y1 : Y0; const int colt = (u.pn & 3) * 256;
#pragma unroll
        for (int ai = 0; ai < 2; ++ai)
#pragma unroll
            for (int m = 0; m < 4; ++m) { const int row = row0 + ai * 128 + m * 16;
#pragma unroll
                for (int bj = 0; bj < 2; ++bj) *(u32x4*)(O + (size_t)row * D + colt + cw0 + bj * 128) = pack8(acc[ai][bj][m][0], acc[ai][bj][m][1]); }
    }
};
struct SchedCtxK {
    int nsl, nks, G, c; const bf16* A; size_t astride; const bf16* Bt; int lda, ldb;
    __device__ __forceinline__ bool next(int i, Unit& u) const { const int L = i * G + c; if (L >= 4 * nsl) return false; u.pm = 0; u.pn = L & 3; u.aux = L >> 2; return true; }
    __device__ __forceinline__ const char* abase(const Unit& u) const { return (const char*)(A + (size_t)(u.aux / nks) * astride + (size_t)(u.aux % nks) * 256); }
    __device__ __forceinline__ const char* bbase(const Unit& u) const { return (const char*)(Bt + (size_t)u.pn * 256 * ldb + (size_t)(u.aux % nks) * 256); }
};
struct SchedCtxMerge {
    int G, c; const bf16* O; const bf16* W;
    __device__ __forceinline__ bool next(int i, Unit& u) const { const int L = i * G + c; if (L >= 12) return false; u.pm = 0; u.pn = L & 3; u.aux = L >> 2; return true; }
    __device__ __forceinline__ const char* abase(const Unit& u) const { return (const char*)(O + (size_t)u.aux * NT * 512); }
    __device__ __forceinline__ const char* bbase(const Unit& u) const { return (const char*)(W + ((size_t)u.aux * 1024 + (size_t)u.pn * 256) * 512); }
};
struct EpiMergeCtx {
    const bf16* Gt; bf16* M1C;
    __device__ __forceinline__ void operator()(const f32x4 (&acc)[2][2][4][2], const Unit& u, int wr, int wc, int fr, int fq) const {
        EPI_ROWS(u) const int br = u.aux;
#pragma unroll
        for (int ai = 0; ai < 2; ++ai)
#pragma unroll
            for (int m = 0; m < 4; ++m) { const int row = row0 + ai * 128 + m * 16;
#pragma unroll
                for (int bj = 0; bj < 2; ++bj) { const int col = u.pn * 256 + cw0 + bj * 128; float g[8]; unpack8(*(const u32x4*)(Gt + (size_t)row * 3072 + br * 1024 + col), g);
                    f32x4 a, b;
#pragma unroll
                    for (int q = 0; q < 4; ++q) { a[q] = g[q] * acc[ai][bj][m][0][q]; b[q] = g[4 + q] * acc[ai][bj][m][1][q]; }
                    *(u32x4*)(M1C + ((size_t)br * 256 + row) * 1024 + col) = pack8(a, b); } }
    }
};
struct EpiResidPart {
    float* part; const float* ga;
    __device__ __forceinline__ void operator()(const f32x4 (&acc)[2][2][4][2], const Unit& u, int wr, int wc, int fr, int fq) const {
        EPI_ROWS(u)
#pragma unroll
        for (int bj = 0; bj < 2; ++bj) { const int col = u.pn * 256 + cw0 + bj * 128; const f32x4 g0 = *(const f32x4*)(ga + col), g1 = *(const f32x4*)(ga + col + 4);
#pragma unroll
            for (int ai = 0; ai < 2; ++ai)
#pragma unroll
                for (int m = 0; m < 4; ++m) { const int row = row0 + ai * 128 + m * 16; float* p = part + ((size_t)u.aux * 256 + row) * 1024 + col;
                    *(f32x4*)p = g0 * acc[ai][bj][m][0]; *(f32x4*)(p + 4) = g1 * acc[ai][bj][m][1]; } }
    }
};
struct EpiUp {
    bf16* Act;
    __device__ __forceinline__ void operator()(const f32x4 (&acc)[2][2][4][2], const Unit& u, int wr, int wc, int fr, int fq) const {
        EPI_ROWS(u)
#pragma unroll
        for (int ai = 0; ai < 2; ++ai)
#pragma unroll
            for (int m = 0; m < 4; ++m) { const int row = row0 + ai * 128 + m * 16; f32x4 a, b;
#pragma unroll
                for (int q = 0; q < 4; ++q) { a[q] = fsilu(acc[ai][0][m][0][q]) * acc[ai][1][m][0][q]; b[q] = fsilu(acc[ai][0][m][1][q]) * acc[ai][1][m][1][q]; }
                *(u32x4*)(Act + (size_t)row * FF + u.pn * 128 + cw0) = pack8(a, b); }
    }
};
}

namespace att {
constexpr float THR = 8.f;
__device__ __forceinline__ int crow(int r, int hi) { return (r & 3) + 8 * (r >> 2) + 4 * hi; }
template <int DQK> struct Cst { static constexpr float SCALE = DQK == 96 ? 0.10206207261596575f : 0.125f; static constexpr float C = SCALE * 1.4426950408889634f; };

__device__ __forceinline__ void partialSM(f32x16& p0) {
#pragma unroll
    for (int r = 0; r < 16; ++r) p0[r] = __builtin_amdgcn_exp2f(p0[r]);
}
__device__ __forceinline__ void finishSM(f32x16& p0, f32x16& p1, float& l_reg, bf16x8& pa0, bf16x8& pa1, bf16x8& pa2, bf16x8& pa3) {
#pragma unroll
    for (int r = 0; r < 16; ++r) p1[r] = __builtin_amdgcn_exp2f(p1[r]);
    float ps = 0;
#pragma unroll
    for (int r = 0; r < 16; ++r) ps += p0[r];
#pragma unroll
    for (int r = 0; r < 16; ++r) ps += p1[r];
    { auto rr = __builtin_amdgcn_permlane32_swap(__float_as_uint(ps), __float_as_uint(ps), false, false);
      ps = __uint_as_float(rr[0]) + __uint_as_float(rr[1]); }
    l_reg += ps;
#define PK4(P, BASE, OUT) do { unsigned a0 = cvtpk(P[BASE + 0], P[BASE + 1]), a1 = cvtpk(P[BASE + 2], P[BASE + 3]);   \
    unsigned b0 = cvtpk(P[BASE + 4], P[BASE + 5]), b1 = cvtpk(P[BASE + 6], P[BASE + 7]);                              \
    auto r0 = __builtin_amdgcn_permlane32_swap(a0, b0, false, false); auto r1 = __builtin_amdgcn_permlane32_swap(a1, b1, false, false); \
    u32x4 w = {r0[0], r1[0], r0[1], r1[1]}; OUT = *reinterpret_cast<bf16x8*>(&w); } while (0)
    PK4(p0, 0, pa0); PK4(p0, 8, pa1); PK4(p1, 0, pa2); PK4(p1, 8, pa3);
#undef PK4
}
__device__ __forceinline__ int v_st(int k, int c) { const int kk = (k & ~0xC) | ((k & 4) << 1) | ((k & 8) >> 1); return ((kk >> 3) * 2 + (c >> 5)) * 512 + ((kk & 7) * 32 + (c & 31)) * 2; }
__device__ __forceinline__ int v_rd_base(int lane) { return ((lane & 3) << 3) | (((lane >> 2) & 3) << 6) | (((lane >> 4) & 1) << 5) | (((lane >> 5) & 1) << 8); }
constexpr int v_rd_off(int d0, int ks, int half) { return d0 * 512 + ks * 2048 + half * 1024; }
template <int OFF> __device__ __forceinline__ s16x4 tr_read(int vb) {
    s16x4 r; asm volatile("ds_read_b64_tr_b16 %0, %1 offset:%2" : "=&v"(r) : "v"(vb), "i"(OFF) : "memory"); return r;
}
template <int D0> __device__ __forceinline__ void pv_one(f32x16& od, int vb, bf16x8 pa0, bf16x8 pa1, bf16x8 pa2, bf16x8 pa3) {
    const s16x4 l0 = tr_read<v_rd_off(D0, 0, 0)>(vb), h0 = tr_read<v_rd_off(D0, 0, 1)>(vb), l1 = tr_read<v_rd_off(D0, 1, 0)>(vb), h1 = tr_read<v_rd_off(D0, 1, 1)>(vb);
    const s16x4 l2 = tr_read<v_rd_off(D0, 2, 0)>(vb), h2 = tr_read<v_rd_off(D0, 2, 1)>(vb), l3 = tr_read<v_rd_off(D0, 3, 0)>(vb), h3 = tr_read<v_rd_off(D0, 3, 1)>(vb);
    asm volatile("s_waitcnt lgkmcnt(0)" ::: "memory"); SBAR();
#define PK(L, H) (bf16x8){L[0], L[1], L[2], L[3], H[0], H[1], H[2], H[3]}
    od = __builtin_amdgcn_mfma_f32_32x32x16_bf16(PK(l0, h0), pa0, od, 0, 0, 0);
    od = __builtin_amdgcn_mfma_f32_32x32x16_bf16(PK(l1, h1), pa1, od, 0, 0, 0);
    od = __builtin_amdgcn_mfma_f32_32x32x16_bf16(PK(l2, h2), pa2, od, 0, 0, 0);
    od = __builtin_amdgcn_mfma_f32_32x32x16_bf16(PK(l3, h3), pa3, od, 0, 0, 0);
#undef PK
}

constexpr float V8_OFF = -3.0f;
__device__ __forceinline__ int v8_pos(int k) { const int kb = k >> 5, kk = k & 31; return 32 * ((kk >> 2) & 1) + 16 * kb + 4 * (kk >> 3) + (kk & 3); }
__device__ __forceinline__ int v8_byte(int dim, int pos) { return dim * 64 + ((((pos >> 4) ^ (dim >> 2)) & 3) << 4) + (pos & 15); }
__device__ __forceinline__ void finishSM8(f32x16& p0, f32x16& p1, i32x8& pk) {
#pragma unroll
    for (int r = 0; r < 16; ++r) p1[r] = __builtin_amdgcn_exp2f(p1[r]);
#pragma unroll
    for (int w = 0; w < 4; ++w) { int a = __builtin_amdgcn_cvt_pk_fp8_f32(p0[4 * w], p0[4 * w + 1], 0, false); pk[w] = __builtin_amdgcn_cvt_pk_fp8_f32(p0[4 * w + 2], p0[4 * w + 3], a, true);
                                  int b = __builtin_amdgcn_cvt_pk_fp8_f32(p1[4 * w], p1[4 * w + 1], 0, false); pk[4 + w] = __builtin_amdgcn_cvt_pk_fp8_f32(p1[4 * w + 2], p1[4 * w + 3], b, true); }
}
__device__ __forceinline__ i32x8 ld32(const LAS unsigned char* p) { const u32x4 lo = *(const LAS u32x4*)p, hi4 = *(const LAS u32x4*)(p + 16);
    return (i32x8){(int)lo[0], (int)lo[1], (int)lo[2], (int)lo[3], (int)hi4[0], (int)hi4[1], (int)hi4[2], (int)hi4[3]}; }
__device__ __forceinline__ void pv8_sum(f32x16& os, const i32x8 pk) {
    const i32x8 ones = {0x38383838, 0x38383838, 0x38383838, 0x38383838, 0x38383838, 0x38383838, 0x38383838, 0x38383838};
    os = __builtin_amdgcn_mfma_scale_f32_32x32x64_f8f6f4(ones, pk, os, 0, 0, 0, 0x7F7F7F7F, 0, 0x7F7F7F7F);
}
template <int D0> __device__ __forceinline__ void pv8_one(f32x16& od, const LAS unsigned char* vt, int r32, int hi, const i32x8 pk) {
    const LAS unsigned char* row = vt + (32 * D0 + r32) * 64; const int sw = (r32 >> 2) & 3;
    const u32x4 lo = *(const LAS u32x4*)(row + (((2 * hi) ^ sw) << 4)), hi4 = *(const LAS u32x4*)(row + (((2 * hi + 1) ^ sw) << 4));
    const i32x8 vb = {(int)lo[0], (int)lo[1], (int)lo[2], (int)lo[3], (int)hi4[0], (int)hi4[1], (int)hi4[2], (int)hi4[3]};
    od = __builtin_amdgcn_mfma_scale_f32_32x32x64_f8f6f4(vb, pk, od, 0, 0, 0, 0x7F7F7F7F, 0, 0x7F7F7F7F);
}

template <int DQK, bool NA, bool V8 = false>
__device__ __forceinline__ void attn_unit(const bf16* __restrict__ Qb, const int ldq, const bf16* __restrict__ Kh, const int ldk, const bf16* __restrict__ Vh, const int ldv,
                                          bf16* __restrict__ Ob, const int NT_, const int gr_lo, const int gr_hi, const int qb, const float* __restrict__ rpb, LAS unsigned char* lds) {
    constexpr int ND = DQK / 16, KST = DQK * 2 + 16, KCH = DQK / 8, SHK = 64 * KST, SHV = 64 * 64 * 2;
    constexpr float SCALE = Cst<DQK>::SCALE;
    int tid_ = threadIdx.x; asm volatile("" : "+v"(tid_));
    const int tid = tid_, wid = __builtin_amdgcn_readfirstlane(tid >> 6), lane = tid & 63, r32 = lane & 31, hi = lane >> 5;
    constexpr int NSLOT = V8 ? 4 : 2;
    LAS unsigned char* K_lds = lds; LAS unsigned char* V_lds = lds + NSLOT * SHK;
    LAS float* wsf = (LAS float*)(lds + NSLOT * SHK + NSLOT * SHV) + wid * 64; LAS float* li_l = wsf;
    LAS float* btab = (LAS float*)(lds + NSLOT * SHK + NSLOT * SHV + 2048 + 256);
    float l_reg = 0.f; f32x16 o[2] = {}, osum = {}; bf16x8 qr[ND]; i32x8 q8[2];
    if constexpr (V8) {
        const bf16* Qw = Qb + (size_t)(wid * 32 + r32) * ldq;
#pragma unroll
        for (int m = 0; m < 2; ++m)
#pragma unroll
            for (int c = 0; c < 4; ++c) { float f[8]; unpack8(*(const u32x4*)(Qw + (m == 0 ? 32 * hi : 64) + c * 8), f);
                const int w0 = __builtin_amdgcn_cvt_pk_fp8_f32(f[2], f[3], __builtin_amdgcn_cvt_pk_fp8_f32(f[0], f[1], 0, false), true), w1 = __builtin_amdgcn_cvt_pk_fp8_f32(f[6], f[7], __builtin_amdgcn_cvt_pk_fp8_f32(f[4], f[5], 0, false), true);
                q8[m][2 * c] = (m == 1 && hi) ? 0 : w0; q8[m][2 * c + 1] = (m == 1 && hi) ? 0 : w1; }
    } else { const bf16* Qw = Qb + (size_t)(wid * 32 + r32) * ldq + hi * 8;
#pragma unroll
      for (int d0 = 0; d0 < ND; ++d0) qr[d0] = *(const bf16x8*)(Qw + d0 * 16); }
    const int kc8 = tid < 448 ? tid : tid - 64;
    const int ka0 = r32 * 112 + 32 * hi, ka1 = hi ? 7168 : r32 * 112 + 64, ka1b = hi ? 7168 : (32 + r32) * 112 + 64;
    if constexpr (V8) { if (tid < 8) { *(LAS u32x4*)(lds + (tid >> 1) * SHK + 7168 + (tid & 1) * 16) = (u32x4){0u, 0u, 0u, 0u}; } }
    const int id0 = tid, rk0 = id0 / KCH, ck0 = id0 % KCH;
    const int id1 = 512 + (tid & 255), rk1 = id1 / KCH, ck1 = id1 % KCH;
    const int rv = tid >> 3, cv = tid & 7;
    const int kst0 = rk0 * KST + ck0 * 16, kst1 = rk1 * KST + ck1 * 16, vst = v_st(rv, cv * 8);
    const int vb0 = (int)(uintptr_t)V_lds + v_rd_base(lane);
    struct { bf16x8 k0, k1, v; u32x2 v8; } sr_[2];
    const int rqw = 4 * qb + (wid >> 1), cq = 32 * (wid & 1) + r32;
    const int r0w = rqw - 4 < 0 ? 0 : (rqw - 4 > 248 ? 248 : rqw - 4);
    const int c0 = cq - 8 < 0 ? 0 : (cq - 8 > 48 ? 48 : cq - 8);
    if constexpr (NA) { for (int i = tid; i < 465; i += 512) btab[i] = rpb[i] * 1.4426950408889634f; }
#define KB_OF(j) (NA ? ((j) < 4 ? 64 * (j) : NC + 64 * (gr_lo + (j) - 4 > gr_hi ? gr_hi : gr_lo + (j) - 4)) : 64 * (j))
#define SLOAD(i, j) do { const int kb_ = KB_OF(j); if constexpr (V8) sr_[i].k0 = *(const bf16x8*)((const unsigned char*)Kh + (size_t)(kb_ >> 6) * 7168 + kc8 * 16); else { sr_[i].k0 = *(const bf16x8*)(Kh + (size_t)(kb_ + rk0) * ldk + ck0 * 8); \
        if constexpr (DQK == 96) sr_[i].k1 = *(const bf16x8*)(Kh + (size_t)(kb_ + rk1) * ldk + ck1 * 8); } \
        if constexpr (V8) sr_[i].v8 = *(const u32x2*)((const unsigned char*)Vh + (size_t)(kb_ >> 6) * 4096 + tid * 8); else sr_[i].v = *(const bf16x8*)(Vh + (size_t)(kb_ + rv) * ldv + cv * 8); } while (0)
#define SWRITE(b, i) do { if constexpr (V8) *(LAS bf16x8*)(K_lds + (b) * SHK + kc8 * 16) = sr_[i].k0; else { *(LAS bf16x8*)(K_lds + (b) * SHK + kst0) = sr_[i].k0; if constexpr (DQK == 96) *(LAS bf16x8*)(K_lds + (b) * SHK + kst1) = sr_[i].k1; } \
        if constexpr (V8) *(LAS u32x2*)(V_lds + (b) * SHV + tid * 8) = sr_[i].v8; else *(LAS bf16x8*)(V_lds + (b) * SHV + vst) = sr_[i].v; } while (0)
#define SWAIT() do { if constexpr (DQK == 96 && !V8) asm volatile("s_waitcnt vmcnt(3)" ::: "memory"); else asm volatile("s_waitcnt vmcnt(2)" ::: "memory"); } while (0)
#define QKT(P0, P1, V, b, j) do { V = true; int gk_ = 0; if constexpr (NA) { if ((j) >= 4) { gk_ = gr_lo + (j) - 4; V = (gk_ <= gr_hi) && (gk_ >= r0w) && (gk_ <= r0w + 7); } } \
        if (V) { if constexpr (V8) { _Pragma("unroll") for (int r_ = 0; r_ < 16; ++r_) { P0[r_] = V8_OFF; P1[r_] = V8_OFF; } } else { P0 = f32x16{}; P1 = f32x16{}; } const LAS unsigned char* Ks_ = K_lds + (b) * SHK; \
            if constexpr (V8) { const i32x8 a00 = ld32(Ks_ + ka0), a01 = ld32(Ks_ + ka1), a10 = ld32(Ks_ + 3584 + ka0), a11 = ld32(Ks_ + ka1b); \
                P0 = __builtin_amdgcn_mfma_scale_f32_32x32x64_f8f6f4(a00, q8[0], P0, 0, 0, 0, 0x7F7F7F7F, 0, 0x7F7F7F7F); P1 = __builtin_amdgcn_mfma_scale_f32_32x32x64_f8f6f4(a10, q8[0], P1, 0, 0, 0, 0x7F7F7F7F, 0, 0x7F7F7F7F); \
                P0 = __builtin_amdgcn_mfma_scale_f32_32x32x64_f8f6f4(a01, q8[1], P0, 0, 0, 0, 0x7F7F7F7F, 0, 0x7F7F7F7F); P1 = __builtin_amdgcn_mfma_scale_f32_32x32x64_f8f6f4(a11, q8[1], P1, 0, 0, 0, 0x7F7F7F7F, 0, 0x7F7F7F7F); } else \
            _Pragma("unroll") for (int d0 = 0; d0 < ND; ++d0) { const int cb = (d0 * 16 + hi * 8) * 2; \
                const bf16x8 b0 = *(const LAS bf16x8*)(Ks_ + r32 * KST + cb); const bf16x8 b1 = *(const LAS bf16x8*)(Ks_ + (32 + r32) * KST + cb); \
                P0 = __builtin_amdgcn_mfma_f32_32x32x16_bf16(b0, qr[d0], P0, 0, 0, 0); P1 = __builtin_amdgcn_mfma_f32_32x32x16_bf16(b1, qr[d0], P1, 0, 0, 0); } \
            if constexpr (NA) { if ((j) >= 4) { const LAS float* bb_ = btab + (gk_ - rqw + 7) * 31 + (15 - cq) + 4 * hi; \
                _Pragma("unroll") for (int r = 0; r < 16; ++r) { const int ckc = (r & 3) + 8 * (r >> 2); const int ck = ckc + 4 * hi; \
                    P0[r] = (ck >= c0 && ck <= c0 + 15) ? P0[r] + bb_[ckc] : -1e30f; P1[r] = (ck + 32 >= c0 && ck + 32 <= c0 + 15) ? P1[r] + bb_[ckc + 32] : -1e30f; } } } } } while (0)
#define PSM(P0, V) do { if (V) partialSM(P0); } while (0)
#define FSM(P0, P1) do { if constexpr (V8) finishSM8(P0, P1, pk8); else finishSM(P0, P1, l_reg, pa0, pa1, pa2, pa3); } while (0)
#define PV(vbuf) do { if constexpr (V8) { pv8_one<0>(o[0], V_lds + (vbuf) * SHV, r32, hi, pk8); pv8_one<1>(o[1], V_lds + (vbuf) * SHV, r32, hi, pk8); pv8_sum(osum, pk8); } \
        else { pv_one<0>(o[0], vb0 + (vbuf) * SHV, pa0, pa1, pa2, pa3); pv_one<1>(o[1], vb0 + (vbuf) * SHV, pa0, pa1, pa2, pa3); } } while (0)
#define FSM_PV(P0, P1, V, vbuf) do { if (V) { FSM(P0, P1); SBAR(); PV(vbuf); } } while (0)
    f32x16 pA0, pA1, pB0, pB1; bf16x8 pa0, pa1, pa2, pa3; i32x8 pk8; bool vA, vB; const int NTl = NT_;
    if constexpr (V8) {
        const int NP = NTl >> 1;
        SLOAD(0, 0); SLOAD(1, 1); VM_WAIT(); SWRITE(0, 0); SWRITE(1, 1); __syncthreads();
#define PAIR(sb, nb, pp) do { const int jn_ = ((pp) + 1 < NP ? (pp) + 1 : (pp)) * 2; SLOAD(0, jn_); SLOAD(1, jn_ + 1); SBAR(); \
            QKT(pA0, pA1, vA, sb, 0); PSM(pA0, vA); SBAR(); \
            QKT(pB0, pB1, vB, (sb) + 1, 0); FSM(pA0, pA1); SBAR(); \
            PV(sb); PSM(pB0, vB); SBAR(); \
            FSM(pB0, pB1); SBAR(); PV((sb) + 1); \
            asm volatile("s_waitcnt vmcnt(0)" ::: "memory"); SWRITE(nb, 0); SWRITE((nb) + 1, 1); __syncthreads(); } while (0)
        for (int p = 0; p < NP; p += 2) { PAIR(0, 2, p); PAIR(2, 0, p + 1); }
#undef PAIR
    } else {
    SLOAD(0, 0); VM_WAIT(); SWRITE(0, 0); __syncthreads();
    QKT(pA0, pA1, vA, 0, 0); PSM(pA0, vA);
    SLOAD(1, 1); SLOAD(0, (2 < NTl ? 2 : NTl - 1));
    SWAIT(); SWRITE(1, 1); __syncthreads();
    for (int j = 1; j + 1 < NTl; j += 2) {
        SBAR(); QKT(pB0, pB1, vB, 1, j);
        if (vA) { FSM(pA0, pA1); } SBAR();
        SLOAD(1, j + 2); SBAR();
        if (vA) { PV(0); }
        PSM(pB0, vB);
        __syncthreads(); SWAIT(); SWRITE(0, 0);
        __syncthreads();
        SBAR(); QKT(pA0, pA1, vA, 0, j + 1);
        if (vB) { FSM(pB0, pB1); } SBAR();
        SLOAD(0, (j + 3 < NTl ? j + 3 : NTl - 1)); SBAR();
        if (vB) { PV(1); }
        PSM(pA0, vA);
        __syncthreads(); SWAIT(); SWRITE(1, 1);
        __syncthreads();
    }
    SBAR(); QKT(pB0, pB1, vB, 1, NTl - 1);
    FSM_PV(pA0, pA1, vA, 0); PSM(pB0, vB);
    FSM_PV(pB0, pB1, vB, 1);
    }
    { bf16* Ow = Ob + (size_t)(wid * 32 + r32) * 512 + 8 * hi; float rl; if constexpr (V8) rl = __builtin_amdgcn_rcpf(osum[0]); else rl = __builtin_amdgcn_rcpf(l_reg);
#pragma unroll
      for (int d0 = 0; d0 < 2; ++d0)
#pragma unroll
          for (int gp = 0; gp < 2; ++gp) { const int r0 = 8 * gp;
              const unsigned ax = cvtpk(o[d0][r0 + 0] * rl, o[d0][r0 + 1] * rl), ay = cvtpk(o[d0][r0 + 2] * rl, o[d0][r0 + 3] * rl), bx = cvtpk(o[d0][r0 + 4] * rl, o[d0][r0 + 5] * rl), by = cvtpk(o[d0][r0 + 6] * rl, o[d0][r0 + 7] * rl);
              auto s0 = __builtin_amdgcn_permlane32_swap(ax, bx, false, false); auto s1 = __builtin_amdgcn_permlane32_swap(ay, by, false, false);
              *(u32x4*)(Ow + d0 * 32 + 16 * gp) = (u32x4){s0[0], s1[0], s0[1], s1[1]}; } }
    __syncthreads();
#undef KB_OF
#undef SLOAD
#undef SWRITE
#undef SWAIT
#undef QKT
#undef PSM
#undef FSM_PV
#undef FSM
#undef PV
}
}

struct Args { const float* in[39]; float* out; unsigned char* ws; int ph_lo, ph_hi; };
struct Frame {
    LAS unsigned char* lds; unsigned char* ws; float* out;
    int tid, lane, wave, vcu, G, gw, NGW;
};
#define WSP(T, off) ((T*)(F.ws + (off)))
constexpr int INTAB_OFF = RING_BYTES + 1024;
__device__ __forceinline__ const float* inp(const Frame& F, int i) {
    const LAS unsigned* t = (const LAS unsigned*)(F.lds + INTAB_OFF) + 2 * i;
    const unsigned lo = __builtin_amdgcn_readfirstlane(t[0]), hi = __builtin_amdgcn_readfirstlane(t[1]);
    return (const float*)(const GAS float*)(((unsigned long long)hi << 32) | lo);
}

struct CvtItem { const float* src; bf16* dst; const float* kscale; int ldw, ldt, k0; bool zero; };
__device__ __forceinline__ void cvt_load(const CvtItem& d, f32x4 (&v)[8], int lane) {
#pragma unroll
    for (int i = 0; i < 8; ++i) { const int kk = 8 * i + (lane >> 3), n4 = (lane & 7) * 4; v[i] = d.zero ? (f32x4){0.f, 0.f, 0.f, 0.f} : __builtin_nontemporal_load((const f32x4*)(d.src + (size_t)kk * d.ldw + n4)); }
}
__device__ __forceinline__ void cvt_store(const CvtItem& d, f32x4 (&v)[8], LAS float* scr, int lane) {
#pragma unroll
    for (int i = 0; i < 8; ++i) { const int kk = 8 * i + (lane >> 3), n4 = (lane & 7) * 4; f32x4 x = v[i]; if (d.kscale) x *= d.kscale[d.k0 + kk];
        scr[kk * 33 + n4] = x[0]; scr[kk * 33 + n4 + 1] = x[1]; scr[kk * 33 + n4 + 2] = x[2]; scr[kk * 33 + n4 + 3] = x[3]; }
    LDS_WAIT(); asm volatile("" ::: "memory");
    const int c = lane & 7;
#pragma unroll
    for (int j = 0; j < 4; ++j) { const int n = (lane >> 3) + 8 * j; const LAS float* s = scr + (8 * c) * 33 + n;
        u32x4 o; o.x = cvtpk(s[0 * 33], s[1 * 33]); o.y = cvtpk(s[2 * 33], s[3 * 33]); o.z = cvtpk(s[4 * 33], s[5 * 33]); o.w = cvtpk(s[6 * 33], s[7 * 33]);
        *(u32x4*)(d.dst + (size_t)n * d.ldt + 8 * c) = o; }
    LDS_WAIT(); asm volatile("" ::: "memory");
}
__device__ __forceinline__ CvtItem cvt_decode(Frame& F, int l, int it) {
#ifdef DBG_CONV8
    const int j = 0; const bool moe = (l & 1);
#else
    const int j = l >> 1; const bool moe = (l & 1) && !DBG_NOMOE;
#endif
    constexpr int I_WIN = (DINP / 32) * (D / 64), I_UQ = (768 / 32) * (384 / 64), I_UKV = (1024 / 32) * (256 / 64), I_GLU = (512 / 32) * (512 / 64), I_BR = (1024 / 32) * (512 / 64), I_OUT = (1024 / 32) * (1024 / 64);
    constexpr int I_GU = (FF2 / 32) * (D / 64), I_DN = (1024 / 32) * (FF / 64);
    CvtItem d; d.kscale = nullptr; d.zero = false; int r = it;
#define CVT_SET(W, LDW, C0, K0, WT, R0, LDT) do { d.ldw = (LDW); d.ldt = (LDT); d.k0 = (K0); d.src = (W) + (size_t)(K0) * (LDW) + (C0); d.dst = (WT) + (size_t)(R0) * (LDT) + (K0); } while (0)
    if (r < I_WIN) { const int nb = r % (DINP / 32), kb = r / (DINP / 32); const int n0 = nb * 32; const bool z = (n0 >= 672 && n0 < 768); const int c0 = n0 < 672 ? n0 : n0 - 96;
        CVT_SET(inp(F, 8) + (size_t)l * D * 5792, 5792, z ? 0 : c0, kb * 64, WSP(bf16, WS_WIN), n0, D); d.zero = z; return d; } r -= I_WIN;
    if (r < I_UQ) { const int nb = r % 24, kb = r / 24; CVT_SET(inp(F, 11) + (size_t)l * 384 * 768, 768, nb * 32, kb * 64, WSP(bf16, WS_WUQ), nb * 32, 384); d.kscale = inp(F, 9) + l * 384; return d; } r -= I_UQ;
    if (r < I_UKV) { const int nb = r % 32, kb = r / 32; CVT_SET(inp(F, 12) + (size_t)l * 256 * 1024, 1024, nb * 32, kb * 64, WSP(bf16, WS_WUKV), nb * 32, 256); d.kscale = inp(F, 10) + l * 256; return d; } r -= I_UKV;
    if (r < I_GLU) { const int nb = r % 16, kb = r / 16; CVT_SET(inp(F, 26) + (size_t)l * 512 * 512, 512, nb * 32, kb * 64, WSP(bf16, WS_WGLU), nb * 32, 512); return d; } r -= I_GLU;
    if (r < 3 * I_BR) { const int br = r / I_BR, q = r % I_BR, nb = q % 32, kb = q / 32; CVT_SET(inp(F, 28 + br) + (size_t)l * 512 * 1024, 1024, nb * 32, kb * 64, WSP(bf16, WS_WBR) + (size_t)br * 1024 * 512, nb * 32, 512); return d; } r -= 3 * I_BR;
    if (r < I_OUT) { const int nb = r % 32, kb = r / 32; CVT_SET(inp(F, 31) + (size_t)l * D * D, D, nb * 32, kb * 64, WSP(bf16, WS_WOUT), nb * 32, D); return d; } r -= I_OUT;
    const int e = r / (I_GU + I_DN); r = r % (I_GU + I_DN);
    const size_t eo = moe ? ((size_t)j * NEXP + e) : (size_t)j;
    if (r < I_GU) { const int nb = r % (FF2 / 32), kb = r / (FF2 / 32); const int n0 = nb * 32, t = n0 >> 8, i = n0 & 255; const bool up = i >= 128; const int c0 = t * 128 + (i & 127);
        const float* src = (moe ? (up ? inp(F, 37) : inp(F, 36)) : (up ? inp(F, 33) : inp(F, 32))) + eo * (size_t)D * FF;
        CVT_SET(src, FF, c0, kb * 64, WSP(bf16, WS_WGU) + (size_t)e * FF2 * D, n0, D); return d; } r -= I_GU;
    { const int nb = r % 32, kb = r / 32; const float* src = (moe ? inp(F, 38) : inp(F, 34)) + eo * (size_t)FF * D;
      CVT_SET(src, D, nb * 32, kb * 64, WSP(bf16, WS_WD) + (size_t)e * D * FF, nb * 32, FF); return d; }
#undef CVT_SET
}
constexpr int CVT_NONFFN = (DINP / 32) * (D / 64) + (768 / 32) * (384 / 64) + (1024 / 32) * (256 / 64) + (512 / 32) * (512 / 64) + 3 * (1024 / 32) * (512 / 64) + (1024 / 32) * (1024 / 64);
constexpr int CVT_FFN = (FF2 / 32) * (D / 64) + (1024 / 32) * (FF / 64);
#define CW_CVT 24576
__device__ __forceinline__ void convert_items(Frame& F, int l, int first, int end, int step) {
    LAS float* scr = (LAS float*)(F.lds + F.wave * 16384);
    const int total = end;
    int it = first; if (it >= total) return;
    CvtItem cur = cvt_decode(F, l, it); f32x4 va[8], vb[8]; cvt_load(cur, va, F.lane);
    for (;;) {
        const int itn = it + step; const bool more = itn < total; CvtItem nxt = cur;
        if (more) { nxt = cvt_decode(F, l, itn); cvt_load(nxt, vb, F.lane); }
        cvt_store(cur, va, scr, F.lane);
        if (!more) break;
#pragma unroll
        for (int i = 0; i < 8; ++i) va[i] = vb[i];
        cur = nxt; it = itn;
    }
}

__device__ __forceinline__ void prologue0(Frame& F) {
    if (F.vcu == 0 && F.tid < 16) WSP(unsigned, WS_CTL)[CW_CNT + (F.tid >> 3) * 8 * 64 + (F.tid & 7) * 64] = 0u;
    LAS float* red = (LAS float*)F.lds;
    LAS float* sv = (LAS float*)(F.lds + 16384);
    for (int i = F.tid; i < D; i += 512) { sv[i] = fsilu(inp(F, 1)[i]); sv[D + i] = fsilu(inp(F, 3)[i]); }
    __syncthreads();
    for (int it = F.vcu; it < DEPTH * 48; it += F.G) {
        const int l = it / 48, jb = it % 48, cq = F.lane & 31, kh = F.lane >> 5; const int j0 = jb * 128 + cq * 4;
        const float* W = inp(F, 4) + (size_t)l * D * 6144;
        f32x4 accl = {0.f, 0.f, 0.f, 0.f}, accc = {0.f, 0.f, 0.f, 0.f};
#pragma unroll 8
        for (int i = 0; i < 64; ++i) { const int k = F.wave * 128 + 2 * i + kh; const f32x4 w = *(const f32x4*)(W + (size_t)k * 6144 + j0); accl += w * sv[k]; accc += w * sv[D + k]; }
#pragma unroll
        for (int q = 0; q < 4; ++q) { accl[q] += __shfl_xor(accl[q], 32); accc[q] += __shfl_xor(accc[q], 32); }
        if (kh == 0) { *(LAS f32x4*)(red + (F.wave * 2 + 0) * 128 + cq * 4) = accl; *(LAS f32x4*)(red + (F.wave * 2 + 1) * 128 + cq * 4) = accc; }
        __syncthreads();
        if (F.tid < 256) { const int w = F.tid >> 7, jj = F.tid & 127; float sacc = 0.f;
#pragma unroll
          for (int q = 0; q < 8; ++q) sacc += red[(q * 2 + w) * 128 + jj];
          WSP(float, WS_MOD)[((size_t)l * 2 + w) * 6144 + jb * 128 + jj] = sacc + inp(F, 5)[l * 6144 + jb * 128 + jj]; }
        __syncthreads();
    }
    for (int idx = F.vcu * 512 + F.tid; idx < NL * 16; idx += F.G * 512) { const int n = idx >> 4, i = idx & 15; const float pos = (float)(i < 8 ? (n >> 6) : (n & 63));
        const float inv = __expf(-(float)(i & 7) * (9.210340371976184f / 8.f)); float s, c; sincos_rad(pos * inv, s, c);
        WSP(float, WS_ROPE)[idx] = c; WSP(float, WS_ROPE)[NL * 16 + idx] = s; }
    for (int idx = F.vcu * 512 + F.tid; idx < DEPTH * 2 * 32 * 64; idx += F.G * 512) {
        const int g = (idx >> 6) & 31, ld = idx >> 11;
        const float are = inp(F, 18)[idx], aim = inp(F, 19)[idx], dt = __expf(inp(F, 20)[ld * 32 + g]);
        const float er = __expf(are * dt); float sn, cs; sincos_rad(aim * dt, sn, cs);
        const float abr = er * cs, abi = er * sn;
        const float x = abr - 1.f, y = abi, den = 1.f / (are * are + aim * aim);
        const float cr = (x * are + y * aim) * den, ci = (y * are - x * aim) * den;
        float* P = WSP(float, WS_S5P) + (size_t)idx * 100;
        float pr = 1.f, pi = 0.f;
        for (int t = 0; t <= 32; ++t) { P[2 * t] = pr; P[2 * t + 1] = pi; const float nr = pr * abr - pi * abi, ni = pr * abi + pi * abr; pr = nr; pi = ni; }
        const float* bre = inp(F, 21) + (size_t)idx * 16; const float* bim = inp(F, 22) + (size_t)idx * 16;
        for (int c = 0; c < 16; ++c) { const float br = bre[c], bi = bim[c]; P[66 + 2 * c] = cr * br - ci * bi; P[67 + 2 * c] = cr * bi + ci * br; }
    }
}
__device__ __forceinline__ void prologue1(Frame& F) {
    LAS float* Pl = (LAS float*)F.lds;
    LAS float* Cr = Pl + 6400; LAS float* Ci = Cr + 1024;
    for (int ldg = F.vcu; ldg < DEPTH * 2 * 32; ldg += F.G) {
        __syncthreads();
        const float* P = WSP(float, WS_S5P) + (size_t)ldg * 6400; const float* cre = inp(F, 23) + (size_t)ldg * 1024; const float* cim = inp(F, 24) + (size_t)ldg * 1024;
        for (int i = F.tid; i < 6400; i += 512) Pl[i] = P[i];
        for (int i = F.tid; i < 1024; i += 512) { Cr[i] = cre[i]; Ci[i] = cim[i]; }
        __syncthreads();
        for (int e = F.tid; e < 32 * 256; e += 512) { const int cp = e & 15, c = (e >> 4) & 15, tau = e >> 8; float s = 0.f;
#pragma unroll 8
            for (int p = 0; p < 64; ++p) { const LAS float* Pp = Pl + p * 100; const float ar = Pp[2 * tau], ai = Pp[2 * tau + 1], br = Pp[66 + 2 * cp], bi = Pp[67 + 2 * cp];
                const float tr = ar * br - ai * bi, ti = ar * bi + ai * br; s += Cr[c * 64 + p] * tr - Ci[c * 64 + p] * ti; }
            WSP(float, WS_KTAB)[(size_t)ldg * 8192 + e] = s; }
    }
}
__device__ __forceinline__ void s5_tables(Frame& F, int l) {
    const float* KT = WSP(float, WS_KTAB) + (size_t)l * 2 * 32 * 32 * 256;
    const float* SP = WSP(float, WS_S5P) + (size_t)l * 2 * 32 * 64 * 100;
    bf16* WY = WSP(bf16, WS_WY); bf16* WE = WSP(bf16, WS_WEND);
    for (int idx = F.vcu * 512 + F.tid; idx < 32 * 512 * 96; idx += F.G * 512) {
        const int k8 = idx % 96, n = (idx / 96) & 511, g = idx / (96 * 512); const int t = n >> 4, c = n & 15;
        float v[8];
        if (k8 < 64) { const int j = k8 >> 1, c0 = (k8 & 1) * 8, dtj = t - j;
            if (dtj > 0) { const float* s = KT + ((((size_t)0 * 32 + g) * 32 + dtj) * 16 + c) * 16 + c0;
#pragma unroll
                for (int q = 0; q < 8; ++q) v[q] = s[q]; }
            else if (dtj < 0) { const float* s = KT + ((((size_t)1 * 32 + g) * 32 - dtj) * 16 + c) * 16 + c0;
#pragma unroll
                for (int q = 0; q < 8; ++q) v[q] = s[q]; }
            else { const float* s0 = KT + ((((size_t)0 * 32 + g) * 32) * 16 + c) * 16 + c0; const float* s1 = KT + ((((size_t)1 * 32 + g) * 32) * 16 + c) * 16 + c0; const float dsk = inp(F, 25)[l * 512 + g * 16 + c];
#pragma unroll
                for (int q = 0; q < 8; ++q) v[q] = s0[q] + s1[q] + ((c0 + q == c) ? dsk : 0.f); } }
        else { const int part = (k8 - 64) >> 3, dir = part >> 1, im = part & 1, p0 = ((k8 - 64) & 7) * 8; const int e = dir ? 32 - t : t + 1;
            const size_t ldg = ((size_t)(l * 2 + dir) * 32 + g);
            const float* cre = inp(F, 23) + (ldg * 16 + c) * 64 + p0; const float* cim = inp(F, 24) + (ldg * 16 + c) * 64 + p0;
#pragma unroll
            for (int q = 0; q < 8; ++q) { const float* Pp = SP + (((size_t)dir * 32 + g) * 64 + p0 + q) * 100; const float ar = Pp[2 * e], ai = Pp[2 * e + 1];
                v[q] = im ? -(cre[q] * ai + cim[q] * ar) : (cre[q] * ar - cim[q] * ai); } }
        u32x4 w; w.x = cvtpk(v[0], v[1]); w.y = cvtpk(v[2], v[3]); w.z = cvtpk(v[4], v[5]); w.w = cvtpk(v[6], v[7]);
        *(u32x4*)(WY + ((size_t)g * 512 + n) * 768 + k8 * 8) = w;
    }
    for (int idx = F.vcu * 512 + F.tid; idx < 32 * 256 * 64; idx += F.G * 512) {
        const int k8 = idx & 63, q_ = (idx >> 6) & 255, g = idx >> 14; const int j = k8 >> 1, c0 = (k8 & 1) * 8;
        const int dir = q_ >> 7, im = (q_ >> 6) & 1, p = q_ & 63; const int e = dir ? j : 31 - j;
        const float* Pp = SP + (((size_t)dir * 32 + g) * 64 + p) * 100; const float ar = Pp[2 * e], ai = Pp[2 * e + 1]; float v[8];
#pragma unroll
        for (int q = 0; q < 8; ++q) { const float br = Pp[66 + 2 * (c0 + q)], bi = Pp[67 + 2 * (c0 + q)]; v[q] = im ? (ar * bi + ai * br) : (ar * br - ai * bi); }
        u32x4 w; w.x = cvtpk(v[0], v[1]); w.y = cvtpk(v[2], v[3]); w.z = cvtpk(v[4], v[5]); w.w = cvtpk(v[6], v[7]);
        *(u32x4*)(WE + ((size_t)g * 256 + q_) * 512 + k8 * 8) = w;
    }
}

__device__ __forceinline__ void moe_bases(const unsigned* cnt, int (&base)[9]) {
    int b = 0;
#pragma unroll
    for (int e = 0; e < 8; ++e) { base[e] = b; const int c = (int)__hip_atomic_load(cnt + 64 * e, __ATOMIC_RELAXED, __HIP_MEMORY_SCOPE_AGENT); b += ((c + 255) >> 8) << 8; }
    base[8] = b;
}

template <int MODE>
__device__ __forceinline__ void norm_phase(Frame& F, int l) {
    bf16* xs = WSP(bf16, WS_XS); bf16* H = WSP(bf16, WS_H);
    const float* gn = inp(F, MODE == 0 ? 6 : 7) + l * D;
    const float* modl = WSP(float, WS_MOD) + ((size_t)l * 2 + 0) * 6144 + (MODE == 0 ? 0 : 3 * D);
    const float* modc = WSP(float, WS_MOD) + ((size_t)l * 2 + 1) * 6144 + (MODE == 0 ? 0 : 3 * D);
    const bool moe = (MODE == 1) && (l & 1) && !DBG_NOMOE;
    const bool comb = (MODE == 0) && l > 0 && ((l - 1) & 1) && !DBG_NOMOE;
    const int row_lo = (MODE == 1 && l == DEPTH - 1) ? NC : 0;
    int base[9];
    const unsigned* cntp = (const unsigned*)WSP(unsigned, WS_CTL) + CW_CNT + ((l - 1) >> 1) * 8 * 64;
    if (comb) moe_bases(cntp, base);
    LAS float* wr_l = (LAS float*)F.lds;
    LAS int* lcnt = (LAS int*)(F.lds + 32768); LAS int* wgbase = lcnt + 8; LAS unsigned* rowrec = (LAS unsigned*)(F.lds + 32768 + 256);
    if (moe) { const float* wrt = inp(F, 35) + (size_t)(l >> 1) * D * 8; for (int i = F.tid; i < D * 8; i += 512) wr_l[i] = wrt[i]; if (F.tid < 8) lcnt[F.tid] = 0; __syncthreads(); }
    int krow = 0;
    unsigned* cnt = WSP(unsigned, WS_CTL) + CW_CNT + (l >> 1) * 8 * 64;
    const float* ga2p_l = WSP(float, WS_MOD) + ((size_t)(l - 1) * 2 + 0) * 6144 + 5 * D; const float* ga2p_c = WSP(float, WS_MOD) + ((size_t)(l - 1) * 2 + 1) * 6144 + 5 * D;
    for (int m = row_lo + F.gw; m < NT; m += F.NGW) {
        f32x4 v[4];
        if (MODE == 0 && l == 0) { const float* src = m < NC ? inp(F, 2) + (size_t)m * D : inp(F, 0) + (size_t)(m - NC) * D;
#pragma unroll
            for (int j = 0; j < 4; ++j) v[j] = *(const f32x4*)(src + j * 256 + F.lane * 4); }
        else {
#ifdef DBG_SC1
#pragma unroll
            for (int j = 0; j < 4; ++j) {
#pragma unroll
                for (int q = 0; q < 4; ++q) v[j][q] = __hip_atomic_load(xs + (size_t)m * D + j * 256 + F.lane * 4 + q, __ATOMIC_RELAXED, __HIP_MEMORY_SCOPE_AGENT); }
#else
#pragma unroll
            for (int j = 0; j < 4; ++j) v[j] = ld4bf(xs + (size_t)m * D + j * 256 + F.lane * 4);
#endif
        }
        if (comb) { const unsigned* rec = WSP(unsigned, WS_REC) + (size_t)m * 8; const int e0 = rec[0], p0 = rec[1], e1 = rec[2], p1 = rec[3]; const float w0 = __uint_as_float(rec[4]), w1 = __uint_as_float(rec[5]);
            int r0 = 0, r1 = 0;
#pragma unroll
            for (int e = 0; e < 8; ++e) { r0 = (e == e0) ? base[e] + p0 : r0; r1 = (e == e1) ? base[e] + p1 : r1; }
            const bf16* Y0 = WSP(bf16, WS_Y) + (size_t)r0 * D; const bf16* Y1 = WSP(bf16, WS_Y) + (size_t)r1 * D; const float* ga = m < NC ? ga2p_c : ga2p_l; constexpr size_t YH = (size_t)(WS_Y2 - WS_Y) / 2;
#pragma unroll
            for (int j = 0; j < 4; ++j) { const int col = j * 256 + F.lane * 4; const u32x2 a = *(const u32x2*)(Y0 + col), b = *(const u32x2*)(Y1 + col), a2 = *(const u32x2*)(Y0 + YH + col), b2 = *(const u32x2*)(Y1 + YH + col); const f32x4 g = *(const f32x4*)(ga + col);
                v[j][0] += g[0] * (w0 * (bflo(a.x) + bflo(a2.x)) + w1 * (bflo(b.x) + bflo(b2.x))); v[j][1] += g[1] * (w0 * (bfhi(a.x) + bfhi(a2.x)) + w1 * (bfhi(b.x) + bfhi(b2.x)));
                v[j][2] += g[2] * (w0 * (bflo(a.y) + bflo(a2.y)) + w1 * (bflo(b.y) + bflo(b2.y))); v[j][3] += g[3] * (w0 * (bfhi(a.y) + bfhi(a2.y)) + w1 * (bfhi(b.y) + bfhi(b2.y))); } }
        const int npart = (m < NC) ? ((MODE == 1) ? (l < DEPTH - 1 ? 12 : 0) : ((l > 0 && !((l - 1) & 1)) ? 11 : 0)) : 0;
        if (npart) { const float* pp = WSP(float, WS_PART) + (size_t)m * D;
            for (int k = 0; k < npart; ++k) {
#pragma unroll
                for (int j = 0; j < 4; ++j) v[j] += *(const f32x4*)(pp + (size_t)k * 256 * D + j * 256 + F.lane * 4); } }
        if ((MODE == 0 && l == 0) || comb || npart) {
#pragma unroll
            for (int j = 0; j < 4; ++j) st4bf(xs + (size_t)m * D + j * 256 + F.lane * 4, v[j]); }
        float ss = 0.f;
#pragma unroll
        for (int j = 0; j < 4; ++j) ss += (v[j][0] * v[j][0] + v[j][1] * v[j][1]) + (v[j][2] * v[j][2] + v[j][3] * v[j][3]);
        const float r = 1.0f / sqrtf(wave_sum(ss) * (1.f / D) + EPS);
        const float* md = m < NC ? modc : modl;
        float lg[8] = {0.f, 0.f, 0.f, 0.f, 0.f, 0.f, 0.f, 0.f};
#pragma unroll
        for (int j = 0; j < 4; ++j) { const int col = j * 256 + F.lane * 4; const f32x4 g = *(const f32x4*)(gn + col), sh = *(const f32x4*)(md + col), sc = *(const f32x4*)(md + D + col);
            f32x4 h;
#pragma unroll
            for (int q = 0; q < 4; ++q) h[q] = (v[j][q] * r * g[q]) * (1.f + sc[q]) + sh[q];
            u32x2 w; w.x = cvtpk(h[0], h[1]); w.y = cvtpk(h[2], h[3]); *(u32x2*)(H + (size_t)m * D + col) = w;
            if (moe) {
#pragma unroll
                for (int q = 0; q < 4; ++q) { const f32x4 wa = *(const LAS f32x4*)(wr_l + (col + q) * 8), wb = *(const LAS f32x4*)(wr_l + (col + q) * 8 + 4);
                    lg[0] += h[q] * wa[0]; lg[1] += h[q] * wa[1]; lg[2] += h[q] * wa[2]; lg[3] += h[q] * wa[3]; lg[4] += h[q] * wb[0]; lg[5] += h[q] * wb[1]; lg[6] += h[q] * wb[2]; lg[7] += h[q] * wb[3]; } } }
        if (moe) {
#pragma unroll
            for (int e = 0; e < 8; ++e) lg[e] = wave_sum(lg[e]);
            int i0 = 0; float v0 = lg[0];
#pragma unroll
            for (int e = 1; e < 8; ++e) if (lg[e] > v0) { v0 = lg[e]; i0 = e; }
            int i1 = -1; float v1 = -3.0e38f;
#pragma unroll
            for (int e = 0; e < 8; ++e) if (e != i0 && lg[e] > v1) { v1 = lg[e]; i1 = e; }
#ifdef DBG_FIXROUTE
            i0 = m & 7; i1 = (m + 1) & 7; v0 = 0.f; v1 = 0.f;
#endif
            if (F.lane == 0) { const float w1 = 1.f / (1.f + __expf(v0 - v1)), w0 = 1.f - w1;
                const unsigned p0 = (unsigned)__hip_atomic_fetch_add(lcnt + i0, 1, __ATOMIC_RELAXED, __HIP_MEMORY_SCOPE_WORKGROUP), p1 = (unsigned)__hip_atomic_fetch_add(lcnt + i1, 1, __ATOMIC_RELAXED, __HIP_MEMORY_SCOPE_WORKGROUP);
                LAS unsigned* rr = rowrec + (F.wave * 9 + krow) * 6; rr[0] = i0; rr[1] = p0; rr[2] = i1; rr[3] = p1; rr[4] = __float_as_uint(w0); rr[5] = __float_as_uint(w1); }
            ++krow;
        }
    }
    if (moe) {
        __syncthreads();
        if (F.tid < 8) wgbase[F.tid] = (int)__hip_atomic_fetch_add(cnt + 64 * F.tid, (unsigned)lcnt[F.tid], __ATOMIC_RELAXED, __HIP_MEMORY_SCOPE_AGENT);
        __syncthreads();
        if (F.lane == 0) { int k = 0; for (int m = row_lo + F.gw; m < NT; m += F.NGW, ++k) { const LAS unsigned* rr = rowrec + (F.wave * 9 + k) * 6; unsigned* rec = WSP(unsigned, WS_REC) + (size_t)m * 8;
            const unsigned e0 = rr[0], e1 = rr[2]; rec[0] = e0; rec[1] = rr[1] + (unsigned)wgbase[e0]; rec[2] = e1; rec[3] = rr[3] + (unsigned)wgbase[e1]; rec[4] = rr[4]; rec[5] = rr[5]; } }
    }
}
__device__ __forceinline__ void moe_scatter(Frame& F, int l) {
    int base[9]; moe_bases((const unsigned*)WSP(unsigned, WS_CTL) + CW_CNT + (l >> 1) * 8 * 64, base);
    const int row_lo = (l == DEPTH - 1) ? NC : 0;
    const bf16* H = WSP(bf16, WS_H); bf16* HS = WSP(bf16, WS_HS);
    for (int it = 2 * row_lo + F.gw; it < 2 * NT; it += F.NGW) { const int m = it >> 1, s = it & 1; const unsigned* rec = WSP(unsigned, WS_REC) + (size_t)m * 8; const int e = rec[2 * s], p = rec[2 * s + 1];
        int r = 0;
#pragma unroll
        for (int q = 0; q < 8; ++q) r = (q == e) ? base[q] + p : r;
        const u32x4* src = (const u32x4*)(H + (size_t)m * D); u32x4* dst = (u32x4*)(HS + (size_t)r * D);
        dst[F.lane] = src[F.lane]; dst[64 + F.lane] = src[64 + F.lane]; }
}
__device__ __forceinline__ void final_out(Frame& F, int l) {
#if DBG_DUMP == 9
    { const float* xs = WSP(float, WS_XS); for (int m = NC + ((F.gw + 1024 + 3) % F.NGW); m < NT; m += F.NGW) { for (int j = 0; j < 16; ++j) { const int col = j * 64 + F.lane; F.out[(size_t)(m - NC) * D + col] = xs[(size_t)m * D + col]; } } return; }
#elif DBG_DUMP == 10
    { const float* md = WSP(float, WS_MOD); for (int m = NC + F.gw; m < NT; m += F.NGW) { for (int j = 0; j < 16; ++j) { const int col = j * 64 + F.lane; F.out[(size_t)(m - NC) * D + col] = md[((size_t)(m - NC) * D + col) % 49152]; } } return; }
#elif DBG_DUMP
    { const bf16* src = WSP(bf16, DBG_DUMP == 1 ? WS_H : DBG_DUMP == 2 ? WS_G : DBG_DUMP == 3 ? WS_KVRAW : DBG_DUMP == 4 ? WS_OA : DBG_DUMP == 5 ? WS_M1 : DBG_DUMP == 6 ? WS_QF : DBG_DUMP == 7 ? WS_Z : WS_OC);
      const int ld = DBG_DUMP == 2 ? 3072 : (DBG_DUMP == 4 || DBG_DUMP == 7 || DBG_DUMP == 8) ? 512 : DBG_DUMP == 6 ? 96 : 1024;
      for (int m = NC + F.gw; m < NT; m += F.NGW) { for (int j = 0; j < 16; ++j) { const int col = j * 64 + F.lane; F.out[(size_t)(m - NC) * D + col] = bf2f(src[(size_t)m * ld + (col % ld)]); } } return; }
#endif
    if (!(l & 1) || DBG_NOMOE) { const bf16* xs = WSP(bf16, WS_XS); for (int m = NC + F.gw; m < NT; m += F.NGW) {
#pragma unroll
        for (int j = 0; j < 4; ++j) *(f32x4*)(F.out + (size_t)(m - NC) * D + j * 256 + F.lane * 4) = ld4bf(xs + (size_t)m * D + j * 256 + F.lane * 4); } return; }
    int base[9]; moe_bases((const unsigned*)WSP(unsigned, WS_CTL) + CW_CNT + (l >> 1) * 8 * 64, base);
    const bf16* xs = WSP(bf16, WS_XS); const float* ga = WSP(float, WS_MOD) + ((size_t)l * 2 + 0) * 6144 + 5 * D;
    for (int m = NC + F.gw; m < NT; m += F.NGW) { const unsigned* rec = WSP(unsigned, WS_REC) + (size_t)m * 8; const int e0 = rec[0], p0 = rec[1], e1 = rec[2], p1 = rec[3];
#ifndef DBG_NOREC
        const float w0 = __uint_as_float(rec[4]), w1 = __uint_as_float(rec[5]);
#endif
        int r0 = 0, r1 = 0;
#pragma unroll
        for (int e = 0; e < 8; ++e) { r0 = (e == e0) ? base[e] + p0 : r0; r1 = (e == e1) ? base[e] + p1 : r1; }
        const bf16* Y0 = WSP(bf16, DBG_YSRC) + (size_t)r0 * D; const bf16* Y1 = WSP(bf16, DBG_YSRC) + (size_t)r1 * D;
#ifdef DBG_DIRECTH
        Y0 = WSP(bf16, WS_H) + (size_t)m * D; Y1 = Y0;
#endif
#ifdef DBG_NOREC
        const float w0 = DBG_W, w1 = DBG_W;
#endif
#pragma unroll
        for (int j = 0; j < 4; ++j) { const int col = j * 256 + F.lane * 4; constexpr size_t YH = (size_t)(WS_Y2 - WS_Y) / 2; const u32x2 a = *(const u32x2*)(Y0 + col), b = *(const u32x2*)(Y1 + col), a2 = *(const u32x2*)(Y0 + YH + col), b2 = *(const u32x2*)(Y1 + YH + col); const f32x4 g = *(const f32x4*)(ga + col); f32x4 v = ld4bf(xs + (size_t)m * D + col);
            v[0] += g[0] * (w0 * (bflo(a.x) + bflo(a2.x)) + w1 * (bflo(b.x) + bflo(b2.x))); v[1] += g[1] * (w0 * (bfhi(a.x) + bfhi(a2.x)) + w1 * (bfhi(b.x) + bfhi(b2.x))); v[2] += g[2] * (w0 * (bflo(a.y) + bflo(a2.y)) + w1 * (bflo(b.y) + bflo(b2.y))); v[3] += g[3] * (w0 * (bfhi(a.y) + bfhi(a2.y)) + w1 * (bfhi(b.y) + bfhi(b2.y)));
            *(f32x4*)(F.out + (size_t)(m - NC) * D + col) = v; } }
}

__device__ __forceinline__ float sum8(float v) { v += __shfl_xor(v, 1); v += __shfl_xor(v, 2); v += __shfl_xor(v, 4); return v; }
__device__ __forceinline__ void finalize_phase(Frame& F, int l, int wg, int nwg) {
    const bf16* pA = WSP(bf16, WS_PA); const bf16* pN = WSP(bf16, WS_PN); const bf16* QR = WSP(bf16, WS_QRAW); const bf16* KVR = WSP(bf16, WS_KVRAW);
    bf16* QF = WSP(bf16, WS_QF); unsigned char* K8G = WSP(unsigned char, WS_KF); unsigned char* V8G = WSP(unsigned char, WS_VF); bf16* NQ = WSP(bf16, WS_NQ); bf16* NK = WSP(bf16, WS_NK);
    const float* gqn = inp(F, 13) + l * 96; const float* gkn = inp(F, 14) + l * 96; const float* gnq = inp(F, 15) + l * 64; const float* gnk = inp(F, 16) + l * 64;
    const float* COS = WSP(float, WS_ROPE); const float* SIN = COS + NL * 16;
    LAS unsigned char* buf = F.lds; LAS float* stats = (LAS float*)(F.lds + RING_BYTES + 4096); LAS unsigned char* krl = F.lds + RING_BYTES + 4096 + 512;
    const int tid0 = F.tid;
#define SWZ(c, row) (((c) & ~15) | (((c) ^ (row)) & 15))
#define PK8(f) (u32x4){cvtpk(f[0], f[1]), cvtpk(f[2], f[3]), cvtpk(f[4], f[5]), cvtpk(f[6], f[7])}
    for (int tg = wg; tg < NT / 64; tg += nwg) {
        int tid_ = tid0; asm volatile("" : "+v"(tid_));
        const int tid = tid_, lane = tid & 63, wave = __builtin_amdgcn_readfirstlane(tid >> 6), h = tid >> 6, tl = tid & 63;
        const int t0 = tg * 64, t = t0 + tl; const bool lat = t >= NC; const int n = t - NC;
        __syncthreads();
        { u32x4 va[8], vb[8]; float sq[8], skv[8];
#pragma unroll
          for (int i = 0; i < 8; ++i) { const bf16* row = pA + (size_t)(t0 + wave * 8 + i) * 768; va[i] = *(const u32x4*)(row + lane * 8); vb[i] = lane < 20 ? *(const u32x4*)(row + (64 + lane) * 8) : (u32x4){0u, 0u, 0u, 0u}; }
#pragma unroll
          for (int i = 0; i < 8; ++i) { float f[8]; unpack8(va[i], f); float ss = 0.f;
#pragma unroll
              for (int q = 0; q < 8; ++q) ss += f[q] * f[q];
              sq[i] = lane < 48 ? ss : 0.f; skv[i] = lane >= 48 ? ss : 0.f;
              if (lane < 16) { float g[8]; unpack8(vb[i], g);
#pragma unroll
                  for (int q = 0; q < 8; ++q) skv[i] += g[q] * g[q]; }
              else if (lane < 20) *(LAS u32x4*)(krl + (wave * 8 + i) * 64 + (lane - 16) * 16) = vb[i]; }
#pragma unroll
          for (int o = 1; o < 64; o <<= 1) {
#pragma unroll
              for (int i = 0; i < 8; ++i) { sq[i] += __shfl_xor(sq[i], o); skv[i] += __shfl_xor(skv[i], o); } }
          if (lane == 0) {
#pragma unroll
              for (int i = 0; i < 8; ++i) { stats[(wave * 8 + i) * 2] = 1.0f / sqrtf(sq[i] * (1.f / 384.f) + EPS); stats[(wave * 8 + i) * 2 + 1] = 1.0f / sqrtf(skv[i] * (1.f / 256.f) + EPS); } } }
#pragma unroll 8
        for (int i = 0; i < 12; ++i) { const int id = tid + 512 * i, row = id / 96, c = id % 96; *(LAS u32x4*)(buf + row * 1536 + SWZ(c, row) * 16) = *(const u32x4*)(QR + (size_t)(t0 + row) * 768 + c * 8); }
        __syncthreads();
        { LAS unsigned char* pq = buf + tl * 1536; const float rq = stats[tl * 2]; float ss = 0.f;
#define QCH(c) (pq + SWZ(h * 12 + (c), tl) * 16)
#pragma unroll
          for (int c = 0; c < 12; ++c) { float f[8]; unpack8(*(const LAS u32x4*)QCH(c), f);
#pragma unroll
              for (int q = 0; q < 8; ++q) { const float v = f[q] * rq; ss += v * v; } }
          const float sc = rq / sqrtf(ss * (1.f / 96.f) + EPS) * (0.10206207261596575f * 1.4426950408889634f);
#pragma unroll
          for (int c = 0; c < 8; ++c) { float f[8]; unpack8(*(const LAS u32x4*)QCH(c), f);
#pragma unroll
              for (int q = 0; q < 8; ++q) f[q] = f[q] * sc * gqn[c * 8 + q];
              *(LAS u32x4*)QCH(c) = PK8(f); }
#pragma unroll
          for (int cp = 0; cp < 2; ++cp) { float a[8], b[8]; unpack8(*(const LAS u32x4*)QCH(8 + cp), a); unpack8(*(const LAS u32x4*)QCH(10 + cp), b);
#pragma unroll
              for (int q = 0; q < 8; ++q) { a[q] = a[q] * sc * gqn[64 + cp * 8 + q]; b[q] = b[q] * sc * gqn[80 + cp * 8 + q]; }
              if (lat) {
#pragma unroll
                  for (int q = 0; q < 8; ++q) { const float cs = COS[(size_t)n * 16 + cp * 8 + q], sn = SIN[(size_t)n * 16 + cp * 8 + q]; const float ra = a[q] * cs - b[q] * sn, rb = a[q] * sn + b[q] * cs; a[q] = ra; b[q] = rb; } }
              *(LAS u32x4*)QCH(8 + cp) = PK8(a); *(LAS u32x4*)QCH(10 + cp) = PK8(b); } }
#undef QCH
        __syncthreads();
#pragma unroll 8
        for (int i = 0; i < 12; ++i) { const int id = tid + 512 * i, hh = id / 768, rem = id % 768, row = rem / 12, c = rem % 12;
            *(u32x4*)(QF + ((size_t)hh * NT + t0 + row) * 96 + c * 8) = *(const LAS u32x4*)(buf + row * 1536 + SWZ(hh * 12 + c, row) * 16); }
        __syncthreads();
#pragma unroll 8
        for (int i = 0; i < 16; ++i) { const int id = tid + 512 * i, row = id >> 7, c = id & 127; *(LAS u32x4*)(buf + row * 2048 + SWZ(c, row) * 16) = *(const u32x4*)(KVR + (size_t)(t0 + row) * 1024 + c * 8); }
        __syncthreads();
        unsigned v8r[16];
#define F8W(f, o) ((unsigned)__builtin_amdgcn_cvt_pk_fp8_f32(f[(o) + 2], f[(o) + 3], __builtin_amdgcn_cvt_pk_fp8_f32(f[(o)], f[(o) + 1], 0, false), true))
        { LAS unsigned char* pk = buf + tl * 2048; const LAS unsigned char* pr = krl + tl * 64;
#define KCHK(c) (pk + SWZ(h * 16 + (c), tl) * 16)
          const float rkv = stats[tl * 2 + 1]; float ss = 0.f;
#pragma unroll
          for (int c = 0; c < 8; ++c) { float f[8]; unpack8(*(const LAS u32x4*)KCHK(c), f);
#pragma unroll
              for (int q = 0; q < 8; ++q) { const float v = f[q] * rkv; ss += v * v; } }
#pragma unroll
          for (int c = 0; c < 4; ++c) { float f[8]; unpack8(*(const LAS u32x4*)(pr + c * 16), f);
#pragma unroll
              for (int q = 0; q < 8; ++q) ss += f[q] * f[q]; }
          const float rn = 1.0f / sqrtf(ss * (1.f / 96.f) + EPS), sc = rkv * rn; unsigned kw[16];
#pragma unroll
          for (int c = 0; c < 8; ++c) { float f[8]; unpack8(*(const LAS u32x4*)KCHK(c), f);
#pragma unroll
              for (int q = 0; q < 8; ++q) f[q] = f[q] * sc * gkn[c * 8 + q];
              kw[c * 2] = F8W(f, 0); kw[c * 2 + 1] = F8W(f, 4); }
          unsigned kr[8];
#pragma unroll
          for (int c = 8; c < 16; ++c) { float f[8]; unpack8(*(const LAS u32x4*)KCHK(c), f);
#pragma unroll
              for (int q = 0; q < 8; ++q) f[q] *= rkv;
              v8r[(c - 8) * 2] = F8W(f, 0); v8r[(c - 8) * 2 + 1] = F8W(f, 4); }
#pragma unroll
          for (int cp = 0; cp < 2; ++cp) { float a[8], b[8]; unpack8(*(const LAS u32x4*)(pr + cp * 16), a); unpack8(*(const LAS u32x4*)(pr + (2 + cp) * 16), b);
#pragma unroll
              for (int q = 0; q < 8; ++q) { a[q] = a[q] * rn * gkn[64 + cp * 8 + q]; b[q] = b[q] * rn * gkn[80 + cp * 8 + q]; }
              if (lat) {
#pragma unroll
                  for (int q = 0; q < 8; ++q) { const float cs = COS[(size_t)n * 16 + cp * 8 + q], sn = SIN[(size_t)n * 16 + cp * 8 + q]; const float ra = a[q] * cs - b[q] * sn, rb = a[q] * sn + b[q] * cs; a[q] = ra; b[q] = rb; } }
              kr[cp * 2] = F8W(a, 0); kr[cp * 2 + 1] = F8W(a, 4); kr[4 + cp * 2] = F8W(b, 0); kr[4 + cp * 2 + 1] = F8W(b, 4); }
#pragma unroll
          for (int w = 0; w < 4; ++w) *(LAS u32x4*)KCHK(w) = (u32x4){kw[4 * w], kw[4 * w + 1], kw[4 * w + 2], kw[4 * w + 3]};
          *(LAS u32x4*)KCHK(4) = (u32x4){kr[0], kr[1], kr[2], kr[3]}; *(LAS u32x4*)KCHK(5) = (u32x4){kr[4], kr[5], kr[6], kr[7]}; }
#undef F8W
        __syncthreads();
        int tq = tid; asm volatile("" : "+v"(tq));
#pragma unroll
        for (int i = 0; i < 6; ++i) { const int id = tq + 512 * i, hh = id / 384, r = id % 384, row = r / 6, w = r % 6;
            *(u32x4*)(K8G + ((size_t)hh * (NT / 64) + tg) * 7168 + row * 112 + w * 16) = *(const LAS u32x4*)(buf + row * 2048 + SWZ(hh * 16 + w, row) * 16); }
        __syncthreads();
        { int tl2 = tq & 63; const int pos = att::v8_pos(tl2); LAS unsigned char* vt = buf + (tq >> 6) * 4096 + (pos & 15);
          LAS unsigned char* vq[4];
#pragma unroll
          for (int x = 0; x < 4; ++x) vq[x] = vt + ((((pos >> 4) ^ x) & 3) << 4);
#pragma unroll
          for (int w = 0; w < 16; ++w)
#pragma unroll
              for (int b = 0; b < 4; ++b) vq[w & 3][(4 * w + b) * 64] = (unsigned char)(v8r[w] >> (8 * b)); }
        __syncthreads();
#pragma unroll
        for (int i = 0; i < 4; ++i) { const int id = tq + 512 * i, hh = id >> 8, off = (id & 255) * 16;
            *(u32x4*)(V8G + ((size_t)hh * (NT / 64) + tg) * 4096 + off) = *(const LAS u32x4*)(buf + hh * 4096 + off); }
        __syncthreads();
#pragma unroll 8
        for (int i = 0; i < 16; ++i) { const int id = tid + 512 * i, row = id >> 7, c = id & 127; *(LAS u32x4*)(buf + row * 2048 + SWZ(c, row) * 16) = *(const u32x4*)(pN + (size_t)(t0 + row) * 1536 + c * 8); }
        __syncthreads();
#pragma unroll
        for (int which = 0; which < 2; ++which) { LAS unsigned char* pn = buf + tl * 2048; const float* gg = which ? gnk : gnq; float ss = 0.f;
#pragma unroll
            for (int c = 0; c < 8; ++c) { float f[8]; unpack8(*(const LAS u32x4*)(pn + SWZ(which * 64 + h * 8 + c, tl) * 16), f);
#pragma unroll
                for (int q = 0; q < 8; ++q) ss += f[q] * f[q]; }
            const float rn = (which ? 1.0f : 0.125f * 1.4426950408889634f) / sqrtf(ss * (1.f / 64.f) + EPS);
#pragma unroll
            for (int c = 0; c < 8; ++c) { float f[8]; unpack8(*(const LAS u32x4*)(pn + SWZ(which * 64 + h * 8 + c, tl) * 16), f);
#pragma unroll
                for (int q = 0; q < 8; ++q) f[q] = f[q] * rn * gg[c * 8 + q];
                *(LAS u32x4*)(pn + SWZ(which * 64 + h * 8 + c, tl) * 16) = PK8(f); } }
        __syncthreads();
#pragma unroll 8
        for (int i = 0; i < 8; ++i) { const int id = tid + 512 * i, hh = id >> 9, row = (id & 511) >> 3, c = id & 7;
            *(u32x4*)(NQ + ((size_t)hh * NT + t0 + row) * 64 + c * 8) = *(const LAS u32x4*)(buf + row * 2048 + SWZ(hh * 8 + c, row) * 16);
            *(u32x4*)(NK + ((size_t)hh * NT + t0 + row) * 64 + c * 8) = *(const LAS u32x4*)(buf + row * 2048 + SWZ(64 + hh * 8 + c, row) * 16); }
    }
#undef PK8
#undef SWZ
#undef KCHK
}
__device__ __forceinline__ void s5_carry(Frame& F, int l, int cw) {
    const int idx = cw * 512 + F.tid; const int seg = idx & 7, p = (idx >> 3) & 63, g = (idx >> 9) & 31, dir = idx >> 14;
    const float* Pp = WSP(float, WS_S5P) + ((((size_t)l * 2 + dir) * 32 + g) * 64 + p) * 100; const float ar = Pp[64], ai = Pp[65];
    const float* E = WSP(float, WS_E) + (size_t)g * S5ROWS * 256 + dir * 128 + p; bf16* AG = WSP(bf16, WS_AG) + (size_t)g * S5ROWS * S5K + 512 + dir * 128 + p;
#define S5ROW(st) (dir == 0 ? ((st) < 8 ? 512 + (st) : (st) - 8) : 519 - (st))
    float tr = 0.f, ti = 0.f, pr = 1.f, pi = 0.f;
    for (int s0 = 0; s0 < 65; s0 += 5) { float er[5], ei[5];
#pragma unroll
        for (int q = 0; q < 5; ++q) { const int row = S5ROW(seg * 65 + s0 + q); er[q] = E[(size_t)row * 256]; ei[q] = E[(size_t)row * 256 + 64]; }
#pragma unroll
        for (int q = 0; q < 5; ++q) { const float nr = ar * tr - ai * ti + er[q], ni = ar * ti + ai * tr + ei[q]; tr = nr; ti = ni; const float qr = pr * ar - pi * ai, qi = pr * ai + pi * ar; pr = qr; pi = qi; } }
    float cr = 0.f, ci = 0.f, xr = 0.f, xi = 0.f; const int lb = F.lane & ~7;
#pragma unroll
    for (int k = 0; k < 8; ++k) { const float kr = __shfl(tr, lb + k), ki = __shfl(ti, lb + k); if (k == seg) { cr = xr; ci = xi; } const float nr = pr * xr - pi * xi + kr, ni = pr * xi + pi * xr + ki; xr = nr; xi = ni; }
    float sr = cr, si = ci;
    for (int s0 = 0; s0 < 65; s0 += 5) { float er[5], ei[5]; int rows[5];
#pragma unroll
        for (int q = 0; q < 5; ++q) { const int row = S5ROW(seg * 65 + s0 + q); rows[q] = row; er[q] = E[(size_t)row * 256]; ei[q] = E[(size_t)row * 256 + 64]; }
#pragma unroll
        for (int q = 0; q < 5; ++q) { AG[(size_t)rows[q] * S5K] = f2bf(sr); AG[(size_t)rows[q] * S5K + 64] = f2bf(si); const float nr = ar * sr - ai * si + er[q], ni = ar * si + ai * sr + ei[q]; sr = nr; si = ni; } }
#undef S5ROW
}
__device__ __forceinline__ void dbg_thrash(Frame& F) {
    f32x4 a = {0.f, 0.f, 0.f, 0.f};
    for (int w = 36; w < 39; ++w) { const f32x4* src = (const f32x4*)inp(F, w);
        for (size_t i = (size_t)F.vcu * 512 + F.tid; i < (size_t)11534336; i += (size_t)F.G * 512) a += src[i]; }
    if (a[0] + a[1] + a[2] + a[3] == 1.2345e33f) WSP(float, WS_E)[0] = a[0];
}
#define PH_BEGIN if (lo <= ph && ph < hi) { { int t_ = threadIdx.x; asm volatile("" : "+v"(t_)); F.tid = t_; F.lane = t_ & 63; unsigned long long w_ = (unsigned long long)args.ws; asm volatile("" : "+s"(w_)); F.ws = (unsigned char*)(GAS unsigned char*)w_; } DBG_LDSCLR
#define PH_END   if (ph + 1 < hi) xcd_barrier(bar); } ++ph;
template <int l>
__device__ __forceinline__ void layer_body(Frame& F, const Args& args, XcdBarrier& bar, int& ph, const int lo, const int hi, LAS unsigned char* ring, const int c, unsigned* ctl) {
    const int bx = blockIdx.x;
        const bool need_ctx = l < DEPTH - 1, moe = (l & 1) && !DBG_NOMOE;
        const int pm0 = need_ctx ? 0 : 1, nM = need_ctx ? 65 : 64;
        const float* modl = WSP(float, WS_MOD) + ((size_t)l * 2 + 0) * 6144; const float* modc = WSP(float, WS_MOD) + ((size_t)l * 2 + 1) * 6144;
        PH_BEGIN LPH(1) {
#if DBG_THRASH == 3
        if (l == 1) {   } else
#endif
        { for (int ra_ = 0; ra_ < 1 + DBG_REPA; ++ra_) { convert_items(F, l, F.gw, CVT_NONFFN, F.NGW);
        s5_tables(F, l); __syncthreads(); } norm_phase<0>(F, l); } } PH_END
        PH_BEGIN LPH(2) { { pg8::SchedPlain S; S.T.init(65, 23, F.G, bx); S.A = WSP(bf16, WS_H); S.Bt = WSP(bf16, WS_WIN); S.lda = D; S.ldb = D; S.pm0 = 0;
            pg8::EpiWin E{WSP(bf16, WS_PA), WSP(bf16, WS_PN), WSP(bf16, WS_AG), WSP(bf16, WS_G)};
            pg8::gemm_phase(ring, D, D, D, S, E); } } PH_END
        PH_BEGIN LPH(3) {
        { pg8::SchedPlain S; S.T.init(65, 3, F.G, bx); S.A = WSP(bf16, WS_PA); S.Bt = WSP(bf16, WS_WUQ); S.lda = 768; S.ldb = 384; S.pm0 = 0;
          pg8::EpiBf16 E{WSP(bf16, WS_QRAW), 768}; pg8::gemm_phase(ring, 384, 768, 384, S, E); }
        { pg8::SchedPlain S; S.T.init(65, 4, F.G, (bx + 61) & 255); S.A = WSP(bf16, WS_PA) + 384; S.Bt = WSP(bf16, WS_WUKV); S.lda = 768; S.ldb = 256; S.pm0 = 0;
          pg8::EpiBf16 E{WSP(bf16, WS_KVRAW), 1024}; pg8::gemm_phase(ring, 256, 768, 256, S, E); }
        { pg8::SchedS5 S; S.nrt = 3; S.nct = 1; S.G = F.G; S.c = (c + 57) & 255; S.A = WSP(bf16, WS_AG); S.W = WSP(bf16, WS_WEND); S.brows = 256; S.ldb = 512;
          pg8::EpiS5E E{WSP(float, WS_E)}; pg8::gemm_phase(ring, 512, S5K, 512, S, E); }
        } PH_END
        PH_BEGIN LPH(4) { if (c >= F.G - 64) s5_carry(F, l, c - (F.G - 64)); else finalize_phase(F, l, c, F.G - 64); } PH_END
        PH_BEGIN LPH(5) {
        { pg8::SchedS5 S; S.nrt = need_ctx ? 3 : 2; S.nct = 2; S.G = F.G; S.c = c; S.A = WSP(bf16, WS_AG); S.W = WSP(bf16, WS_WY); S.brows = 512; S.ldb = 768;
          pg8::EpiS5Y E{WSP(bf16, WS_Z)}; pg8::gemm_phase(ring, S5K, S5K, 768, S, E); }
        if (need_ctx && c >= 192 && c < 208) { const int u = c - 192, h = u & 7;
            if (u < 8) att::attn_unit<96, false, true>(WSP(bf16, WS_QF) + (size_t)h * NT * 96, 96, (const bf16*)(WSP(unsigned char, WS_KF) + (size_t)h * (NT / 64) * 7168), 96, (const bf16*)(WSP(unsigned char, WS_VF) + (size_t)h * (NT / 64) * 4096), 64, WSP(bf16, WS_OA) + h * 64, 4, 0, 0, 0, nullptr, ring);
            else att::attn_unit<64, false>(WSP(bf16, WS_NQ) + (size_t)h * NT * 64, 64, WSP(bf16, WS_NK) + (size_t)h * NT * 64, 64, WSP(bf16, WS_PN) + 1024 + h * 64, 1536, WSP(bf16, WS_OB) + h * 64, 4, 0, 0, 0, nullptr, ring); }
        for (int i = 0; i < 2; ++i) { const int h = c >> 5, qb = (c & 31) + 32 * i;
            att::attn_unit<96, false, true>(WSP(bf16, WS_QF) + ((size_t)h * NT + NC + qb * 256) * 96, 96, (const bf16*)(WSP(unsigned char, WS_KF) + (size_t)h * (NT / 64) * 7168), 96, (const bf16*)(WSP(unsigned char, WS_VF) + (size_t)h * (NT / 64) * 4096), 64,
                                      WSP(bf16, WS_OA) + (size_t)(NC + qb * 256) * 512 + h * 64, NT / 64, 0, 0, 0, nullptr, ring); }
        for (int i = 0; i < 2; ++i) { const int h = c >> 5, qb = (c & 31) + 32 * i;
            const int glo = 4 * qb - 4 < 0 ? 0 : (4 * qb - 4 > 248 ? 248 : 4 * qb - 4), ghi0 = 4 * qb - 1 < 0 ? 0 : (4 * qb - 1 > 248 ? 248 : 4 * qb - 1), ghi = ghi0 + 7;
            const int ntl = 4 + (ghi - glo + 1), ntp = (ntl + 1) & ~1;
            att::attn_unit<64, true>(WSP(bf16, WS_NQ) + ((size_t)h * NT + NC + qb * 256) * 64, 64, WSP(bf16, WS_NK) + (size_t)h * NT * 64, 64, WSP(bf16, WS_PN) + 1024 + h * 64, 1536,
                                     WSP(bf16, WS_OB) + (size_t)(NC + qb * 256) * 512 + h * 64, ntp, glo, ghi, qb, inp(F, 17) + ((size_t)l * 8 + h) * 465, ring); }
        { volatile LAS unsigned* tk = (volatile LAS unsigned*)(F.lds + MISC_OFF) + 12; const int ntk = (moe ? NEXP : 1) * (CVT_FFN / 64);
          for (;;) { __syncthreads(); if (F.tid == 0) tk[0] = xb_add(ctl + CW_CVT + l * 64, 1u);
              __syncthreads(); const int t = __builtin_amdgcn_readfirstlane((int)tk[0]); if (t >= ntk) break;
              convert_items(F, l, CVT_NONFFN + t * 64 + F.wave, CVT_NONFFN + (t + 1) * 64, 8); } }
        } PH_END
        PH_BEGIN LPH(6) { { pg8::SchedPlain S; S.T.init(nM, 2, F.G, bx); S.A = WSP(bf16, WS_Z); S.Bt = WSP(bf16, WS_WGLU); S.lda = 512; S.ldb = 512; S.pm0 = pm0;
            pg8::EpiGlu E{WSP(bf16, WS_Z), WSP(bf16, WS_OC), inp(F, 27) + l * 512}; pg8::gemm_phase(ring, 512, 512, 512, S, E); } } PH_END
        PH_BEGIN LPH(7) { { pg8::SchedMerge S; S.T.init(64, 4, F.G, bx); S.O = WSP(bf16, WS_OA); S.W = WSP(bf16, WS_WBR); S.pm0 = 1;
            pg8::EpiMerge E{WSP(bf16, WS_G), WSP(bf16, WS_M1)}; pg8::gemm_phase(ring, 512, 512, 512, S, E); }
            if (need_ctx) { pg8::SchedCtxMerge S; S.G = F.G; S.c = (c + 96) & 255; S.O = WSP(bf16, WS_OA); S.W = WSP(bf16, WS_WBR);
            pg8::EpiMergeCtx E{WSP(bf16, WS_G), WSP(bf16, WS_M1C)}; pg8::gemm_phase(ring, 512, 512, 512, S, E); } } PH_END
        PH_BEGIN LPH(8) { { pg8::SchedPlain S; S.T.init(64, 4, F.G, bx); S.A = WSP(bf16, WS_M1); S.Bt = WSP(bf16, WS_WOUT); S.lda = D; S.ldb = D; S.pm0 = 1;
            pg8::EpiResid E{WSP(bf16, WS_XS), modl + 2 * D, modc + 2 * D}; pg8::gemm_phase(ring, D, D, D, S, E); }
            if (need_ctx) { pg8::SchedCtxK S; S.nsl = 12; S.nks = 4; S.G = F.G; S.c = (c + 96) & 255; S.A = WSP(bf16, WS_M1C); S.astride = (size_t)256 * 1024; S.Bt = WSP(bf16, WS_WOUT); S.lda = D; S.ldb = D;
            pg8::EpiResidPart E{WSP(float, WS_PART), modc + 2 * D}; pg8::gemm_phase(ring, 256, D, D, S, E); } } PH_END
        PH_BEGIN LPH(9) { norm_phase<1>(F, l); } PH_END
        if (!moe) {
            PH_BEGIN LPH(10) { { pg8::SchedPlain S; S.T.init(nM, 22, F.G, bx); S.A = WSP(bf16, WS_H); S.Bt = WSP(bf16, WS_WGU); S.lda = D; S.ldb = D; S.pm0 = pm0;
                pg8::EpiUp E{WSP(bf16, WS_ACT)}; pg8::gemm_phase(ring, D, D, D, S, E); } } PH_END
            PH_BEGIN LPH(11) { { pg8::SchedPlain S; S.T.init(64, 4, F.G, bx); S.A = WSP(bf16, WS_ACT); S.Bt = WSP(bf16, WS_WD); S.lda = FF; S.ldb = FF; S.pm0 = 1;
                pg8::EpiResid E{WSP(bf16, WS_XS), modl + 5 * D, modc + 5 * D}; pg8::gemm_phase(ring, FF, FF, FF, S, E); }
                if (need_ctx) { pg8::SchedCtxK S; S.nsl = 11; S.nks = 11; S.G = F.G; S.c = (c + 96) & 255; S.A = WSP(bf16, WS_ACT); S.astride = 0; S.Bt = WSP(bf16, WS_WD); S.lda = FF; S.ldb = FF;
                pg8::EpiResidPart E{WSP(float, WS_PART), modc + 5 * D}; pg8::gemm_phase(ring, 256, FF, FF, S, E); } } PH_END
        } else {
            PH_BEGIN LPH(12) { moe_scatter(F, l); } PH_END
            LAS int* tst = (LAS int*)(F.lds + RING_BYTES + 2048);
            PH_BEGIN LPH(13) { { int base[9]; moe_bases((const unsigned*)ctl + CW_CNT + (l >> 1) * 8 * 64, base); __syncthreads();
                if (F.tid < 160) { int e = 0;
#pragma unroll
                    for (int j = 1; j < 8; ++j) e += (F.tid >= (base[j] >> 8)) ? 1 : 0;
                    tst[F.tid] = e; } __syncthreads();
                pg8::SchedMoe S; S.T.init(base[8] >> 8, 22, F.G, bx); S.A = WSP(bf16, WS_HS); S.W = WSP(bf16, WS_WGU); S.lda = D; S.ldb = D; S.wstride = (size_t)FF2 * D; S.tstart = tst;
                pg8::EpiUp E{WSP(bf16, WS_ACT)}; pg8::gemm_phase(ring, D, D, D, S, E); } } PH_END
            PH_BEGIN LPH(14) { { int base[9]; moe_bases((const unsigned*)ctl + CW_CNT + (l >> 1) * 8 * 64, base); __syncthreads();
                if (F.tid < 160) { int e = 0;
#pragma unroll
                    for (int j = 1; j < 8; ++j) e += (F.tid >= (base[j] >> 8)) ? 1 : 0;
                    tst[F.tid] = e; } __syncthreads();
                pg8::SchedMoeDown S; S.T.init(base[8] >> 8, 8, F.G, bx); S.A = WSP(bf16, WS_ACT); S.W = WSP(bf16, WS_WD); S.tstart = tst;
                pg8::EpiMoeY E{WSP(bf16, WS_Y), WSP(bf16, WS_Y2)}; pg8::gemm_phase(ring, 1408, FF, FF, S, E); } } PH_END
        }
    }
__global__ void __launch_bounds__(512, 2) mega(Args args) {
    extern __shared__ __attribute__((aligned(16))) unsigned char lds_raw[];
    Frame F; F.lds = (LAS unsigned char*)lds_raw; F.ws = (unsigned char*)(GAS unsigned char*)(unsigned long long)args.ws; F.out = (float*)(GAS float*)(unsigned long long)args.out;
    F.tid = threadIdx.x; F.lane = F.tid & 63; F.wave = __builtin_amdgcn_readfirstlane(F.tid >> 6);
    F.G = gridDim.x; { const int bx = blockIdx.x; F.vcu = (F.G % 8 == 0) ? (bx % 8) * (F.G / 8) + bx / 8 : bx; }
    F.gw = F.vcu * 8 + F.wave; F.NGW = F.G * 8;
    volatile LAS unsigned* MISC = (volatile LAS unsigned*)(F.lds + MISC_OFF);
    for (int u = F.tid; u < (LDS_BYTES - RING_BYTES) / 4; u += 512) ((LAS unsigned*)(F.lds + RING_BYTES))[u] = 0u;
    __syncthreads();
    if (F.tid < 39) { const unsigned long long pv = (unsigned long long)args.in[F.tid]; LAS unsigned* t = (LAS unsigned*)(F.lds + INTAB_OFF) + 2 * F.tid; t[0] = (unsigned)pv; t[1] = (unsigned)(pv >> 32); }
    __syncthreads();
    unsigned* ctl = WSP(unsigned, WS_CTL);
    XcdBarrier bar; bar.bar = ctl + CW_BAR; bar.x = 0; bar.st = nullptr;
    if (ONE_LAUNCH) bar = xcd_barrier_post(ctl + CW_BAR, MISC + 8);
    int ph = 0; const int lo = args.ph_lo, hi = args.ph_hi;
    LAS unsigned char* ring = F.lds;
    const int c = F.vcu;

    PH_BEGIN
#if DBG_THRASH == 1
    dbg_thrash(F);
#endif
    prologue0(F); PH_END
    PH_BEGIN prologue1(F); PH_END

    layer_body<0>(F, args, bar, ph, lo, hi, ring, c, ctl);
    if (DBG_NLAYERS > 1) layer_body<1>(F, args, bar, ph, lo, hi, ring, c, ctl);
    if (DBG_NLAYERS > 2) layer_body<2>(F, args, bar, ph, lo, hi, ring, c, ctl);
    if (DBG_NLAYERS > 3) layer_body<3>(F, args, bar, ph, lo, hi, ring, c, ctl);
    for (int xb_ = 0; xb_ < DBG_XB; ++xb_) { PH_BEGIN PH_END }
    PH_BEGIN
#if DBG_THRASH == 2
    dbg_thrash(F); __syncthreads();
#endif
    final_out(F, DBG_NLAYERS - 1);
    if (ONE_LAUNCH && xb_ld(ctl + CW_BAR + XB_TMO) != 0u) {
        const float qn = __builtin_nanf(""); for (size_t i = (size_t)blockIdx.x * 512 + F.tid; i < (size_t)NL * D; i += (size_t)F.G * 512) F.out[i] = qn; }
    PH_END
}

static int count_phases() { int n = 2; for (int l = 0; l < DBG_NLAYERS; ++l) n += 9 + (((l & 1) && !DBG_NOMOE) ? 3 : 2); return n + 1 + DBG_XB; }
extern "C" void kernel_launch(void* const* d_in, const int* in_sizes, int n_in, void* d_out, int out_size, void* d_ws, size_t ws_size, hipStream_t stream) {
    static int grid = 0;
    if (grid == 0) {
        if (n_in != 39 || out_size != NL * D || ws_size < WS_END) { fprintf(stderr, "kernel_launch: unexpected shapes: n_in %d out %d ws %zu (need %zu)\n", n_in, out_size, ws_size, (size_t)WS_END); grid = -1; return; }
        int dev = 0, cus = 0, per_cu = 0;
        if (hipGetDevice(&dev) != hipSuccess || hipDeviceGetAttribute(&cus, hipDeviceAttributeMultiprocessorCount, dev) != hipSuccess) { grid = -1; return; }
        if (hipFuncSetAttribute((const void*)mega, hipFuncAttributeMaxDynamicSharedMemorySize, LDS_BYTES) != hipSuccess) { fprintf(stderr, "kernel_launch: hipFuncSetAttribute failed\n"); grid = -1; return; }
        if (hipOccupancyMaxActiveBlocksPerMultiprocessor(&per_cu, (const void*)mega, 512, LDS_BYTES) != hipSuccess || per_cu < 1) fprintf(stderr, "kernel_launch: occupancy query reports %d\n", per_cu);
        (void)hipGetLastError();
        grid = cus;
    }
    if (grid < 0) return;
    (void)hipMemsetAsync((char*)d_ws + WS_CTL, 0, CTL_BYTES, stream);
#ifdef DBG_MEMSET_LO
    (void)hipMemsetAsync((char*)d_ws + (size_t)DBG_MEMSET_LO * MiB, 0, (size_t)(DBG_MEMSET_HI - DBG_MEMSET_LO) * MiB, stream);
#endif
    Args a{};
    for (int i = 0; i < 39; ++i) a.in[i] = (const float*)d_in[i];
    a.out = (float*)d_out; a.ws = (unsigned char*)d_ws;
    const int nph = count_phases();
#if ONE_LAUNCH
    a.ph_lo = 0; a.ph_hi = nph;
    hipLaunchKernelGGL(mega, dim3(grid), dim3(512), LDS_BYTES, stream, a);
#else
    for (int p = 0; p < nph; ++p) { a.ph_lo = p; a.ph_hi = p + 1; hipLaunchKernelGGL(mega, dim3(grid), dim3(512), LDS_BYTES, stream, a); }
#endif
    const hipError_t le = hipPeekAtLastError();
    if (le != hipSuccess) fprintf(stderr, "kernel_launch: launch failed: %s\n", hipGetErrorName(le));
}
```

```cpp
#include <hip/hip_runtime.h>
#include <cstdio>
#include <cstdint>

#define DBG_REPA 0
#ifndef DBG_THRASH
#define DBG_THRASH 0
#endif
#ifdef DBG_LDSZERO
#define DBG_LDSCLR { for (int u_ = threadIdx.x; u_ < RING_BYTES / 16; u_ += 512) ((LAS u32x4*)F.lds)[u_] = (u32x4){0u, 0u, 0u, 0u}; __syncthreads(); }
#else
#define DBG_LDSCLR
#endif
#ifndef DBG_XB
#define DBG_XB 0
#endif
#ifndef DBG_SP
#define DBG_SP 99
#endif
#ifndef DBG_DUMP
#define DBG_DUMP 0
#endif
#ifndef DBG_REPMASK
#define DBG_REPMASK 0
#endif
#define LPH(k) for (int rep_ = 0; rep_ < 1 + ((DBG_REPMASK >> (k)) & 1); ++rep_)
#ifndef DBG_YSRC
#define DBG_YSRC WS_Y
#endif
#ifndef DBG_NOMOE
#define DBG_NOMOE 0
#endif
#ifndef DBG_NLAYERS
#define DBG_NLAYERS 4
#endif
#ifndef ONE_LAUNCH
#define ONE_LAUNCH 1
#endif

#define GAS __attribute__((address_space(1)))
#define LAS __attribute__((address_space(3)))
typedef unsigned short bf16;
typedef short bf16x8 __attribute__((ext_vector_type(8)));
typedef short s16x4 __attribute__((ext_vector_type(4)));
typedef float f32x4 __attribute__((ext_vector_type(4)));
typedef float f32x16 __attribute__((ext_vector_type(16)));
typedef unsigned u32x4 __attribute__((ext_vector_type(4)));
typedef unsigned u32x2 __attribute__((ext_vector_type(2)));
typedef int i32x8 __attribute__((ext_vector_type(8)));

constexpr int D = 1024, NL = 16384, NC = 256, NT = NL + NC, DEPTH = 4;
constexpr int DINP = 5888;
constexpr int FF = 2816, FF2 = 5632, NEXP = 8;
constexpr float EPS = 1e-6f;
constexpr int S5T = 32, S5ROWS = 768, S5K = 768;
constexpr int MOE_ROWS = 35328;

constexpr size_t MiB = 1u << 20;
constexpr size_t WS_CTL = 0, CTL_BYTES = 1 * MiB;
constexpr size_t WS_MOD = 1 * MiB;
constexpr size_t WS_ROPE = 2 * MiB;
constexpr size_t WS_S5P = 4 * MiB;
constexpr size_t WS_KTAB = 11 * MiB;
constexpr size_t WS_REC = 19 * MiB;
constexpr size_t WS_WIN = 20 * MiB;
constexpr size_t WS_WUQ = 32 * MiB;
constexpr size_t WS_WUKV = 33 * MiB;
constexpr size_t WS_WGLU = 34 * MiB;
constexpr size_t WS_WBR = 35 * MiB;
constexpr size_t WS_WOUT = 38 * MiB;
constexpr size_t WS_WGU = 40 * MiB;
constexpr size_t WS_WD = 128 * MiB;
constexpr size_t WS_WY = 172 * MiB;
constexpr size_t WS_WEND = 196 * MiB;
constexpr size_t WS_AG = 204 * MiB;
constexpr size_t WS_E = 240 * MiB;
constexpr size_t WS_Z = 264 * MiB;
constexpr size_t WS_M1 = 240 * MiB;
constexpr size_t WS_XS = 281 * MiB;
constexpr size_t WS_OA = 346 * MiB;
constexpr size_t WS_OB = WS_OA + (size_t)NT * 512 * 2;
constexpr size_t WS_OC = WS_OB + (size_t)NT * 512 * 2;
constexpr size_t WS_H = 346 * MiB;
constexpr size_t WS_R1 = 395 * MiB;
constexpr size_t WS_G = WS_R1;
constexpr size_t WS_PN = WS_G + (size_t)NT * 3072 * 2;
constexpr size_t WS_PA = WS_PN + (size_t)NT * 1536 * 2;
constexpr size_t WS_QRAW = WS_PA + (size_t)NT * 768 * 2;
constexpr size_t WS_KVRAW = WS_QRAW + (size_t)NT * 768 * 2;
constexpr size_t WS_ACT = WS_R1;
constexpr size_t WS_R2 = 623 * MiB;
constexpr size_t WS_QF = WS_R2;
constexpr size_t WS_KF = WS_QF + (size_t)8 * NT * 96 * 2;
constexpr size_t WS_VF = WS_KF + (size_t)8 * NT * 96 * 2;
constexpr size_t WS_NQ = WS_VF + (size_t)8 * NT * 64 * 2;
constexpr size_t WS_NK = WS_NQ + (size_t)8 * NT * 64 * 2;
constexpr size_t WS_HS = WS_R2;
constexpr size_t WS_Y = WS_HS + (size_t)MOE_ROWS * 1024 * 2;
constexpr size_t WS_PART = 762 * MiB;
constexpr size_t WS_Y2 = 774 * MiB;
constexpr size_t WS_M1C = 843 * MiB;
constexpr size_t WS_END = 845 * MiB;
static_assert(WS_KVRAW + (size_t)NT * 1024 * 2 <= WS_R2 && WS_ACT + (size_t)MOE_ROWS * 2816 * 2 <= WS_R2, "region 1");
static_assert(WS_NK + (size_t)8 * NT * 64 * 2 <= WS_END && WS_Y + (size_t)MOE_ROWS * 1024 * 2 <= WS_END, "region 2");
static_assert(WS_OC + (size_t)NT * 512 * 2 <= WS_R1 && WS_Z + (size_t)NT * 512 * 2 <= WS_XS && WS_M1 + (size_t)NT * 1024 * 2 <= WS_XS, "map");
constexpr int CW_BAR = 4096;
constexpr int CW_CNT = 16384;

constexpr int RING_BYTES = 131072, MISC_OFF = RING_BYTES + 320, LDS_BYTES = 147456;

#define LDS_WAIT() asm volatile("s_waitcnt lgkmcnt(0)" ::: "memory")
#define VM_WAIT() asm volatile("s_waitcnt vmcnt(0)" ::: "memory")
#define SBAR() __builtin_amdgcn_sched_barrier(0)
__device__ __forceinline__ unsigned cvtpk(float lo, float hi) { unsigned r; asm volatile("v_cvt_pk_bf16_f32 %0, %1, %2" : "=v"(r) : "v"(lo), "v"(hi)); return r; }
__device__ __forceinline__ float bflo(unsigned w) { return __uint_as_float(w << 16); }
__device__ __forceinline__ float bfhi(unsigned w) { return __uint_as_float(w & 0xffff0000u); }
__device__ __forceinline__ bf16 f2bf(float f) { return (bf16)(cvtpk(f, 0.f) & 0xffffu); }
__device__ __forceinline__ float bf2f(bf16 b) { return __uint_as_float(((unsigned)b) << 16); }
__device__ __forceinline__ void unpack8(const u32x4 w, float (&f)[8]) { f[0] = bflo(w.x); f[1] = bfhi(w.x); f[2] = bflo(w.y); f[3] = bfhi(w.y); f[4] = bflo(w.z); f[5] = bfhi(w.z); f[6] = bflo(w.w); f[7] = bfhi(w.w); }
__device__ __forceinline__ u32x4 pack8(const f32x4 a, const f32x4 b) { u32x4 w; w.x = cvtpk(a[0], a[1]); w.y = cvtpk(a[2], a[3]); w.z = cvtpk(b[0], b[1]); w.w = cvtpk(b[2], b[3]); return w; }
__device__ __forceinline__ f32x4 ld4bf(const bf16* p) { const u32x2 w = *(const u32x2*)p; return (f32x4){bflo(w.x), bfhi(w.x), bflo(w.y), bfhi(w.y)}; }
__device__ __forceinline__ void st4bf(bf16* p, const f32x4 v) { u32x2 w; w.x = cvtpk(v[0], v[1]); w.y = cvtpk(v[2], v[3]); *(u32x2*)p = w; }
__device__ __forceinline__ float fsigmoid(float x) { return __builtin_amdgcn_rcpf(1.f + __builtin_amdgcn_exp2f(-1.4426950408889634f * x)); }
__device__ __forceinline__ float fsilu(float x) { return x * fsigmoid(x); }
__device__ __forceinline__ float fgelu_tanh(float x) { return x * fsigmoid(1.5957691216057308f * (x + 0.044715f * x * x * x)); }
__device__ __forceinline__ float wave_sum(float v) {
#pragma unroll
    for (int o = 1; o < 64; o <<= 1) v += __shfl_xor(v, o);
    return v;
}
__device__ __forceinline__ void sincos_rad(float a, float& s, float& c) {
    float rev = a * 0.15915494309189535f; rev = rev - floorf(rev);
    s = __builtin_amdgcn_sinf(rev); c = __builtin_amdgcn_cosf(rev);
}

#define XB_TMO      128
#define XB_XCNT(j)  (256  + 64 * (j))
#define XB_XSUB(j)  (1280 + 64 * (j))
#define XB_XGEN(j)  (2304 + 64 * (j))
#define XB_TOP      3328
#define XB_TOPGEN   3392
#define XCD_BAR_WORDS 3456
#define XB_SPIN_CAP (1u << 22)

__device__ __forceinline__ unsigned xb_ld(unsigned* p)              { return __hip_atomic_load(p, __ATOMIC_RELAXED, __HIP_MEMORY_SCOPE_AGENT); }
__device__ __forceinline__ unsigned xb_add(unsigned* p, unsigned v) { return __hip_atomic_fetch_add(p, v, __ATOMIC_RELAXED, __HIP_MEMORY_SCOPE_AGENT); }
__device__ __forceinline__ unsigned xb_xcc_id() { return (unsigned)__builtin_amdgcn_s_getreg((3 << 11) | 20) & 0xFu; }
#define XB_SPIN(cond, bar) do { unsigned _sp = 0; while (cond) { __builtin_amdgcn_s_sleep(1); \
    if ((++_sp & 255u) == 0u) { if (xb_ld(&(bar)[XB_TMO])) break; if (_sp > XB_SPIN_CAP) { atomicAdd(&(bar)[XB_TMO], 1u); break; } } } } while (0)

struct XcdBarrier { unsigned* bar; unsigned x; volatile LAS unsigned* st; };
__device__ __forceinline__ XcdBarrier xcd_barrier_post(unsigned* bar, volatile LAS unsigned* st) {
    XcdBarrier b; b.bar = bar; b.x = xb_xcc_id(); b.st = st;
    if (threadIdx.x == 0) (void)xb_add(&bar[XB_XCNT(b.x)], 1u);
    return b;
}
__device__ __forceinline__ void xcd_barrier_complete(unsigned* bar, unsigned x, unsigned& nloc, unsigned& nx) {
    const unsigned G = gridDim.x * gridDim.y * gridDim.z;
    unsigned sum, cnt, mine, sp = 0u;
    for (;;) {
        sum = 0u; cnt = 0u; mine = 0u;
#pragma unroll
        for (unsigned j = 0; j < 16; ++j) { const unsigned c = xb_ld(&bar[XB_XCNT(j)]); sum += c; cnt += (c > 0u) ? 1u : 0u; mine = (j == x) ? c : mine; }
        if (sum == G) break;
        __builtin_amdgcn_s_sleep(1);
        if ((++sp & 255u) == 0u) { if (xb_ld(&bar[XB_TMO])) break; if (sp > XB_SPIN_CAP) { atomicAdd(&bar[XB_TMO], 1u); break; } }
    }
    nloc = mine > 0u ? mine : 1u; nx = cnt > 0u ? cnt : 1u;
}
__device__ __forceinline__ void xcd_barrier(const XcdBarrier& b) {
    asm volatile("s_waitcnt vmcnt(0)" ::: "memory");
    __syncthreads();
    if (threadIdx.x == 0) {
        unsigned* bar = b.bar;
        __builtin_amdgcn_s_waitcnt(0);
        unsigned nloc = b.st[0], nx = b.st[1];
        if (nloc == 0u) { xcd_barrier_complete(bar, b.x, nloc, nx); b.st[0] = nloc; b.st[1] = nx; }
        const unsigned old = xb_add(&bar[XB_XSUB(b.x)], 1u);
        const unsigned gen = old / nloc;
        if (old + 1u == (gen + 1u) * nloc) {
            __builtin_amdgcn_fence(__ATOMIC_RELEASE, "agent");
            asm volatile("s_waitcnt vmcnt(0)" ::: "memory");
            const unsigned og = xb_add(&bar[XB_TOP], 1u);
            const unsigned tg = og / nx;
            if (og + 1u == (tg + 1u) * nx) xb_add(&bar[XB_TOPGEN], 1u);
            else XB_SPIN(xb_ld(&bar[XB_TOPGEN]) == tg, bar);
            __builtin_amdgcn_fence(__ATOMIC_ACQUIRE, "agent");
            xb_add(&bar[XB_XGEN(b.x)], 1u);
            asm volatile("s_waitcnt vmcnt(0)" ::: "memory");
        } else {
            XB_SPIN(xb_ld(&bar[XB_XGEN(b.x)]) == gen, bar);
            __builtin_amdgcn_fence(__ATOMIC_ACQUIRE, "agent");
            asm volatile("s_waitcnt vmcnt(0)" ::: "memory");
        }
    }
    __syncthreads();
}

namespace pg8 {
constexpr int BM = 256, BK = 64, HALF = 128, HTB = HALF * BK * 2, NXCD = 8, WGM = 8;
__host__ __device__ __forceinline__ int lds_byte(int r, int c) { const int st = (r >> 4) * 2 + (c >> 5), rr = r & 15, cc = c & 31, ob = rr * 64 + cc * 2; return st * 1024 + (ob ^ (((ob >> 9) & 1) << 5)); }
__host__ __device__ __forceinline__ void stage_rc(int b, int& R, int& C) { const int st = b / 1024, sb = b % 1024, swz = sb ^ (((sb >> 9) & 1) << 5); R = (st >> 1) * 16 + swz / 64; C = (st & 1) * 32 + (swz % 64) / 2; }
__host__ __device__ __forceinline__ int perm32(int rho) { const int n = rho >> 4, i = rho & 15; return 8 * (i >> 2) + 4 * n + (i & 3); }
struct Unit { int pm, pn, aux; };

struct TileOrder {
    int nM, nN, nwg, G, c;
    __device__ __forceinline__ void init(int nM_, int nN_, int G_, int c_) { nM = nM_; nN = nN_; nwg = nM * nN; G = G_; c = c_; }
    __device__ __forceinline__ bool tile(int i, int& pm, int& pn) const {
        const long L = (long)i * G + c; if (L >= nwg) return false;
        int wgid = (int)L; { const int q = nwg / NXCD, r = nwg % NXCD, xcd = wgid % NXCD, off = wgid / NXCD; wgid = (xcd < r ? xcd * (q + 1) : r * (q + 1) + (xcd - r) * q) + off; }
        const int nig = WGM * nN, gid = wgid / nig, fm = gid * WGM, gsz = (nM - fm) < WGM ? (nM - fm) : WGM;
        pm = fm + ((wgid % nig) % gsz); pn = (wgid % nig) / gsz; return true;
    }
};

template <class Epi, class Sched>
__device__ __forceinline__ void gemm_phase(LAS unsigned char* lds, const int K, const int lda, const int ldb, const Sched& S, const Epi& E) {
    int tid_ = threadIdx.x; asm volatile("" : "+v"(tid_));
    const int tid = tid_, wid = __builtin_amdgcn_readfirstlane(tid >> 6), lane = tid & 63, wr = wid >> 2, wc = wid & 3, fr = lane & 15, fq = lane >> 4;
    const int nt = K / BK;
    unsigned voffA[2], voffB[2];
#pragma unroll
    for (int i = 0; i < 2; ++i) { int R, C; stage_rc(tid * 16 + i * 8192, R, C); const int Rb = (R & ~31) + perm32(R & 31);
        voffA[i] = (unsigned)(R * lda + C) * 2u; voffB[i] = (unsigned)(Rb * ldb + C) * 2u; }
    const size_t kstep = (size_t)(BK * 2);
    const size_t hstepA = (size_t)HALF * lda * 2, hstepB = (size_t)HALF * ldb * 2;
    const unsigned ldsw = (unsigned)wid * 1024u;
    const int aoff = lds_byte(wr * 64 + fr, fq * 8), boff = lds_byte(wc * 32 + fr, fq * 8);
#define PG8_SA(b, h) (((b) * 2 + (h)) * HTB)
#define PG8_SB(b, h) ((4 + (b) * 2 + (h)) * HTB)
#define PG8_STAGE(bufoff, gbase, voff) do { _Pragma("unroll") for (int _i = 0; _i < 2; ++_i) \
        __builtin_amdgcn_global_load_lds((const unsigned*)((const char*)(gbase) + (voff)[_i]), (LAS unsigned*)(lds + (bufoff) + ldsw + _i * 8192), 16, 0, 0); } while (0)
#define PG8_LDA(dst, b, h) do { _Pragma("unroll") for (int m = 0; m < 4; ++m) _Pragma("unroll") for (int k = 0; k < 2; ++k) dst[m][k] = *(const LAS bf16x8*)(lds + PG8_SA(b, h) + aoff + m * 2048 + k * 1024); } while (0)
#define PG8_LDB(dst, b, h) do { _Pragma("unroll") for (int n = 0; n < 2; ++n) _Pragma("unroll") for (int k = 0; k < 2; ++k) dst[n][k] = *(const LAS bf16x8*)(lds + PG8_SB(b, h) + boff + n * 2048 + k * 1024); } while (0)
#define PG8_MMA(ai, bj, At, Bt) do { __builtin_amdgcn_s_setprio(1); _Pragma("unroll") for (int m = 0; m < 4; ++m) _Pragma("unroll") for (int n = 0; n < 2; ++n) _Pragma("unroll") for (int k = 0; k < 2; ++k) \
        acc[ai][bj][m][n] = __builtin_amdgcn_mfma_f32_16x16x32_bf16(Bt[n][k], At[m][k], acc[ai][bj][m][n], 0, 0, 0); __builtin_amdgcn_s_setprio(0); } while (0)
#define PG8_WAIT_V(n) asm volatile("s_waitcnt vmcnt(" #n ")" ::: "memory")
#define PG8_WAIT_L(n) asm volatile("s_waitcnt lgkmcnt(" #n ")" ::: "memory")
#define PG8_BAR __builtin_amdgcn_s_barrier()
#define PG8_SCHED __builtin_amdgcn_sched_barrier(0)
    Unit cur, nxt; int ui = 0;
    if (!S.next(0, cur)) return;
    f32x4 acc[2][2][4][2];
#pragma unroll
    for (int a = 0; a < 2; ++a)
#pragma unroll
        for (int b = 0; b < 2; ++b)
#pragma unroll
            for (int m = 0; m < 4; ++m)
#pragma unroll
                for (int n = 0; n < 2; ++n) acc[a][b][m][n] = (f32x4){0.f, 0.f, 0.f, 0.f};
    bf16x8 At[4][2], B0[2][2], B1[2][2];
    const char* cA = S.abase(cur); const char* cB = S.bbase(cur);
    PG8_STAGE(PG8_SB(0, 0), cB, voffB); PG8_STAGE(PG8_SB(0, 1), cB + hstepB, voffB); PG8_STAGE(PG8_SA(0, 0), cA, voffA); PG8_STAGE(PG8_SA(0, 1), cA + hstepA, voffA);
    if (wr == 1) PG8_BAR;
    PG8_WAIT_V(2); PG8_BAR;
    PG8_STAGE(PG8_SB(1, 0), cB + kstep, voffB); PG8_STAGE(PG8_SA(1, 0), cA + kstep, voffA); PG8_STAGE(PG8_SB(1, 1), cB + hstepB + kstep, voffB);
    PG8_WAIT_V(6); PG8_BAR;
    for (;;) {
        const bool has_next = S.next(ui + 1, nxt);
        const char* nA = has_next ? S.abase(nxt) : cA; const char* nB = has_next ? S.bbase(nxt) : cB;
#pragma clang loop unroll(disable)
        for (int t = 0; t < nt; t += 2) {
            const bool last = (t == nt - 2);
            const char* a1 = cA + (size_t)(t + 1) * kstep;
            const char* a2 = last ? nA : cA + (size_t)(t + 2) * kstep; const char* b2 = last ? nB : cB + (size_t)(t + 2) * kstep;
            const char* a3 = a2 + kstep; const char* b3 = b2 + kstep;
            PG8_LDB(B0, 0, 0); PG8_LDB(B1, 0, 1); PG8_SCHED; PG8_LDA(At, 0, 0); PG8_STAGE(PG8_SA(1, 1), a1 + hstepA, voffA);
            PG8_WAIT_V(8); PG8_WAIT_L(0); PG8_BAR; PG8_MMA(0, 0, At, B0); PG8_MMA(0, 1, At, B1); PG8_BAR; PG8_SCHED;
            PG8_LDA(At, 0, 1); PG8_STAGE(PG8_SB(0, 0), b2, voffB); PG8_STAGE(PG8_SB(0, 1), b2 + hstepB, voffB); PG8_STAGE(PG8_SA(0, 0), a2, voffA);
            PG8_WAIT_V(8); PG8_WAIT_L(0); PG8_BAR; PG8_MMA(1, 0, At, B0); PG8_MMA(1, 1, At, B1); PG8_BAR; PG8_SCHED;
            PG8_LDB(B0, 1, 0); PG8_LDB(B1, 1, 1); PG8_SCHED; PG8_LDA(At, 1, 0); PG8_STAGE(PG8_SA(0, 1), a2 + hstepA, voffA);
            PG8_WAIT_V(8); PG8_WAIT_L(0); PG8_BAR; PG8_MMA(0, 0, At, B0); PG8_MMA(0, 1, At, B1); PG8_BAR; PG8_SCHED;
            PG8_LDA(At, 1, 1); PG8_STAGE(PG8_SB(1, 0), b3, voffB); PG8_STAGE(PG8_SB(1, 1), b3 + hstepB, voffB); PG8_STAGE(PG8_SA(1, 0), a3, voffA);
            PG8_WAIT_V(8); PG8_WAIT_L(0); PG8_BAR; PG8_MMA(1, 0, At, B0); PG8_MMA(1, 1, At, B1); PG8_BAR; PG8_SCHED;
        }
        if (wr == 0) PG8_BAR;
        E(acc, cur, wr, wc, fr, fq);
        if (!has_next) break;
#pragma unroll
        for (int a = 0; a < 2; ++a)
#pragma unroll
            for (int b = 0; b < 2; ++b)
#pragma unroll
                for (int m = 0; m < 4; ++m)
#pragma unroll
                    for (int n = 0; n < 2; ++n) acc[a][b][m][n] = (f32x4){0.f, 0.f, 0.f, 0.f};
        cur = nxt; cA = nA; cB = nB; ++ui;
        if (wr == 1) PG8_BAR;
    }
    PG8_WAIT_V(0);
    PG8_BAR;
#undef PG8_SA
#undef PG8_SB
#undef PG8_STAGE
#undef PG8_LDA
#undef PG8_LDB
#undef PG8_MMA
#undef PG8_WAIT_V
#undef PG8_WAIT_L
#undef PG8_BAR
#undef PG8_SCHED
}

struct SchedPlain {
    TileOrder T; const bf16* A; const bf16* Bt; int lda, ldb, pm0;
    __device__ __forceinline__ bool next(int i, Unit& u) const { int pm, pn; if (!T.tile(i, pm, pn)) return false; u.pm = pm + pm0; u.pn = pn; u.aux = 0; return true; }
    __device__ __forceinline__ const char* abase(const Unit& u) const { return (const char*)(A + (size_t)u.pm * 256 * lda); }
    __device__ __forceinline__ const char* bbase(const Unit& u) const { return (const char*)(Bt + (size_t)u.pn * 256 * ldb); }
};
struct SchedMerge {
    TileOrder T; const bf16* O; const bf16* W; int pm0;
    __device__ __forceinline__ bool next(int i, Unit& u) const { int pm, pn; if (!T.tile(i / 3, pm, pn)) return false; u.pm = pm + pm0; u.pn = pn; u.aux = i % 3; return true; }
    __device__ __forceinline__ const char* abase(const Unit& u) const { return (const char*)(O + ((size_t)u.aux * NT + (size_t)u.pm * 256) * 512); }
    __device__ __forceinline__ const char* bbase(const Unit& u) const { return (const char*)(W + ((size_t)u.aux * 1024 + (size_t)u.pn * 256) * 512); }
};
struct SchedS5 {
    int nrt, nct, G, c; const bf16* A; const bf16* W; int brows, ldb;
    __device__ __forceinline__ bool next(int i, Unit& u) const { const int L = i * G + c; if (L >= 32 * nrt * nct) return false; u.aux = L / (nrt * nct); const int r = L % (nrt * nct); u.pm = r / nct; u.pn = r % nct; return true; }
    __device__ __forceinline__ const char* abase(const Unit& u) const { return (const char*)(A + ((size_t)u.aux * S5ROWS + (size_t)u.pm * 256) * S5K); }
    __device__ __forceinline__ const char* bbase(const Unit& u) const { return (const char*)(W + ((size_t)u.aux * brows + (size_t)u.pn * 256) * ldb); }
};
struct SchedMoe {
    TileOrder T; const bf16* A; const bf16* W; int lda, ldb; size_t wstride; const LAS int* tstart;
    __device__ __forceinline__ bool next(int i, Unit& u) const { int pm, pn; if (!T.tile(i, pm, pn)) return false; u.pm = pm; u.pn = pn; u.aux = __builtin_amdgcn_readfirstlane(tstart[pm]); return true; }
    __device__ __forceinline__ const char* abase(const Unit& u) const { return (const char*)(A + (size_t)u.pm * 256 * lda); }
    __device__ __forceinline__ const char* bbase(const Unit& u) const { return (const char*)(W + (size_t)u.aux * wstride + (size_t)u.pn * 256 * ldb); }
};

#define EPI_ROWS(u) const int row0 = (u).pm * 256 + wr * 64 + fr; const int cw0 = wc * 32 + 8 * fq;
struct EpiWin {
    bf16 *pA, *pN, *AG, *Gt;
    __device__ __forceinline__ void operator()(const f32x4 (&acc)[2][2][4][2], const Unit& u, int wr, int wc, int fr, int fq) const {
        EPI_ROWS(u) const int pn = u.pn;
#pragma unroll
        for (int ai = 0; ai < 2; ++ai)
#pragma unroll
            for (int m = 0; m < 4; ++m) { const int row = row0 + ai * 128 + m * 16;
#pragma unroll
                for (int bj = 0; bj < 2; ++bj) { const int cw = cw0 + bj * 128; const f32x4 v0 = acc[ai][bj][m][0], v1 = acc[ai][bj][m][1];
                    if (pn < 3) *(u32x4*)(pA + (size_t)row * 768 + pn * 256 + cw) = pack8(v0, v1);
                    else if (pn < 9) *(u32x4*)(pN + (size_t)row * 1536 + (pn - 3) * 256 + cw) = pack8(v0, v1);
                    else if (pn < 11) { const int ucol = (pn - 9) * 256 + cw, g = ucol >> 4, c = ucol & 15;
                        const int tk = row < NC ? row : row - NC; const int cr = (row < NC ? 512 : 0) + (tk >> 5), j = tk & 31;
                        *(u32x4*)(AG + ((size_t)g * S5ROWS + cr) * S5K + j * 16 + c) = pack8(v0, v1); }
                    else { f32x4 s0, s1;
#pragma unroll
                        for (int q = 0; q < 4; ++q) { s0[q] = fsigmoid(v0[q]); s1[q] = fsigmoid(v1[q]); }
                        *(u32x4*)(Gt + (size_t)row * 3072 + (pn - 11) * 256 + cw) = pack8(s0, s1); } } }
    }
};
struct EpiBf16 {
    bf16* O; int ldc;
    __device__ __forceinline__ void operator()(const f32x4 (&acc)[2][2][4][2], const Unit& u, int wr, int wc, int fr, int fq) const {
        EPI_ROWS(u)
#pragma unroll
        for (int ai = 0; ai < 2; ++ai)
#pragma unroll
            for (int m = 0; m < 4; ++m) { const int row = row0 + ai * 128 + m * 16;
#pragma unroll
                for (int bj = 0; bj < 2; ++bj) *(u32x4*)(O + (size_t)row * ldc + u.pn * 256 + cw0 + bj * 128) = pack8(acc[ai][bj][m][0], acc[ai][bj][m][1]); }
    }
};
struct EpiS5E {
    float* Eo;
    __device__ __forceinline__ void operator()(const f32x4 (&acc)[2][2][4][2], const Unit& u, int wr, int wc, int fr, int fq) const {
        EPI_ROWS(u)
#pragma unroll
        for (int ai = 0; ai < 2; ++ai)
#pragma unroll
            for (int m = 0; m < 4; ++m) { const int row = row0 + ai * 128 + m * 16;
#pragma unroll
                for (int bj = 0; bj < 2; ++bj) { float* p = Eo + ((size_t)u.aux * S5ROWS + row) * 256 + cw0 + bj * 128; *(f32x4*)p = acc[ai][bj][m][0]; *(f32x4*)(p + 4) = acc[ai][bj][m][1]; } }
    }
};
struct EpiS5Y {
    bf16* Z;
    __device__ __forceinline__ void operator()(const f32x4 (&acc)[2][2][4][2], const Unit& u, int wr, int wc, int fr, int fq) const {
        EPI_ROWS(u)
#pragma unroll
        for (int ai = 0; ai < 2; ++ai)
#pragma unroll
            for (int m = 0; m < 4; ++m) { const int cr = row0 + ai * 128 + m * 16;
                if (cr < 520) {
#pragma unroll
                for (int bj = 0; bj < 2; ++bj) { const int n = u.pn * 256 + cw0 + bj * 128, t = n >> 4, c = n & 15;
                    const int tok = cr < 512 ? NC + cr * 32 + t : (cr - 512) * 32 + t; f32x4 a, b;
#pragma unroll
                    for (int q = 0; q < 4; ++q) { a[q] = fgelu_tanh(acc[ai][bj][m][0][q]); b[q] = fgelu_tanh(acc[ai][bj][m][1][q]); }
                    *(u32x4*)(Z + (size_t)tok * 512 + u.aux * 16 + c) = pack8(a, b); } } }
    }
};
struct EpiGlu {
    const bf16* Z; bf16* O; const float* bias;
    __device__ __forceinline__ void operator()(const f32x4 (&acc)[2][2][4][2], const Unit& u, int wr, int wc, int fr, int fq) const {
        EPI_ROWS(u)
#pragma unroll
        for (int bj = 0; bj < 2; ++bj) { const int col = u.pn * 256 + cw0 + bj * 128; const f32x4 b0 = *(const f32x4*)(bias + col), b1 = *(const f32x4*)(bias + col + 4);
#pragma unroll
            for (int ai = 0; ai < 2; ++ai)
#pragma unroll
                for (int m = 0; m < 4; ++m) { const int row = row0 + ai * 128 + m * 16; float z[8]; unpack8(*(const u32x4*)(Z + (size_t)row * 512 + col), z); f32x4 a, b;
#pragma unroll
                    for (int q = 0; q < 4; ++q) { a[q] = z[q] * fsigmoid(acc[ai][bj][m][0][q] + b0[q]); b[q] = z[4 + q] * fsigmoid(acc[ai][bj][m][1][q] + b1[q]); }
                    *(u32x4*)(O + (size_t)row * 512 + col) = pack8(a, b); } }
    }
};
struct EpiMerge {
    const bf16* Gt; bf16* M1;
    __device__ __forceinline__ void operator()(const f32x4 (&acc)[2][2][4][2], const Unit& u, int wr, int wc, int fr, int fq) const {
        EPI_ROWS(u) const int br = u.aux;
#pragma unroll
        for (int ai = 0; ai < 2; ++ai)
#pragma unroll
            for (int m = 0; m < 4; ++m) { const int row = row0 + ai * 128 + m * 16;
#pragma unroll
                for (int bj = 0; bj < 2; ++bj) { const int col = u.pn * 256 + cw0 + bj * 128; float g[8]; unpack8(*(const u32x4*)(Gt + (size_t)row * 3072 + br * 1024 + col), g);
                    f32x4 a, b;
#pragma unroll
                    for (int q = 0; q < 4; ++q) { a[q] = g[q] * acc[ai][bj][m][0][q]; b[q] = g[4 + q] * acc[ai][bj][m][1][q]; }
                    bf16* mp = M1 + (size_t)row * 1024 + col;
                    if (br) { float o[8]; unpack8(*(const u32x4*)mp, o);
#pragma unroll
                        for (int q = 0; q < 4; ++q) { a[q] += o[q]; b[q] += o[4 + q]; } }
                    *(u32x4*)mp = pack8(a, b); } }
    }
};
struct EpiResid {
    bf16* xs; const float* ga_l; const float* ga_c;
    __device__ __forceinline__ void operator()(const f32x4 (&acc)[2][2][4][2], const Unit& u, int wr, int wc, int fr, int fq) const {
        EPI_ROWS(u) const float* ga = u.pm == 0 ? ga_c : ga_l;
#pragma unroll
        for (int bj = 0; bj < 2; ++bj) { const int col = u.pn * 256 + cw0 + bj * 128; const f32x4 g0 = *(const f32x4*)(ga + col), g1 = *(const f32x4*)(ga + col + 4);
#pragma unroll
            for (int ai = 0; ai < 2; ++ai)
#pragma unroll
                for (int m = 0; m < 4; ++m) { const int row = row0 + ai * 128 + m * 16; bf16* p = xs + (size_t)row * 1024 + col;
                    float x[8]; unpack8(*(const u32x4*)p, x); const f32x4 x0 = {x[0], x[1], x[2], x[3]}, x1 = {x[4], x[5], x[6], x[7]};
                    *(u32x4*)p = pack8(x0 + g0 * acc[ai][bj][m][0], x1 + g1 * acc[ai][bj][m][1]); } }
    }
};
struct SchedMoeDown {
    TileOrder T; const bf16* A; const bf16* W; const LAS int* tstart;
    __device__ __forceinline__ bool next(int i, Unit& u) const { int pm, pn; if (!T.tile(i, pm, pn)) return false; u.pm = pm; u.pn = pn; u.aux = __builtin_amdgcn_readfirstlane(tstart[pm]); return true; }
    __device__ __forceinline__ const char* abase(const Unit& u) const { return (const char*)(A + (size_t)u.pm * 256 * FF + (u.pn >> 2) * 1408); }
    __device__ __forceinline__ const char* bbase(const Unit& u) const { return (const char*)(W + (size_t)u.aux * D * FF + (size_t)(u.pn & 3) * 256 * FF + (u.pn >> 2) * 1408); }
};
struct EpiMoeY {
    bf16* Y0; bf16* Y1;
    __device__ __forceinline__ void operator()(const f32x4 (&acc)[2][2][4][2], const Unit& u, int wr, int wc, int fr, int fq) const {
        EPI_ROWS(u) bf16* O = (u.pn >> 2) ? Y1 : Y0; const int colt = (u.pn & 3) * 256;
#pragma unroll
        for (int ai = 0; ai < 2; ++ai)
#pragma unroll
            for (int m = 0; m < 4; ++m) { const int row = row0 + ai * 128 + m * 16;
#pragma unroll
                for (int bj = 0; bj < 2; ++bj) *(u32x4*)(O + (size_t)row * D + colt + cw0 + bj * 128) = pack8(acc[ai][bj][m][0], acc[ai][bj][m][1]); }
    }
};
struct SchedCtxK {
    int nsl, nks, G, c; const bf16* A; size_t astride; const bf16* Bt; int lda, ldb;
    __device__ __forceinline__ bool next(int i, Unit& u) const { const int L = i * G + c; if (L >= 4 * nsl) return false; u.pm = 0; u.pn = L & 3; u.aux = L >> 2; return true; }
    __device__ __forceinline__ const char* abase(const Unit& u) const { return (const char*)(A + (size_t)(u.aux / nks) * astride + (size_t)(u.aux % nks) * 256); }
    __device__ __forceinline__ const char* bbase(const Unit& u) const { return (const char*)(Bt + (size_t)u.pn * 256 * ldb + (size_t)(u.aux % nks) * 256); }
};
struct SchedCtxMerge {
    int G, c; const bf16* O; const bf16* W;
    __device__ __forceinline__ bool next(int i, Unit& u) const { const int L = i * G + c; if (L >= 12) return false; u.pm = 0; u.pn = L & 3; u.aux = L >> 2; return true; }
    __device__ __forceinline__ const char* abase(const Unit& u) const { return (const char*)(O + (size_t)u.aux * NT * 512); }
    __device__ __forceinline__ const char* bbase(const Unit& u) const { return (const char*)(W + ((size_t)u.aux * 1024 + (size_t)u.pn * 256) * 512); }
};
struct EpiMergeCtx {
    const bf16* Gt; bf16* M1C;
    __device__ __forceinline__ void operator()(const f32x4 (&acc)[2][2][4][2], const Unit& u, int wr, int wc, int fr, int fq) const {
        EPI_ROWS(u) const int br = u.aux;
#pragma unroll
        for (int ai = 0; ai < 2; ++ai)
#pragma unroll
            for (int m = 0; m < 4; ++m) { const int row = row0 + ai * 128 + m * 16;
#pragma unroll
                for (int bj = 0; bj < 2; ++bj) { const int col = u.pn * 256 + cw0 + bj * 128; float g[8]; unpack8(*(const u32x4*)(Gt + (size_t)row * 3072 + br * 1024 + col), g);
                    f32x4 a, b;
#pragma unroll
                    for (int q = 0; q < 4; ++q) { a[q] = g[q] * acc[ai][bj][m][0][q]; b[q] = g[4 + q] * acc[ai][bj][m][1][q]; }
                    *(u32x4*)(M1C + ((size_t)br * 256 + row) * 1024 + col) = pack8(a, b); } }
    }
};
struct EpiResidPart {
    float* part; const float* ga;
    __device__ __forceinline__ void operator()(const f32x4 (&acc)[2][2][4][2], const Unit& u, int wr, int wc, int fr, int fq) const {
        EPI_ROWS(u)
#pragma unroll
        for (int bj = 0; bj < 2; ++bj) { const int col = u.pn * 256 + cw0 + bj * 128; const f32x4 g0 = *(const f32x4*)(ga + col), g1 = *(const f32x4*)(ga + col + 4);
#pragma unroll
            for (int ai = 0; ai < 2; ++ai)
#pragma unroll
                for (int m = 0; m < 4; ++m) { const int row = row0 + ai * 128 + m * 16; float* p = part + ((size_t)u.aux * 256 + row) * 1024 + col;
                    *(f32x4*)p = g0 * acc[ai][bj][m][0]; *(f32x4*)(p + 4) = g1 * acc[ai][bj][m][1]; } }
    }
};
struct EpiUp {
    bf16* Act;
    __device__ __forceinline__ void operator()(const f32x4 (&acc)[2][2][4][2], const Unit& u, int wr, int wc, int fr, int fq) const {
        EPI_ROWS(u)
#pragma unroll
        for (int ai = 0; ai < 2; ++ai)
#pragma unroll
            for (int m = 0; m < 4; ++m) { const int row = row0 + ai * 128 + m * 16; f32x4 a, b;
#pragma unroll
                for (int q = 0; q < 4; ++q) { a[q] = fsilu(acc[ai][0][m][0][q]) * acc[ai][1][m][0][q]; b[q] = fsilu(acc[ai][0][m][1][q]) * acc[ai][1][m][1][q]; }
                *(u32x4*)(Act + (size_t)row * FF + u.pn * 128 + cw0) = pack8(a, b); }
    }
};
}

namespace att {
constexpr float THR = 8.f;
__device__ __forceinline__ int crow(int r, int hi) { return (r & 3) + 8 * (r >> 2) + 4 * hi; }
template <int DQK> struct Cst { static constexpr float SCALE = DQK == 96 ? 0.10206207261596575f : 0.125f; static constexpr float C = SCALE * 1.4426950408889634f; };

__device__ __forceinline__ void partialSM(f32x16& p0) {
#pragma unroll
    for (int r = 0; r < 16; ++r) p0[r] = __builtin_amdgcn_exp2f(p0[r]);
}
__device__ __forceinline__ void finishSM(f32x16& p0, f32x16& p1, float& l_reg, bf16x8& pa0, bf16x8& pa1, bf16x8& pa2, bf16x8& pa3) {
#pragma unroll
    for (int r = 0; r < 16; ++r) p1[r] = __builtin_amdgcn_exp2f(p1[r]);
    float ps = 0;
#pragma unroll
    for (int r = 0; r < 16; ++r) ps += p0[r];
#pragma unroll
    for (int r = 0; r < 16; ++r) ps += p1[r];
    { auto rr = __builtin_amdgcn_permlane32_swap(__float_as_uint(ps), __float_as_uint(ps), false, false);
      ps = __uint_as_float(rr[0]) + __uint_as_float(rr[1]); }
    l_reg += ps;
#define PK4(P, BASE, OUT) do { unsigned a0 = cvtpk(P[BASE + 0], P[BASE + 1]), a1 = cvtpk(P[BASE + 2], P[BASE + 3]);   \
    unsigned b0 = cvtpk(P[BASE + 4], P[BASE + 5]), b1 = cvtpk(P[BASE + 6], P[BASE + 7]);                              \
    auto r0 = __builtin_amdgcn_permlane32_swap(a0, b0, false, false); auto r1 = __builtin_amdgcn_permlane32_swap(a1, b1, false, false); \
    u32x4 w = {r0[0], r1[0], r0[1], r1[1]}; OUT = *reinterpret_cast<bf16x8*>(&w); } while (0)
    PK4(p0, 0, pa0); PK4(p0, 8, pa1); PK4(p1, 0, pa2); PK4(p1, 8, pa3);
#undef PK4
}
__device__ __forceinline__ int v_st(int k, int c) { const int kk = (k & ~0xC) | ((k & 4) << 1) | ((k & 8) >> 1); return ((kk >> 3) * 2 + (c >> 5)) * 512 + ((kk & 7) * 32 + (c & 31)) * 2; }
__device__ __forceinline__ int v_rd_base(int lane) { return ((lane & 3) << 3) | (((lane >> 2) & 3) << 6) | (((lane >> 4) & 1) << 5) | (((lane >> 5) & 1) << 8); }
constexpr int v_rd_off(int d0, int ks, int half) { return d0 * 512 + ks * 2048 + half * 1024; }
template <int OFF> __device__ __forceinline__ s16x4 tr_read(int vb) {
    s16x4 r; asm volatile("ds_read_b64_tr_b16 %0, %1 offset:%2" : "=&v"(r) : "v"(vb), "i"(OFF) : "memory"); return r;
}
template <int D0> __device__ __forceinline__ void pv_one(f32x16& od, int vb, bf16x8 pa0, bf16x8 pa1, bf16x8 pa2, bf16x8 pa3) {
    const s16x4 l0 = tr_read<v_rd_off(D0, 0, 0)>(vb), h0 = tr_read<v_rd_off(D0, 0, 1)>(vb), l1 = tr_read<v_rd_off(D0, 1, 0)>(vb), h1 = tr_read<v_rd_off(D0, 1, 1)>(vb);
    const s16x4 l2 = tr_read<v_rd_off(D0, 2, 0)>(vb), h2 = tr_read<v_rd_off(D0, 2, 1)>(vb), l3 = tr_read<v_rd_off(D0, 3, 0)>(vb), h3 = tr_read<v_rd_off(D0, 3, 1)>(vb);
    asm volatile("s_waitcnt lgkmcnt(0)" ::: "memory"); SBAR();
#define PK(L, H) (bf16x8){L[0], L[1], L[2], L[3], H[0], H[1], H[2], H[3]}
    od = __builtin_amdgcn_mfma_f32_32x32x16_bf16(pa0, PK(l0, h0), od, 0, 0, 0);
    od = __builtin_amdgcn_mfma_f32_32x32x16_bf16(pa1, PK(l1, h1), od, 0, 0, 0);
    od = __builtin_amdgcn_mfma_f32_32x32x16_bf16(pa2, PK(l2, h2), od, 0, 0, 0);
    od = __builtin_amdgcn_mfma_f32_32x32x16_bf16(pa3, PK(l3, h3), od, 0, 0, 0);
#undef PK
}

constexpr float V8_OFF = -3.0f;
__device__ __forceinline__ int v8_pos(int k) { const int kb = k >> 5, kk = k & 31; return 32 * ((kk >> 2) & 1) + 16 * kb + 4 * (kk >> 3) + (kk & 3); }
__device__ __forceinline__ int v8_byte(int dim, int pos) { return dim * 64 + ((((pos >> 4) ^ (dim >> 2)) & 3) << 4) + (pos & 15); }
__device__ __forceinline__ void finishSM8(f32x16& p0, f32x16& p1, i32x8& pk) {
#pragma unroll
    for (int r = 0; r < 16; ++r) p1[r] = __builtin_amdgcn_exp2f(p1[r]);
#pragma unroll
    for (int w = 0; w < 4; ++w) { int a = __builtin_amdgcn_cvt_pk_fp8_f32(p0[4 * w], p0[4 * w + 1], 0, false); pk[w] = __builtin_amdgcn_cvt_pk_fp8_f32(p0[4 * w + 2], p0[4 * w + 3], a, true);
                                  int b = __builtin_amdgcn_cvt_pk_fp8_f32(p1[4 * w], p1[4 * w + 1], 0, false); pk[4 + w] = __builtin_amdgcn_cvt_pk_fp8_f32(p1[4 * w + 2], p1[4 * w + 3], b, true); }
}
__device__ __forceinline__ i32x8 ld32(const LAS unsigned char* p) { const u32x4 lo = *(const LAS u32x4*)p, hi4 = *(const LAS u32x4*)(p + 16);
    return (i32x8){(int)lo[0], (int)lo[1], (int)lo[2], (int)lo[3], (int)hi4[0], (int)hi4[1], (int)hi4[2], (int)hi4[3]}; }
__device__ __forceinline__ void pv8_sum(f32x16& os, const i32x8 pk) {
    const i32x8 ones = {0x38383838, 0x38383838, 0x38383838, 0x38383838, 0x38383838, 0x38383838, 0x38383838, 0x38383838};
    os = __builtin_amdgcn_mfma_scale_f32_32x32x64_f8f6f4(pk, ones, os, 0, 0, 0, 0x7F7F7F7F, 0, 0x7F7F7F7F);
}
template <int D0> __device__ __forceinline__ void pv8_one(f32x16& od, const LAS unsigned char* vt, int r32, int hi, const i32x8 pk) {
    const LAS unsigned char* row = vt + (32 * D0 + r32) * 64; const int sw = (r32 >> 2) & 3;
    const u32x4 lo = *(const LAS u32x4*)(row + (((2 * hi) ^ sw) << 4)), hi4 = *(const LAS u32x4*)(row + (((2 * hi + 1) ^ sw) << 4));
    const i32x8 vb = {(int)lo[0], (int)lo[1], (int)lo[2], (int)lo[3], (int)hi4[0], (int)hi4[1], (int)hi4[2], (int)hi4[3]};
    od = __builtin_amdgcn_mfma_scale_f32_32x32x64_f8f6f4(pk, vb, od, 0, 0, 0, 0x7F7F7F7F, 0, 0x7F7F7F7F);
}

template <int DQK, bool NA, bool V8 = false>
__device__ __forceinline__ void attn_unit(const bf16* __restrict__ Qb, const int ldq, const bf16* __restrict__ Kh, const int ldk, const bf16* __restrict__ Vh, const int ldv,
                                          bf16* __restrict__ Ob, const int NT_, const int gr_lo, const int gr_hi, const int qb, const float* __restrict__ rpb, LAS unsigned char* lds) {
    constexpr int ND = DQK / 16, KST = DQK * 2 + 16, KCH = DQK / 8, SHK = 64 * KST, SHV = 64 * 64 * 2;
    constexpr float SCALE = Cst<DQK>::SCALE;
    int tid_ = threadIdx.x; asm volatile("" : "+v"(tid_));
    const int tid = tid_, wid = __builtin_amdgcn_readfirstlane(tid >> 6), lane = tid & 63, r32 = lane & 31, hi = lane >> 5;
    constexpr int NSLOT = V8 ? 4 : 2;
    LAS unsigned char* K_lds = lds; LAS unsigned char* V_lds = lds + NSLOT * SHK;
    LAS float* wsf = (LAS float*)(lds + NSLOT * SHK + NSLOT * SHV) + wid * 64; LAS float* li_l = wsf;
    LAS float* btab = (LAS float*)(lds + NSLOT * SHK + NSLOT * SHV + 2048 + 256);
    float l_reg = 0.f; f32x16 o[2] = {}, osum = {}; bf16x8 qr[ND]; i32x8 q8[2];
    if constexpr (V8) {
        const bf16* Qw = Qb + (size_t)(wid * 32 + r32) * ldq;
#pragma unroll
        for (int m = 0; m < 2; ++m)
#pragma unroll
            for (int c = 0; c < 4; ++c) { float f[8]; unpack8(*(const u32x4*)(Qw + (m == 0 ? 32 * hi : 64) + c * 8), f);
                const int w0 = __builtin_amdgcn_cvt_pk_fp8_f32(f[2], f[3], __builtin_amdgcn_cvt_pk_fp8_f32(f[0], f[1], 0, false), true), w1 = __builtin_amdgcn_cvt_pk_fp8_f32(f[6], f[7], __builtin_amdgcn_cvt_pk_fp8_f32(f[4], f[5], 0, false), true);
                q8[m][2 * c] = (m == 1 && hi) ? 0 : w0; q8[m][2 * c + 1] = (m == 1 && hi) ? 0 : w1; }
    } else { const bf16* Qw = Qb + (size_t)(wid * 32 + r32) * ldq + hi * 8;
#pragma unroll
      for (int d0 = 0; d0 < ND; ++d0) qr[d0] = *(const bf16x8*)(Qw + d0 * 16); }
    const int kc8 = tid < 448 ? tid : tid - 64;
    const int ka0 = r32 * 112 + 32 * hi, ka1 = hi ? 7168 : r32 * 112 + 64, ka1b = hi ? 7168 : (32 + r32) * 112 + 64;
    if constexpr (V8) { if (tid < 8) { *(LAS u32x4*)(lds + (tid >> 1) * SHK + 7168 + (tid & 1) * 16) = (u32x4){0u, 0u, 0u, 0u}; } }
    const int id0 = tid, rk0 = id0 / KCH, ck0 = id0 % KCH;
    const int id1 = 512 + (tid & 255), rk1 = id1 / KCH, ck1 = id1 % KCH;
    const int rv = tid >> 3, cv = tid & 7;
    const int kst0 = rk0 * KST + ck0 * 16, kst1 = rk1 * KST + ck1 * 16, vst = v_st(rv, cv * 8);
    const int vb0 = (int)(uintptr_t)V_lds + v_rd_base(lane);
    struct { bf16x8 k0, k1, v; u32x2 v8; } sr_[2];
    const int rqw = 4 * qb + (wid >> 1), cq = 32 * (wid & 1) + r32;
    const int r0w = rqw - 4 < 0 ? 0 : (rqw - 4 > 248 ? 248 : rqw - 4);
    const int c0 = cq - 8 < 0 ? 0 : (cq - 8 > 48 ? 48 : cq - 8);
    if constexpr (NA) { for (int i = tid; i < 465; i += 512) btab[i] = rpb[i] * 1.4426950408889634f; }
#define KB_OF(j) (NA ? ((j) < 4 ? 64 * (j) : NC + 64 * (gr_lo + (j) - 4 > gr_hi ? gr_hi : gr_lo + (j) - 4)) : 64 * (j))
#define SLOAD(i, j) do { const int kb_ = KB_OF(j); if constexpr (V8) sr_[i].k0 = *(const bf16x8*)((const unsigned char*)Kh + (size_t)(kb_ >> 6) * 7168 + kc8 * 16); else { sr_[i].k0 = *(const bf16x8*)(Kh + (size_t)(kb_ + rk0) * ldk + ck0 * 8); \
        if constexpr (DQK == 96) sr_[i].k1 = *(const bf16x8*)(Kh + (size_t)(kb_ + rk1) * ldk + ck1 * 8); } \
        if constexpr (V8) sr_[i].v8 = *(const u32x2*)((const unsigned char*)Vh + (size_t)(kb_ >> 6) * 4096 + tid * 8); else sr_[i].v = *(const bf16x8*)(Vh + (size_t)(kb_ + rv) * ldv + cv * 8); } while (0)
#define SWRITE(b, i) do { if constexpr (V8) *(LAS bf16x8*)(K_lds + (b) * SHK + kc8 * 16) = sr_[i].k0; else { *(LAS bf16x8*)(K_lds + (b) * SHK + kst0) = sr_[i].k0; if constexpr (DQK == 96) *(LAS bf16x8*)(K_lds + (b) * SHK + kst1) = sr_[i].k1; } \
        if constexpr (V8) *(LAS u32x2*)(V_lds + (b) * SHV + tid * 8) = sr_[i].v8; else *(LAS bf16x8*)(V_lds + (b) * SHV + vst) = sr_[i].v; } while (0)
#define SWAIT() do { if constexpr (DQK == 96 && !V8) asm volatile("s_waitcnt vmcnt(3)" ::: "memory"); else asm volatile("s_waitcnt vmcnt(2)" ::: "memory"); } while (0)
#define QKT(P0, P1, V, b, j) do { V = true; int gk_ = 0; if constexpr (NA) { if ((j) >= 4) { gk_ = gr_lo + (j) - 4; V = (gk_ <= gr_hi) && (gk_ >= r0w) && (gk_ <= r0w + 7); } } \
        if (V) { if constexpr (V8) { _Pragma("unroll") for (int r_ = 0; r_ < 16; ++r_) { P0[r_] = V8_OFF; P1[r_] = V8_OFF; } } else { P0 = f32x16{}; P1 = f32x16{}; } const LAS unsigned char* Ks_ = K_lds + (b) * SHK; \
            if constexpr (V8) { const i32x8 a00 = ld32(Ks_ + ka0), a01 = ld32(Ks_ + ka1), a10 = ld32(Ks_ + 3584 + ka0), a11 = ld32(Ks_ + ka1b); \
                P0 = __builtin_amdgcn_mfma_scale_f32_32x32x64_f8f6f4(a00, q8[0], P0, 0, 0, 0, 0x7F7F7F7F, 0, 0x7F7F7F7F); P1 = __builtin_amdgcn_mfma_scale_f32_32x32x64_f8f6f4(a10, q8[0], P1, 0, 0, 0, 0x7F7F7F7F, 0, 0x7F7F7F7F); \
                P0 = __builtin_amdgcn_mfma_scale_f32_32x32x64_f8f6f4(a01, q8[1], P0, 0, 0, 0, 0x7F7F7F7F, 0, 0x7F7F7F7F); P1 = __builtin_amdgcn_mfma_scale_f32_32x32x64_f8f6f4(a11, q8[1], P1, 0, 0, 0, 0x7F7F7F7F, 0, 0x7F7F7F7F); } else \
            _Pragma("unroll") for (int d0 = 0; d0 < ND; ++d0) { const int cb = (d0 * 16 + hi * 8) * 2; \
                const bf16x8 b0 = *(const LAS bf16x8*)(Ks_ + r32 * KST + cb); const bf16x8 b1 = *(const LAS bf16x8*)(Ks_ + (32 + r32) * KST + cb); \
                P0 = __builtin_amdgcn_mfma_f32_32x32x16_bf16(b0, qr[d0], P0, 0, 0, 0); P1 = __builtin_amdgcn_mfma_f32_32x32x16_bf16(b1, qr[d0], P1, 0, 0, 0); } \
            if constexpr (NA) { if ((j) >= 4) { const LAS float* bb_ = btab + (gk_ - rqw + 7) * 31 + (15 - cq) + 4 * hi; \
                _Pragma("unroll") for (int r = 0; r < 16; ++r) { const int ckc = (r & 3) + 8 * (r >> 2); const int ck = ckc + 4 * hi; \
                    P0[r] = (ck >= c0 && ck <= c0 + 15) ? P0[r] + bb_[ckc] : -1e30f; P1[r] = (ck + 32 >= c0 && ck + 32 <= c0 + 15) ? P1[r] + bb_[ckc + 32] : -1e30f; } } } } } while (0)
#define PSM(P0, V) do { if (V) partialSM(P0); } while (0)
#define FSM(P0, P1) do { if constexpr (V8) finishSM8(P0, P1, pk8); else finishSM(P0, P1, l_reg, pa0, pa1, pa2, pa3); } while (0)
#define PV(vbuf) do { if constexpr (V8) { pv8_one<0>(o[0], V_lds + (vbuf) * SHV, r32, hi, pk8); pv8_one<1>(o[1], V_lds + (vbuf) * SHV, r32, hi, pk8); pv8_sum(osum, pk8); } \
        else { pv_one<0>(o[0], vb0 + (vbuf) * SHV, pa0, pa1, pa2, pa3); pv_one<1>(o[1], vb0 + (vbuf) * SHV, pa0, pa1, pa2, pa3); } } while (0)
#define FSM_PV(P0, P1, V, vbuf) do { if (V) { FSM(P0, P1); SBAR(); PV(vbuf); } } while (0)
    f32x16 pA0, pA1, pB0, pB1; bf16x8 pa0, pa1, pa2, pa3; i32x8 pk8; bool vA, vB; const int NTl = NT_;
    if constexpr (V8) {
        const int NP = NTl >> 1;
        SLOAD(0, 0); SLOAD(1, 1); VM_WAIT(); SWRITE(0, 0); SWRITE(1, 1); __syncthreads();
#define PAIR(sb, nb, pp) do { const int jn_ = ((pp) + 1 < NP ? (pp) + 1 : (pp)) * 2; SLOAD(0, jn_); SLOAD(1, jn_ + 1); SBAR(); \
            QKT(pA0, pA1, vA, sb, 0); PSM(pA0, vA); SBAR(); \
            QKT(pB0, pB1, vB, (sb) + 1, 0); FSM(pA0, pA1); SBAR(); \
            PV(sb); PSM(pB0, vB); SBAR(); \
            FSM(pB0, pB1); SBAR(); PV((sb) + 1); \
            asm volatile("s_waitcnt vmcnt(0)" ::: "memory"); SWRITE(nb, 0); SWRITE((nb) + 1, 1); __syncthreads(); } while (0)
        for (int p = 0; p < NP; p += 2) { PAIR(0, 2, p); PAIR(2, 0, p + 1); }
#undef PAIR
    } else {
    SLOAD(0, 0); VM_WAIT(); SWRITE(0, 0); __syncthreads();
    QKT(pA0, pA1, vA, 0, 0); PSM(pA0, vA);
    SLOAD(1, 1); SLOAD(0, (2 < NTl ? 2 : NTl - 1));
    SWAIT(); SWRITE(1, 1); __syncthreads();
    for (int j = 1; j + 1 < NTl; j += 2) {
        SBAR(); QKT(pB0, pB1, vB, 1, j);
        if (vA) { FSM(pA0, pA1); } SBAR();
        SLOAD(1, j + 2); SBAR();
        if (vA) { PV(0); }
        PSM(pB0, vB);
        __syncthreads(); SWAIT(); SWRITE(0, 0);
        __syncthreads();
        SBAR(); QKT(pA0, pA1, vA, 0, j + 1);
        if (vB) { FSM(pB0, pB1); } SBAR();
        SLOAD(0, (j + 3 < NTl ? j + 3 : NTl - 1)); SBAR();
        if (vB) { PV(1); }
        PSM(pA0, vA);
        __syncthreads(); SWAIT(); SWRITE(1, 1);
        __syncthreads();
    }
    SBAR(); QKT(pB0, pB1, vB, 1, NTl - 1);
    FSM_PV(pA0, pA1, vA, 0); PSM(pB0, vB);
    FSM_PV(pB0, pB1, vB, 1);
    }
    if constexpr (!V8) { if (hi == 0) li_l[r32] = l_reg; asm volatile("s_waitcnt lgkmcnt(0)" ::: "memory"); }
    bf16* Ow = Ob + (size_t)(wid * 32) * 512;
#pragma unroll
    for (int r = 0; r < 16; ++r) { const int orow = crow(r, hi); float rl; if constexpr (V8) rl = __builtin_amdgcn_rcpf(osum[r]); else rl = __builtin_amdgcn_rcpf(li_l[orow]);
#pragma unroll
        for (int d0 = 0; d0 < 2; ++d0) Ow[(size_t)orow * 512 + d0 * 32 + r32] = f2bf(o[d0][r] * rl); }
    __syncthreads();
#undef KB_OF
#undef SLOAD
#undef SWRITE
#undef SWAIT
#undef QKT
#undef PSM
#undef FSM_PV
#undef FSM
#undef PV
}
}

struct Args { const float* in[39]; float* out; unsigned char* ws; int ph_lo, ph_hi; };
struct Frame {
    LAS unsigned char* lds; unsigned char* ws; float* out;
    int tid, lane, wave, vcu, G, gw, NGW;
};
#define WSP(T, off) ((T*)(F.ws + (off)))
constexpr int INTAB_OFF = RING_BYTES + 1024;
__device__ __forceinline__ const float* inp(const Frame& F, int i) {
    const LAS unsigned* t = (const LAS unsigned*)(F.lds + INTAB_OFF) + 2 * i;
    const unsigned lo = __builtin_amdgcn_readfirstlane(t[0]), hi = __builtin_amdgcn_readfirstlane(t[1]);
    return (const float*)(const GAS float*)(((unsigned long long)hi << 32) | lo);
}

struct CvtItem { const float* src; bf16* dst; const float* kscale; int ldw, ldt, k0; bool zero; };
__device__ __forceinline__ void cvt_load(const CvtItem& d, f32x4 (&v)[8], int lane) {
#pragma unroll
    for (int i = 0; i < 8; ++i) { const int kk = 8 * i + (lane >> 3), n4 = (lane & 7) * 4; v[i] = d.zero ? (f32x4){0.f, 0.f, 0.f, 0.f} : __builtin_nontemporal_load((const f32x4*)(d.src + (size_t)kk * d.ldw + n4)); }
}
__device__ __forceinline__ void cvt_store(const CvtItem& d, f32x4 (&v)[8], LAS float* scr, int lane) {
#pragma unroll
    for (int i = 0; i < 8; ++i) { const int kk = 8 * i + (lane >> 3), n4 = (lane & 7) * 4; f32x4 x = v[i]; if (d.kscale) x *= d.kscale[d.k0 + kk];
        scr[kk * 33 + n4] = x[0]; scr[kk * 33 + n4 + 1] = x[1]; scr[kk * 33 + n4 + 2] = x[2]; scr[kk * 33 + n4 + 3] = x[3]; }
    LDS_WAIT(); asm volatile("" ::: "memory");
    const int c = lane & 7;
#pragma unroll
    for (int j = 0; j < 4; ++j) { const int n = (lane >> 3) + 8 * j; const LAS float* s = scr + (8 * c) * 33 + n;
        u32x4 o; o.x = cvtpk(s[0 * 33], s[1 * 33]); o.y = cvtpk(s[2 * 33], s[3 * 33]); o.z = cvtpk(s[4 * 33], s[5 * 33]); o.w = cvtpk(s[6 * 33], s[7 * 33]);
        *(u32x4*)(d.dst + (size_t)n * d.ldt + 8 * c) = o; }
    LDS_WAIT(); asm volatile("" ::: "memory");
}
__device__ __forceinline__ CvtItem cvt_decode(Frame& F, int l, int it) {
#ifdef DBG_CONV8
    const int j = 0; const bool moe = (l & 1);
#else
    const int j = l >> 1; const bool moe = (l & 1) && !DBG_NOMOE;
#endif
    constexpr int I_WIN = (DINP / 32) * (D / 64), I_UQ = (768 / 32) * (384 / 64), I_UKV = (1024 / 32) * (256 / 64), I_GLU = (512 / 32) * (512 / 64), I_BR = (1024 / 32) * (512 / 64), I_OUT = (1024 / 32) * (1024 / 64);
    constexpr int I_GU = (FF2 / 32) * (D / 64), I_DN = (1024 / 32) * (FF / 64);
    CvtItem d; d.kscale = nullptr; d.zero = false; int r = it;
#define CVT_SET(W, LDW, C0, K0, WT, R0, LDT) do { d.ldw = (LDW); d.ldt = (LDT); d.k0 = (K0); d.src = (W) + (size_t)(K0) * (LDW) + (C0); d.dst = (WT) + (size_t)(R0) * (LDT) + (K0); } while (0)
    if (r < I_WIN) { const int nb = r % (DINP / 32), kb = r / (DINP / 32); const int n0 = nb * 32; const bool z = (n0 >= 672 && n0 < 768); const int c0 = n0 < 672 ? n0 : n0 - 96;
        CVT_SET(inp(F, 8) + (size_t)l * D * 5792, 5792, z ? 0 : c0, kb * 64, WSP(bf16, WS_WIN), n0, D); d.zero = z; return d; } r -= I_WIN;
    if (r < I_UQ) { const int nb = r % 24, kb = r / 24; CVT_SET(inp(F, 11) + (size_t)l * 384 * 768, 768, nb * 32, kb * 64, WSP(bf16, WS_WUQ), nb * 32, 384); d.kscale = inp(F, 9) + l * 384; return d; } r -= I_UQ;
    if (r < I_UKV) { const int nb = r % 32, kb = r / 32; CVT_SET(inp(F, 12) + (size_t)l * 256 * 1024, 1024, nb * 32, kb * 64, WSP(bf16, WS_WUKV), nb * 32, 256); d.kscale = inp(F, 10) + l * 256; return d; } r -= I_UKV;
    if (r < I_GLU) { const int nb = r % 16, kb = r / 16; CVT_SET(inp(F, 26) + (size_t)l * 512 * 512, 512, nb * 32, kb * 64, WSP(bf16, WS_WGLU), nb * 32, 512); return d; } r -= I_GLU;
    if (r < 3 * I_BR) { const int br = r / I_BR, q = r % I_BR, nb = q % 32, kb = q / 32; CVT_SET(inp(F, 28 + br) + (size_t)l * 512 * 1024, 1024, nb * 32, kb * 64, WSP(bf16, WS_WBR) + (size_t)br * 1024 * 512, nb * 32, 512); return d; } r -= 3 * I_BR;
    if (r < I_OUT) { const int nb = r % 32, kb = r / 32; CVT_SET(inp(F, 31) + (size_t)l * D * D, D, nb * 32, kb * 64, WSP(bf16, WS_WOUT), nb * 32, D); return d; } r -= I_OUT;
    const int e = r / (I_GU + I_DN); r = r % (I_GU + I_DN);
    const size_t eo = moe ? ((size_t)j * NEXP + e) : (size_t)j;
    if (r < I_GU) { const int nb = r % (FF2 / 32), kb = r / (FF2 / 32); const int n0 = nb * 32, t = n0 >> 8, i = n0 & 255; const bool up = i >= 128; const int c0 = t * 128 + (i & 127);
        const float* src = (moe ? (up ? inp(F, 37) : inp(F, 36)) : (up ? inp(F, 33) : inp(F, 32))) + eo * (size_t)D * FF;
        CVT_SET(src, FF, c0, kb * 64, WSP(bf16, WS_WGU) + (size_t)e * FF2 * D, n0, D); return d; } r -= I_GU;
    { const int nb = r % 32, kb = r / 32; const float* src = (moe ? inp(F, 38) : inp(F, 34)) + eo * (size_t)FF * D;
      CVT_SET(src, D, nb * 32, kb * 64, WSP(bf16, WS_WD) + (size_t)e * D * FF, nb * 32, FF); return d; }
#undef CVT_SET
}
constexpr int CVT_NONFFN = (DINP / 32) * (D / 64) + (768 / 32) * (384 / 64) + (1024 / 32) * (256 / 64) + (512 / 32) * (512 / 64) + 3 * (1024 / 32) * (512 / 64) + (1024 / 32) * (1024 / 64);
constexpr int CVT_FFN = (FF2 / 32) * (D / 64) + (1024 / 32) * (FF / 64);
#define CW_CVT 24576
__device__ __forceinline__ void convert_items(Frame& F, int l, int first, int end, int step) {
    LAS float* scr = (LAS float*)(F.lds + F.wave * 16384);
    const int total = end;
    int it = first; if (it >= total) return;
    CvtItem cur = cvt_decode(F, l, it); f32x4 va[8], vb[8]; cvt_load(cur, va, F.lane);
    for (;;) {
        const int itn = it + step; const bool more = itn < total; CvtItem nxt = cur;
        if (more) { nxt = cvt_decode(F, l, itn); cvt_load(nxt, vb, F.lane); }
        cvt_store(cur, va, scr, F.lane);
        if (!more) break;
#pragma unroll
        for (int i = 0; i < 8; ++i) va[i] = vb[i];
        cur = nxt; it = itn;
    }
}

__device__ __forceinline__ void prologue0(Frame& F) {
    if (F.vcu == 0 && F.tid < 16) WSP(unsigned, WS_CTL)[CW_CNT + (F.tid >> 3) * 8 * 64 + (F.tid & 7) * 64] = 0u;
    LAS float* red = (LAS float*)F.lds;
    LAS float* sv = (LAS float*)(F.lds + 16384);
    for (int i = F.tid; i < D; i += 512) { sv[i] = fsilu(inp(F, 1)[i]); sv[D + i] = fsilu(inp(F, 3)[i]); }
    __syncthreads();
    for (int it = F.vcu; it < DEPTH * 48; it += F.G) {
        const int l = it / 48, jb = it % 48, cq = F.lane & 31, kh = F.lane >> 5; const int j0 = jb * 128 + cq * 4;
        const float* W = inp(F, 4) + (size_t)l * D * 6144;
        f32x4 accl = {0.f, 0.f, 0.f, 0.f}, accc = {0.f, 0.f, 0.f, 0.f};
#pragma unroll 8
        for (int i = 0; i < 64; ++i) { const int k = F.wave * 128 + 2 * i + kh; const f32x4 w = *(const f32x4*)(W + (size_t)k * 6144 + j0); accl += w * sv[k]; accc += w * sv[D + k]; }
#pragma unroll
        for (int q = 0; q < 4; ++q) { accl[q] += __shfl_xor(accl[q], 32); accc[q] += __shfl_xor(accc[q], 32); }
        if (kh == 0) { *(LAS f32x4*)(red + (F.wave * 2 + 0) * 128 + cq * 4) = accl; *(LAS f32x4*)(red + (F.wave * 2 + 1) * 128 + cq * 4) = accc; }
        __syncthreads();
        if (F.tid < 256) { const int w = F.tid >> 7, jj = F.tid & 127; float sacc = 0.f;
#pragma unroll
          for (int q = 0; q < 8; ++q) sacc += red[(q * 2 + w) * 128 + jj];
          WSP(float, WS_MOD)[((size_t)l * 2 + w) * 6144 + jb * 128 + jj] = sacc + inp(F, 5)[l * 6144 + jb * 128 + jj]; }
        __syncthreads();
    }
    for (int idx = F.vcu * 512 + F.tid; idx < NL * 16; idx += F.G * 512) { const int n = idx >> 4, i = idx & 15; const float pos = (float)(i < 8 ? (n >> 6) : (n & 63));
        const float inv = __expf(-(float)(i & 7) * (9.210340371976184f / 8.f)); float s, c; sincos_rad(pos * inv, s, c);
        WSP(float, WS_ROPE)[idx] = c; WSP(float, WS_ROPE)[NL * 16 + idx] = s; }
    for (int idx = F.vcu * 512 + F.tid; idx < DEPTH * 2 * 32 * 64; idx += F.G * 512) {
        const int g = (idx >> 6) & 31, ld = idx >> 11;
        const float are = inp(F, 18)[idx], aim = inp(F, 19)[idx], dt = __expf(inp(F, 20)[ld * 32 + g]);
        const float er = __expf(are * dt); float sn, cs; sincos_rad(aim * dt, sn, cs);
        const float abr = er * cs, abi = er * sn;
        const float x = abr - 1.f, y = abi, den = 1.f / (are * are + aim * aim);
        const float cr = (x * are + y * aim) * den, ci = (y * are - x * aim) * den;
        float* P = WSP(float, WS_S5P) + (size_t)idx * 100;
        float pr = 1.f, pi = 0.f;
        for (int t = 0; t <= 32; ++t) { P[2 * t] = pr; P[2 * t + 1] = pi; const float nr = pr * abr - pi * abi, ni = pr * abi + pi * abr; pr = nr; pi = ni; }
        const float* bre = inp(F, 21) + (size_t)idx * 16; const float* bim = inp(F, 22) + (size_t)idx * 16;
        for (int c = 0; c < 16; ++c) { const float br = bre[c], bi = bim[c]; P[66 + 2 * c] = cr * br - ci * bi; P[67 + 2 * c] = cr * bi + ci * br; }
    }
}
__device__ __forceinline__ void prologue1(Frame& F) {
    LAS float* Pl = (LAS float*)F.lds;
    LAS float* Cr = Pl + 6400; LAS float* Ci = Cr + 1024;
    for (int ldg = F.vcu; ldg < DEPTH * 2 * 32; ldg += F.G) {
        __syncthreads();
        const float* P = WSP(float, WS_S5P) + (size_t)ldg * 6400; const float* cre = inp(F, 23) + (size_t)ldg * 1024; const float* cim = inp(F, 24) + (size_t)ldg * 1024;
        for (int i = F.tid; i < 6400; i += 512) Pl[i] = P[i];
        for (int i = F.tid; i < 1024; i += 512) { Cr[i] = cre[i]; Ci[i] = cim[i]; }
        __syncthreads();
        for (int e = F.tid; e < 32 * 256; e += 512) { const int cp = e & 15, c = (e >> 4) & 15, tau = e >> 8; float s = 0.f;
#pragma unroll 8
            for (int p = 0; p < 64; ++p) { const LAS float* Pp = Pl + p * 100; const float ar = Pp[2 * tau], ai = Pp[2 * tau + 1], br = Pp[66 + 2 * cp], bi = Pp[67 + 2 * cp];
                const float tr = ar * br - ai * bi, ti = ar * bi + ai * br; s += Cr[c * 64 + p] * tr - Ci[c * 64 + p] * ti; }
            WSP(float, WS_KTAB)[(size_t)ldg * 8192 + e] = s; }
    }
}
__device__ __forceinline__ void s5_tables(Frame& F, int l) {
    const float* KT = WSP(float, WS_KTAB) + (size_t)l * 2 * 32 * 32 * 256;
    const float* SP = WSP(float, WS_S5P) + (size_t)l * 2 * 32 * 64 * 100;
    bf16* WY = WSP(bf16, WS_WY); bf16* WE = WSP(bf16, WS_WEND);
    for (int idx = F.vcu * 512 + F.tid; idx < 32 * 512 * 96; idx += F.G * 512) {
        const int k8 = idx % 96, n = (idx / 96) & 511, g = idx / (96 * 512); const int t = n >> 4, c = n & 15;
        float v[8];
        if (k8 < 64) { const int j = k8 >> 1, c0 = (k8 & 1) * 8, dtj = t - j;
            if (dtj > 0) { const float* s = KT + ((((size_t)0 * 32 + g) * 32 + dtj) * 16 + c) * 16 + c0;
#pragma unroll
                for (int q = 0; q < 8; ++q) v[q] = s[q]; }
            else if (dtj < 0) { const float* s = KT + ((((size_t)1 * 32 + g) * 32 - dtj) * 16 + c) * 16 + c0;
#pragma unroll
                for (int q = 0; q < 8; ++q) v[q] = s[q]; }
            else { const float* s0 = KT + ((((size_t)0 * 32 + g) * 32) * 16 + c) * 16 + c0; const float* s1 = KT + ((((size_t)1 * 32 + g) * 32) * 16 + c) * 16 + c0; const float dsk = inp(F, 25)[l * 512 + g * 16 + c];
#pragma unroll
                for (int q = 0; q < 8; ++q) v[q] = s0[q] + s1[q] + ((c0 + q == c) ? dsk : 0.f); } }
        else { const int part = (k8 - 64) >> 3, dir = part >> 1, im = part & 1, p0 = ((k8 - 64) & 7) * 8; const int e = dir ? 32 - t : t + 1;
            const size_t ldg = ((size_t)(l * 2 + dir) * 32 + g);
            const float* cre = inp(F, 23) + (ldg * 16 + c) * 64 + p0; const float* cim = inp(F, 24) + (ldg * 16 + c) * 64 + p0;
#pragma unroll
            for (int q = 0; q < 8; ++q) { const float* Pp = SP + (((size_t)dir * 32 + g) * 64 + p0 + q) * 100; const float ar = Pp[2 * e], ai = Pp[2 * e + 1];
                v[q] = im ? -(cre[q] * ai + cim[q] * ar) : (cre[q] * ar - cim[q] * ai); } }
        u32x4 w; w.x = cvtpk(v[0], v[1]); w.y = cvtpk(v[2], v[3]); w.z = cvtpk(v[4], v[5]); w.w = cvtpk(v[6], v[7]);
        *(u32x4*)(WY + ((size_t)g * 512 + n) * 768 + k8 * 8) = w;
    }
    for (int idx = F.vcu * 512 + F.tid; idx < 32 * 256 * 64; idx += F.G * 512) {
        const int k8 = idx & 63, q_ = (idx >> 6) & 255, g = idx >> 14; const int j = k8 >> 1, c0 = (k8 & 1) * 8;
        const int dir = q_ >> 7, im = (q_ >> 6) & 1, p = q_ & 63; const int e = dir ? j : 31 - j;
        const float* Pp = SP + (((size_t)dir * 32 + g) * 64 + p) * 100; const float ar = Pp[2 * e], ai = Pp[2 * e + 1]; float v[8];
#pragma unroll
        for (int q = 0; q < 8; ++q) { const float br = Pp[66 + 2 * (c0 + q)], bi = Pp[67 + 2 * (c0 + q)]; v[q] = im ? (ar * bi + ai * br) : (ar * br - ai * bi); }
        u32x4 w; w.x = cvtpk(v[0], v[1]); w.y = cvtpk(v[2], v[3]); w.z = cvtpk(v[4], v[5]); w.w = cvtpk(v[6], v[7]);
        *(u32x4*)(WE + ((size_t)g * 256 + q_) * 512 + k8 * 8) = w;
    }
}

__device__ __forceinline__ void moe_bases(const unsigned* cnt, int (&base)[9]) {
    int b = 0;
#pragma unroll
    for (int e = 0; e < 8; ++e) { base[e] = b; const int c = (int)__hip_atomic_load(cnt + 64 * e, __ATOMIC_RELAXED, __HIP_MEMORY_SCOPE_AGENT); b += ((c + 255) >> 8) << 8; }
    base[8] = b;
}

template <int MODE>
__device__ __forceinline__ void norm_phase(Frame& F, int l) {
    bf16* xs = WSP(bf16, WS_XS); bf16* H = WSP(bf16, WS_H);
    const float* gn = inp(F, MODE == 0 ? 6 : 7) + l * D;
    const float* modl = WSP(float, WS_MOD) + ((size_t)l * 2 + 0) * 6144 + (MODE == 0 ? 0 : 3 * D);
    const float* modc = WSP(float, WS_MOD) + ((size_t)l * 2 + 1) * 6144 + (MODE == 0 ? 0 : 3 * D);
    const bool moe = (MODE == 1) && (l & 1) && !DBG_NOMOE;
    const bool comb = (MODE == 0) && l > 0 && ((l - 1) & 1) && !DBG_NOMOE;
    const int row_lo = (MODE == 1 && l == DEPTH - 1) ? NC : 0;
    int base[9];
    const unsigned* cntp = (const unsigned*)WSP(unsigned, WS_CTL) + CW_CNT + ((l - 1) >> 1) * 8 * 64;
    if (comb) moe_bases(cntp, base);
    LAS float* wr_l = (LAS float*)F.lds;
    LAS int* lcnt = (LAS int*)(F.lds + 32768); LAS int* wgbase = lcnt + 8; LAS unsigned* rowrec = (LAS unsigned*)(F.lds + 32768 + 256);
    if (moe) { const float* wrt = inp(F, 35) + (size_t)(l >> 1) * D * 8; for (int i = F.tid; i < D * 8; i += 512) wr_l[i] = wrt[i]; if (F.tid < 8) lcnt[F.tid] = 0; __syncthreads(); }
    int krow = 0;
    unsigned* cnt = WSP(unsigned, WS_CTL) + CW_CNT + (l >> 1) * 8 * 64;
    const float* ga2p_l = WSP(float, WS_MOD) + ((size_t)(l - 1) * 2 + 0) * 6144 + 5 * D; const float* ga2p_c = WSP(float, WS_MOD) + ((size_t)(l - 1) * 2 + 1) * 6144 + 5 * D;
    for (int m = row_lo + F.gw; m < NT; m += F.NGW) {
        f32x4 v[4];
        if (MODE == 0 && l == 0) { const float* src = m < NC ? inp(F, 2) + (size_t)m * D : inp(F, 0) + (size_t)(m - NC) * D;
#pragma unroll
            for (int j = 0; j < 4; ++j) v[j] = *(const f32x4*)(src + j * 256 + F.lane * 4); }
        else {
#ifdef DBG_SC1
#pragma unroll
            for (int j = 0; j < 4; ++j) {
#pragma unroll
                for (int q = 0; q < 4; ++q) v[j][q] = __hip_atomic_load(xs + (size_t)m * D + j * 256 + F.lane * 4 + q, __ATOMIC_RELAXED, __HIP_MEMORY_SCOPE_AGENT); }
#else
#pragma unroll
            for (int j = 0; j < 4; ++j) v[j] = ld4bf(xs + (size_t)m * D + j * 256 + F.lane * 4);
#endif
        }
        if (comb) { const unsigned* rec = WSP(unsigned, WS_REC) + (size_t)m * 8; const int e0 = rec[0], p0 = rec[1], e1 = rec[2], p1 = rec[3]; const float w0 = __uint_as_float(rec[4]), w1 = __uint_as_float(rec[5]);
            int r0 = 0, r1 = 0;
#pragma unroll
            for (int e = 0; e < 8; ++e) { r0 = (e == e0) ? base[e] + p0 : r0; r1 = (e == e1) ? base[e] + p1 : r1; }
            const bf16* Y0 = WSP(bf16, WS_Y) + (size_t)r0 * D; const bf16* Y1 = WSP(bf16, WS_Y) + (size_t)r1 * D; const float* ga = m < NC ? ga2p_c : ga2p_l; constexpr size_t YH = (size_t)(WS_Y2 - WS_Y) / 2;
#pragma unroll
            for (int j = 0; j < 4; ++j) { const int col = j * 256 + F.lane * 4; const u32x2 a = *(const u32x2*)(Y0 + col), b = *(const u32x2*)(Y1 + col), a2 = *(const u32x2*)(Y0 + YH + col), b2 = *(const u32x2*)(Y1 + YH + col); const f32x4 g = *(const f32x4*)(ga + col);
                v[j][0] += g[0] * (w0 * (bflo(a.x) + bflo(a2.x)) + w1 * (bflo(b.x) + bflo(b2.x))); v[j][1] += g[1] * (w0 * (bfhi(a.x) + bfhi(a2.x)) + w1 * (bfhi(b.x) + bfhi(b2.x)));
                v[j][2] += g[2] * (w0 * (bflo(a.y) + bflo(a2.y)) + w1 * (bflo(b.y) + bflo(b2.y))); v[j][3] += g[3] * (w0 * (bfhi(a.y) + bfhi(a2.y)) + w1 * (bfhi(b.y) + bfhi(b2.y))); } }
        const int npart = (m < NC) ? ((MODE == 1) ? (l < DEPTH - 1 ? 12 : 0) : ((l > 0 && !((l - 1) & 1)) ? 11 : 0)) : 0;
        if (npart) { const float* pp = WSP(float, WS_PART) + (size_t)m * D;
            for (int k = 0; k < npart; ++k) {
#pragma unroll
                for (int j = 0; j < 4; ++j) v[j] += *(const f32x4*)(pp + (size_t)k * 256 * D + j * 256 + F.lane * 4); } }
        if ((MODE == 0 && l == 0) || comb || npart) {
#pragma unroll
            for (int j = 0; j < 4; ++j) st4bf(xs + (size_t)m * D + j * 256 + F.lane * 4, v[j]); }
        float ss = 0.f;
#pragma unroll
        for (int j = 0; j < 4; ++j) ss += (v[j][0] * v[j][0] + v[j][1] * v[j][1]) + (v[j][2] * v[j][2] + v[j][3] * v[j][3]);
        const float r = 1.0f / sqrtf(wave_sum(ss) * (1.f / D) + EPS);
        const float* md = m < NC ? modc : modl;
        float lg[8] = {0.f, 0.f, 0.f, 0.f, 0.f, 0.f, 0.f, 0.f};
#pragma unroll
        for (int j = 0; j < 4; ++j) { const int col = j * 256 + F.lane * 4; const f32x4 g = *(const f32x4*)(gn + col), sh = *(const f32x4*)(md + col), sc = *(const f32x4*)(md + D + col);
            f32x4 h;
#pragma unroll
            for (int q = 0; q < 4; ++q) h[q] = (v[j][q] * r * g[q]) * (1.f + sc[q]) + sh[q];
            u32x2 w; w.x = cvtpk(h[0], h[1]); w.y = cvtpk(h[2], h[3]); *(u32x2*)(H + (size_t)m * D + col) = w;
            if (moe) {
#pragma unroll
                for (int q = 0; q < 4; ++q) { const f32x4 wa = *(const LAS f32x4*)(wr_l + (col + q) * 8), wb = *(const LAS f32x4*)(wr_l + (col + q) * 8 + 4);
                    lg[0] += h[q] * wa[0]; lg[1] += h[q] * wa[1]; lg[2] += h[q] * wa[2]; lg[3] += h[q] * wa[3]; lg[4] += h[q] * wb[0]; lg[5] += h[q] * wb[1]; lg[6] += h[q] * wb[2]; lg[7] += h[q] * wb[3]; } } }
        if (moe) {
#pragma unroll
            for (int e = 0; e < 8; ++e) lg[e] = wave_sum(lg[e]);
            int i0 = 0; float v0 = lg[0];
#pragma unroll
            for (int e = 1; e < 8; ++e) if (lg[e] > v0) { v0 = lg[e]; i0 = e; }
            int i1 = -1; float v1 = -3.0e38f;
#pragma unroll
            for (int e = 0; e < 8; ++e) if (e != i0 && lg[e] > v1) { v1 = lg[e]; i1 = e; }
#ifdef DBG_FIXROUTE
            i0 = m & 7; i1 = (m + 1) & 7; v0 = 0.f; v1 = 0.f;
#endif
            if (F.lane == 0) { const float w1 = 1.f / (1.f + __expf(v0 - v1)), w0 = 1.f - w1;
                const unsigned p0 = (unsigned)__hip_atomic_fetch_add(lcnt + i0, 1, __ATOMIC_RELAXED, __HIP_MEMORY_SCOPE_WORKGROUP), p1 = (unsigned)__hip_atomic_fetch_add(lcnt + i1, 1, __ATOMIC_RELAXED, __HIP_MEMORY_SCOPE_WORKGROUP);
                LAS unsigned* rr = rowrec + (F.wave * 9 + krow) * 6; rr[0] = i0; rr[1] = p0; rr[2] = i1; rr[3] = p1; rr[4] = __float_as_uint(w0); rr[5] = __float_as_uint(w1); }
            ++krow;
        }
    }
    if (moe) {
        __syncthreads();
        if (F.tid < 8) wgbase[F.tid] = (int)__hip_atomic_fetch_add(cnt + 64 * F.tid, (unsigned)lcnt[F.tid], __ATOMIC_RELAXED, __HIP_MEMORY_SCOPE_AGENT);
        __syncthreads();
        if (F.lane == 0) { int k = 0; for (int m = row_lo + F.gw; m < NT; m += F.NGW, ++k) { const LAS unsigned* rr = rowrec + (F.wave * 9 + k) * 6; unsigned* rec = WSP(unsigned, WS_REC) + (size_t)m * 8;
            const unsigned e0 = rr[0], e1 = rr[2]; rec[0] = e0; rec[1] = rr[1] + (unsigned)wgbase[e0]; rec[2] = e1; rec[3] = rr[3] + (unsigned)wgbase[e1]; rec[4] = rr[4]; rec[5] = rr[5]; } }
    }
}
__device__ __forceinline__ void moe_scatter(Frame& F, int l) {
    int base[9]; moe_bases((const unsigned*)WSP(unsigned, WS_CTL) + CW_CNT + (l >> 1) * 8 * 64, base);
    const int row_lo = (l == DEPTH - 1) ? NC : 0;
    const bf16* H = WSP(bf16, WS_H); bf16* HS = WSP(bf16, WS_HS);
    for (int it = 2 * row_lo + F.gw; it < 2 * NT; it += F.NGW) { const int m = it >> 1, s = it & 1; const unsigned* rec = WSP(unsigned, WS_REC) + (size_t)m * 8; const int e = rec[2 * s], p = rec[2 * s + 1];
        int r = 0;
#pragma unroll
        for (int q = 0; q < 8; ++q) r = (q == e) ? base[q] + p : r;
        const u32x4* src = (const u32x4*)(H + (size_t)m * D); u32x4* dst = (u32x4*)(HS + (size_t)r * D);
        dst[F.lane] = src[F.lane]; dst[64 + F.lane] = src[64 + F.lane]; }
}
__device__ __forceinline__ void final_out(Frame& F, int l) {
#if DBG_DUMP == 9
    { const float* xs = WSP(float, WS_XS); for (int m = NC + ((F.gw + 1024 + 3) % F.NGW); m < NT; m += F.NGW) { for (int j = 0; j < 16; ++j) { const int col = j * 64 + F.lane; F.out[(size_t)(m - NC) * D + col] = xs[(size_t)m * D + col]; } } return; }
#elif DBG_DUMP == 10
    { const float* md = WSP(float, WS_MOD); for (int m = NC + F.gw; m < NT; m += F.NGW) { for (int j = 0; j < 16; ++j) { const int col = j * 64 + F.lane; F.out[(size_t)(m - NC) * D + col] = md[((size_t)(m - NC) * D + col) % 49152]; } } return; }
#elif DBG_DUMP
    { const bf16* src = WSP(bf16, DBG_DUMP == 1 ? WS_H : DBG_DUMP == 2 ? WS_G : DBG_DUMP == 3 ? WS_KVRAW : DBG_DUMP == 4 ? WS_OA : DBG_DUMP == 5 ? WS_M1 : DBG_DUMP == 6 ? WS_QF : DBG_DUMP == 7 ? WS_Z : WS_OC);
      const int ld = DBG_DUMP == 2 ? 3072 : (DBG_DUMP == 4 || DBG_DUMP == 7 || DBG_DUMP == 8) ? 512 : DBG_DUMP == 6 ? 96 : 1024;
      for (int m = NC + F.gw; m < NT; m += F.NGW) { for (int j = 0; j < 16; ++j) { const int col = j * 64 + F.lane; F.out[(size_t)(m - NC) * D + col] = bf2f(src[(size_t)m * ld + (col % ld)]); } } return; }
#endif
    if (!(l & 1) || DBG_NOMOE) { const bf16* xs = WSP(bf16, WS_XS); for (int m = NC + F.gw; m < NT; m += F.NGW) {
#pragma unroll
        for (int j = 0; j < 4; ++j) *(f32x4*)(F.out + (size_t)(m - NC) * D + j * 256 + F.lane * 4) = ld4bf(xs + (size_t)m * D + j * 256 + F.lane * 4); } return; }
    int base[9]; moe_bases((const unsigned*)WSP(unsigned, WS_CTL) + CW_CNT + (l >> 1) * 8 * 64, base);
    const bf16* xs = WSP(bf16, WS_XS); const float* ga = WSP(float, WS_MOD) + ((size_t)l * 2 + 0) * 6144 + 5 * D;
    for (int m = NC + F.gw; m < NT; m += F.NGW) { const unsigned* rec = WSP(unsigned, WS_REC) + (size_t)m * 8; const int e0 = rec[0], p0 = rec[1], e1 = rec[2], p1 = rec[3];
#ifndef DBG_NOREC
        const float w0 = __uint_as_float(rec[4]), w1 = __uint_as_float(rec[5]);
#endif
        int r0 = 0, r1 = 0;
#pragma unroll
        for (int e = 0; e < 8; ++e) { r0 = (e == e0) ? base[e] + p0 : r0; r1 = (e == e1) ? base[e] + p1 : r1; }
        const bf16* Y0 = WSP(bf16, DBG_YSRC) + (size_t)r0 * D; const bf16* Y1 = WSP(bf16, DBG_YSRC) + (size_t)r1 * D;
#ifdef DBG_DIRECTH
        Y0 = WSP(bf16, WS_H) + (size_t)m * D; Y1 = Y0;
#endif
#ifdef DBG_NOREC
        const float w0 = DBG_W, w1 = DBG_W;
#endif
#pragma unroll
        for (int j = 0; j < 4; ++j) { const int col = j * 256 + F.lane * 4; constexpr size_t YH = (size_t)(WS_Y2 - WS_Y) / 2; const u32x2 a = *(const u32x2*)(Y0 + col), b = *(const u32x2*)(Y1 + col), a2 = *(const u32x2*)(Y0 + YH + col), b2 = *(const u32x2*)(Y1 + YH + col); const f32x4 g = *(const f32x4*)(ga + col); f32x4 v = ld4bf(xs + (size_t)m * D + col);
            v[0] += g[0] * (w0 * (bflo(a.x) + bflo(a2.x)) + w1 * (bflo(b.x) + bflo(b2.x))); v[1] += g[1] * (w0 * (bfhi(a.x) + bfhi(a2.x)) + w1 * (bfhi(b.x) + bfhi(b2.x))); v[2] += g[2] * (w0 * (bflo(a.y) + bflo(a2.y)) + w1 * (bflo(b.y) + bflo(b2.y))); v[3] += g[3] * (w0 * (bfhi(a.y) + bfhi(a2.y)) + w1 * (bfhi(b.y) + bfhi(b2.y)));
            *(f32x4*)(F.out + (size_t)(m - NC) * D + col) = v; } }
}

__device__ __forceinline__ float sum8(float v) { v += __shfl_xor(v, 1); v += __shfl_xor(v, 2); v += __shfl_xor(v, 4); return v; }
__device__ __forceinline__ void finalize_phase(Frame& F, int l, int wg, int nwg) {
    const bf16* pA = WSP(bf16, WS_PA); const bf16* pN = WSP(bf16, WS_PN); const bf16* QR = WSP(bf16, WS_QRAW); const bf16* KVR = WSP(bf16, WS_KVRAW);
    bf16* QF = WSP(bf16, WS_QF); unsigned char* K8G = WSP(unsigned char, WS_KF); unsigned char* V8G = WSP(unsigned char, WS_VF); bf16* NQ = WSP(bf16, WS_NQ); bf16* NK = WSP(bf16, WS_NK);
    const float* gqn = inp(F, 13) + l * 96; const float* gkn = inp(F, 14) + l * 96; const float* gnq = inp(F, 15) + l * 64; const float* gnk = inp(F, 16) + l * 64;
    const float* COS = WSP(float, WS_ROPE); const float* SIN = COS + NL * 16;
    LAS unsigned char* buf = F.lds; LAS float* stats = (LAS float*)(F.lds + RING_BYTES + 4096); LAS unsigned char* krl = F.lds + RING_BYTES + 4096 + 512;
    const int tid0 = F.tid;
#define SWZ(c, row) (((c) & ~15) | (((c) ^ (row)) & 15))
#define PK8(f) (u32x4){cvtpk(f[0], f[1]), cvtpk(f[2], f[3]), cvtpk(f[4], f[5]), cvtpk(f[6], f[7])}
    for (int tg = wg; tg < NT / 64; tg += nwg) {
        int tid_ = tid0; asm volatile("" : "+v"(tid_));
        const int tid = tid_, lane = tid & 63, wave = __builtin_amdgcn_readfirstlane(tid >> 6), h = tid >> 6, tl = tid & 63;
        const int t0 = tg * 64, t = t0 + tl; const bool lat = t >= NC; const int n = t - NC;
        __syncthreads();
        { u32x4 va[8], vb[8]; float sq[8], skv[8];
#pragma unroll
          for (int i = 0; i < 8; ++i) { const bf16* row = pA + (size_t)(t0 + wave * 8 + i) * 768; va[i] = *(const u32x4*)(row + lane * 8); vb[i] = lane < 20 ? *(const u32x4*)(row + (64 + lane) * 8) : (u32x4){0u, 0u, 0u, 0u}; }
#pragma unroll
          for (int i = 0; i < 8; ++i) { float f[8]; unpack8(va[i], f); float ss = 0.f;
#pragma unroll
              for (int q = 0; q < 8; ++q) ss += f[q] * f[q];
              sq[i] = lane < 48 ? ss : 0.f; skv[i] = lane >= 48 ? ss : 0.f;
              if (lane < 16) { float g[8]; unpack8(vb[i], g);
#pragma unroll
                  for (int q = 0; q < 8; ++q) skv[i] += g[q] * g[q]; }
              else if (lane < 20) *(LAS u32x4*)(krl + (wave * 8 + i) * 64 + (lane - 16) * 16) = vb[i]; }
#pragma unroll
          for (int o = 1; o < 64; o <<= 1) {
#pragma unroll
              for (int i = 0; i < 8; ++i) { sq[i] += __shfl_xor(sq[i], o); skv[i] += __shfl_xor(skv[i], o); } }
          if (lane == 0) {
#pragma unroll
              for (int i = 0; i < 8; ++i) { stats[(wave * 8 + i) * 2] = 1.0f / sqrtf(sq[i] * (1.f / 384.f) + EPS); stats[(wave * 8 + i) * 2 + 1] = 1.0f / sqrtf(skv[i] * (1.f / 256.f) + EPS); } } }
#pragma unroll 8
        for (int i = 0; i < 12; ++i) { const int id = tid + 512 * i, row = id / 96, c = id % 96; *(LAS u32x4*)(buf + row * 1536 + SWZ(c, row) * 16) = *(const u32x4*)(QR + (size_t)(t0 + row) * 768 + c * 8); }
        __syncthreads();
        { LAS unsigned char* pq = buf + tl * 1536; const float rq = stats[tl * 2]; float ss = 0.f;
#define QCH(c) (pq + SWZ(h * 12 + (c), tl) * 16)
#pragma unroll
          for (int c = 0; c < 12; ++c) { float f[8]; unpack8(*(const LAS u32x4*)QCH(c), f);
#pragma unroll
              for (int q = 0; q < 8; ++q) { const float v = f[q] * rq; ss += v * v; } }
          const float sc = rq / sqrtf(ss * (1.f / 96.f) + EPS) * (0.10206207261596575f * 1.4426950408889634f);
#pragma unroll
          for (int c = 0; c < 8; ++c) { float f[8]; unpack8(*(const LAS u32x4*)QCH(c), f);
#pragma unroll
              for (int q = 0; q < 8; ++q) f[q] = f[q] * sc * gqn[c * 8 + q];
              *(LAS u32x4*)QCH(c) = PK8(f); }
#pragma unroll
          for (int cp = 0; cp < 2; ++cp) { float a[8], b[8]; unpack8(*(const LAS u32x4*)QCH(8 + cp), a); unpack8(*(const LAS u32x4*)QCH(10 + cp), b);
#pragma unroll
              for (int q = 0; q < 8; ++q) { a[q] = a[q] * sc * gqn[64 + cp * 8 + q]; b[q] = b[q] * sc * gqn[80 + cp * 8 + q]; }
              if (lat) {
#pragma unroll
                  for (int q = 0; q < 8; ++q) { const float cs = COS[(size_t)n * 16 + cp * 8 + q], sn = SIN[(size_t)n * 16 + cp * 8 + q]; const float ra = a[q] * cs - b[q] * sn, rb = a[q] * sn + b[q] * cs; a[q] = ra; b[q] = rb; } }
              *(LAS u32x4*)QCH(8 + cp) = PK8(a); *(LAS u32x4*)QCH(10 + cp) = PK8(b); } }
#undef QCH
        __syncthreads();
#pragma unroll 8
        for (int i = 0; i < 12; ++i) { const int id = tid + 512 * i, hh = id / 768, rem = id % 768, row = rem / 12, c = rem % 12;
            *(u32x4*)(QF + ((size_t)hh * NT + t0 + row) * 96 + c * 8) = *(const LAS u32x4*)(buf + row * 1536 + SWZ(hh * 12 + c, row) * 16); }
        __syncthreads();
#pragma unroll 8
        for (int i = 0; i < 16; ++i) { const int id = tid + 512 * i, row = id >> 7, c = id & 127; *(LAS u32x4*)(buf + row * 2048 + SWZ(c, row) * 16) = *(const u32x4*)(KVR + (size_t)(t0 + row) * 1024 + c * 8); }
        __syncthreads();
        unsigned v8r[16];
#define F8W(f, o) ((unsigned)__builtin_amdgcn_cvt_pk_fp8_f32(f[(o) + 2], f[(o) + 3], __builtin_amdgcn_cvt_pk_fp8_f32(f[(o)], f[(o) + 1], 0, false), true))
        { LAS unsigned char* pk = buf + tl * 2048; const LAS unsigned char* pr = krl + tl * 64;
#define KCHK(c) (pk + SWZ(h * 16 + (c), tl) * 16)
          const float rkv = stats[tl * 2 + 1]; float ss = 0.f;
#pragma unroll
          for (int c = 0; c < 8; ++c) { float f[8]; unpack8(*(const LAS u32x4*)KCHK(c), f);
#pragma unroll
              for (int q = 0; q < 8; ++q) { const float v = f[q] * rkv; ss += v * v; } }
#pragma unroll
          for (int c = 0; c < 4; ++c) { float f[8]; unpack8(*(const LAS u32x4*)(pr + c * 16), f);
#pragma unroll
              for (int q = 0; q < 8; ++q) ss += f[q] * f[q]; }
          const float rn = 1.0f / sqrtf(ss * (1.f / 96.f) + EPS), sc = rkv * rn; unsigned kw[16];
#pragma unroll
          for (int c = 0; c < 8; ++c) { float f[8]; unpack8(*(const LAS u32x4*)KCHK(c), f);
#pragma unroll
              for (int q = 0; q < 8; ++q) f[q] = f[q] * sc * gkn[c * 8 + q];
              kw[c * 2] = F8W(f, 0); kw[c * 2 + 1] = F8W(f, 4); }
          unsigned kr[8];
#pragma unroll
          for (int c = 8; c < 16; ++c) { float f[8]; unpack8(*(const LAS u32x4*)KCHK(c), f);
#pragma unroll
              for (int q = 0; q < 8; ++q) f[q] *= rkv;
              v8r[(c - 8) * 2] = F8W(f, 0); v8r[(c - 8) * 2 + 1] = F8W(f, 4); }
#pragma unroll
          for (int cp = 0; cp < 2; ++cp) { float a[8], b[8]; unpack8(*(const LAS u32x4*)(pr + cp * 16), a); unpack8(*(const LAS u32x4*)(pr + (2 + cp) * 16), b);
#pragma unroll
              for (int q = 0; q < 8; ++q) { a[q] = a[q] * rn * gkn[64 + cp * 8 + q]; b[q] = b[q] * rn * gkn[80 + cp * 8 + q]; }
              if (lat) {
#pragma unroll
                  for (int q = 0; q < 8; ++q) { const float cs = COS[(size_t)n * 16 + cp * 8 + q], sn = SIN[(size_t)n * 16 + cp * 8 + q]; const float ra = a[q] * cs - b[q] * sn, rb = a[q] * sn + b[q] * cs; a[q] = ra; b[q] = rb; } }
              kr[cp * 2] = F8W(a, 0); kr[cp * 2 + 1] = F8W(a, 4); kr[4 + cp * 2] = F8W(b, 0); kr[4 + cp * 2 + 1] = F8W(b, 4); }
#pragma unroll
          for (int w = 0; w < 4; ++w) *(LAS u32x4*)KCHK(w) = (u32x4){kw[4 * w], kw[4 * w + 1], kw[4 * w + 2], kw[4 * w + 3]};
          *(LAS u32x4*)KCHK(4) = (u32x4){kr[0], kr[1], kr[2], kr[3]}; *(LAS u32x4*)KCHK(5) = (u32x4){kr[4], kr[5], kr[6], kr[7]}; }
#undef F8W
        __syncthreads();
        int tq = tid; asm volatile("" : "+v"(tq));
#pragma unroll
        for (int i = 0; i < 6; ++i) { const int id = tq + 512 * i, hh = id / 384, r = id % 384, row = r / 6, w = r % 6;
            *(u32x4*)(K8G + ((size_t)hh * (NT / 64) + tg) * 7168 + row * 112 + w * 16) = *(const LAS u32x4*)(buf + row * 2048 + SWZ(hh * 16 + w, row) * 16); }
        __syncthreads();
        { int tl2 = tq & 63; const int pos = att::v8_pos(tl2); LAS unsigned char* vt = buf + (tq >> 6) * 4096 + (pos & 15);
          LAS unsigned char* vq[4];
#pragma unroll
          for (int x = 0; x < 4; ++x) vq[x] = vt + ((((pos >> 4) ^ x) & 3) << 4);
#pragma unroll
          for (int w = 0; w < 16; ++w)
#pragma unroll
              for (int b = 0; b < 4; ++b) vq[w & 3][(4 * w + b) * 64] = (unsigned char)(v8r[w] >> (8 * b)); }
        __syncthreads();
#pragma unroll
        for (int i = 0; i < 4; ++i) { const int id = tq + 512 * i, hh = id >> 8, off = (id & 255) * 16;
            *(u32x4*)(V8G + ((size_t)hh * (NT / 64) + tg) * 4096 + off) = *(const LAS u32x4*)(buf + hh * 4096 + off); }
        __syncthreads();
#pragma unroll 8
        for (int i = 0; i < 16; ++i) { const int id = tid + 512 * i, row = id >> 7, c = id & 127; *(LAS u32x4*)(buf + row * 2048 + SWZ(c, row) * 16) = *(const u32x4*)(pN + (size_t)(t0 + row) * 1536 + c * 8); }
        __syncthreads();
#pragma unroll
        for (int which = 0; which < 2; ++which) { LAS unsigned char* pn = buf + tl * 2048; const float* gg = which ? gnk : gnq; float ss = 0.f;
#pragma unroll
            for (int c = 0; c < 8; ++c) { float f[8]; unpack8(*(const LAS u32x4*)(pn + SWZ(which * 64 + h * 8 + c, tl) * 16), f);
#pragma unroll
                for (int q = 0; q < 8; ++q) ss += f[q] * f[q]; }
            const float rn = (which ? 1.0f : 0.125f * 1.4426950408889634f) / sqrtf(ss * (1.f / 64.f) + EPS);
#pragma unroll
            for (int c = 0; c < 8; ++c) { float f[8]; unpack8(*(const LAS u32x4*)(pn + SWZ(which * 64 + h * 8 + c, tl) * 16), f);
#pragma unroll
                for (int q = 0; q < 8; ++q) f[q] = f[q] * rn * gg[c * 8 + q];
                *(LAS u32x4*)(pn + SWZ(which * 64 + h * 8 + c, tl) * 16) = PK8(f); } }
        __syncthreads();
#pragma unroll 8
        for (int i = 0; i < 8; ++i) { const int id = tid + 512 * i, hh = id >> 9, row = (id & 511) >> 3, c = id & 7;
            *(u32x4*)(NQ + ((size_t)hh * NT + t0 + row) * 64 + c * 8) = *(const LAS u32x4*)(buf + row * 2048 + SWZ(hh * 8 + c, row) * 16);
            *(u32x4*)(NK + ((size_t)hh * NT + t0 + row) * 64 + c * 8) = *(const LAS u32x4*)(buf + row * 2048 + SWZ(64 + hh * 8 + c, row) * 16); }
    }
#undef PK8
#undef SWZ
#undef KCHK
}
__device__ __forceinline__ void s5_carry(Frame& F, int l, int cw) {
    const int idx = cw * 512 + F.tid; const int seg = idx & 7, p = (idx >> 3) & 63, g = (idx >> 9) & 31, dir = idx >> 14;
    const float* Pp = WSP(float, WS_S5P) + ((((size_t)l * 2 + dir) * 32 + g) * 64 + p) * 100; const float ar = Pp[64], ai = Pp[65];
    const float* E = WSP(float, WS_E) + (size_t)g * S5ROWS * 256 + dir * 128 + p; bf16* AG = WSP(bf16, WS_AG) + (size_t)g * S5ROWS * S5K + 512 + dir * 128 + p;
#define S5ROW(st) (dir == 0 ? ((st) < 8 ? 512 + (st) : (st) - 8) : 519 - (st))
    float tr = 0.f, ti = 0.f, pr = 1.f, pi = 0.f;
    for (int s0 = 0; s0 < 65; s0 += 5) { float er[5], ei[5];
#pragma unroll
        for (int q = 0; q < 5; ++q) { const int row = S5ROW(seg * 65 + s0 + q); er[q] = E[(size_t)row * 256]; ei[q] = E[(size_t)row * 256 + 64]; }
#pragma unroll
        for (int q = 0; q < 5; ++q) { const float nr = ar * tr - ai * ti + er[q], ni = ar * ti + ai * tr + ei[q]; tr = nr; ti = ni; const float qr = pr * ar - pi * ai, qi = pr * ai + pi * ar; pr = qr; pi = qi; } }
    float cr = 0.f, ci = 0.f, xr = 0.f, xi = 0.f; const int lb = F.lane & ~7;
#pragma unroll
    for (int k = 0; k < 8; ++k) { const float kr = __shfl(tr, lb + k), ki = __shfl(ti, lb + k); if (k == seg) { cr = xr; ci = xi; } const float nr = pr * xr - pi * xi + kr, ni = pr * xi + pi * xr + ki; xr = nr; xi = ni; }
    float sr = cr, si = ci;
    for (int s0 = 0; s0 < 65; s0 += 5) { float er[5], ei[5]; int rows[5];
#pragma unroll
        for (int q = 0; q < 5; ++q) { const int row = S5ROW(seg * 65 + s0 + q); rows[q] = row; er[q] = E[(size_t)row * 256]; ei[q] = E[(size_t)row * 256 + 64]; }
#pragma unroll
        for (int q = 0; q < 5; ++q) { AG[(size_t)rows[q] * S5K] = f2bf(sr); AG[(size_t)rows[q] * S5K + 64] = f2bf(si); const float nr = ar * sr - ai * si + er[q], ni = ar * si + ai * sr + ei[q]; sr = nr; si = ni; } }
#undef S5ROW
}
__device__ __forceinline__ void dbg_thrash(Frame& F) {
    f32x4 a = {0.f, 0.f, 0.f, 0.f};
    for (int w = 36; w < 39; ++w) { const f32x4* src = (const f32x4*)inp(F, w);
        for (size_t i = (size_t)F.vcu * 512 + F.tid; i < (size_t)11534336; i += (size_t)F.G * 512) a += src[i]; }
    if (a[0] + a[1] + a[2] + a[3] == 1.2345e33f) WSP(float, WS_E)[0] = a[0];
}
#define PH_BEGIN if (lo <= ph && ph < hi) { { int t_ = threadIdx.x; asm volatile("" : "+v"(t_)); F.tid = t_; F.lane = t_ & 63; unsigned long long w_ = (unsigned long long)args.ws; asm volatile("" : "+s"(w_)); F.ws = (unsigned char*)(GAS unsigned char*)w_; } DBG_LDSCLR
#define PH_END   if (ph + 1 < hi) xcd_barrier(bar); } ++ph;
template <int l>
__device__ __forceinline__ void layer_body(Frame& F, const Args& args, XcdBarrier& bar, int& ph, const int lo, const int hi, LAS unsigned char* ring, const int c, unsigned* ctl) {
    const int bx = blockIdx.x;
        const bool need_ctx = l < DEPTH - 1, moe = (l & 1) && !DBG_NOMOE;
        const int pm0 = need_ctx ? 0 : 1, nM = need_ctx ? 65 : 64;
        const float* modl = WSP(float, WS_MOD) + ((size_t)l * 2 + 0) * 6144; const float* modc = WSP(float, WS_MOD) + ((size_t)l * 2 + 1) * 6144;
        PH_BEGIN LPH(1) {
#if DBG_THRASH == 3
        if (l == 1) {   } else
#endif
        { for (int ra_ = 0; ra_ < 1 + DBG_REPA; ++ra_) { convert_items(F, l, F.gw, CVT_NONFFN, F.NGW);
        s5_tables(F, l); __syncthreads(); } norm_phase<0>(F, l); } } PH_END
        PH_BEGIN LPH(2) { { pg8::SchedPlain S; S.T.init(65, 23, F.G, bx); S.A = WSP(bf16, WS_H); S.Bt = WSP(bf16, WS_WIN); S.lda = D; S.ldb = D; S.pm0 = 0;
            pg8::EpiWin E{WSP(bf16, WS_PA), WSP(bf16, WS_PN), WSP(bf16, WS_AG), WSP(bf16, WS_G)};
            pg8::gemm_phase(ring, D, D, D, S, E); } } PH_END
        PH_BEGIN LPH(3) {
        { pg8::SchedPlain S; S.T.init(65, 3, F.G, bx); S.A = WSP(bf16, WS_PA); S.Bt = WSP(bf16, WS_WUQ); S.lda = 768; S.ldb = 384; S.pm0 = 0;
          pg8::EpiBf16 E{WSP(bf16, WS_QRAW), 768}; pg8::gemm_phase(ring, 384, 768, 384, S, E); }
        { pg8::SchedPlain S; S.T.init(65, 4, F.G, (bx + 61) & 255); S.A = WSP(bf16, WS_PA) + 384; S.Bt = WSP(bf16, WS_WUKV); S.lda = 768; S.ldb = 256; S.pm0 = 0;
          pg8::EpiBf16 E{WSP(bf16, WS_KVRAW), 1024}; pg8::gemm_phase(ring, 256, 768, 256, S, E); }
        { pg8::SchedS5 S; S.nrt = 3; S.nct = 1; S.G = F.G; S.c = (c + 57) & 255; S.A = WSP(bf16, WS_AG); S.W = WSP(bf16, WS_WEND); S.brows = 256; S.ldb = 512;
          pg8::EpiS5E E{WSP(float, WS_E)}; pg8::gemm_phase(ring, 512, S5K, 512, S, E); }
        } PH_END
        PH_BEGIN LPH(4) { if (c >= F.G - 64) s5_carry(F, l, c - (F.G - 64)); else finalize_phase(F, l, c, F.G - 64); } PH_END
        PH_BEGIN LPH(5) {
        { pg8::SchedS5 S; S.nrt = need_ctx ? 3 : 2; S.nct = 2; S.G = F.G; S.c = c; S.A = WSP(bf16, WS_AG); S.W = WSP(bf16, WS_WY); S.brows = 512; S.ldb = 768;
          pg8::EpiS5Y E{WSP(bf16, WS_Z)}; pg8::gemm_phase(ring, S5K, S5K, 768, S, E); }
        if (need_ctx && c >= 192 && c < 208) { const int u = c - 192, h = u & 7;
            if (u < 8) att::attn_unit<96, false, true>(WSP(bf16, WS_QF) + (size_t)h * NT * 96, 96, (const bf16*)(WSP(unsigned char, WS_KF) + (size_t)h * (NT / 64) * 7168), 96, (const bf16*)(WSP(unsigned char, WS_VF) + (size_t)h * (NT / 64) * 4096), 64, WSP(bf16, WS_OA) + h * 64, 4, 0, 0, 0, nullptr, ring);
            else att::attn_unit<64, false>(WSP(bf16, WS_NQ) + (size_t)h * NT * 64, 64, WSP(bf16, WS_NK) + (size_t)h * NT * 64, 64, WSP(bf16, WS_PN) + 1024 + h * 64, 1536, WSP(bf16, WS_OB) + h * 64, 4, 0, 0, 0, nullptr, ring); }
        for (int i = 0; i < 2; ++i) { const int h = c >> 5, qb = (c & 31) + 32 * i;
            att::attn_unit<96, false, true>(WSP(bf16, WS_QF) + ((size_t)h * NT + NC + qb * 256) * 96, 96, (const bf16*)(WSP(unsigned char, WS_KF) + (size_t)h * (NT / 64) * 7168), 96, (const bf16*)(WSP(unsigned char, WS_VF) + (size_t)h * (NT / 64) * 4096), 64,
                                      WSP(bf16, WS_OA) + (size_t)(NC + qb * 256) * 512 + h * 64, NT / 64, 0, 0, 0, nullptr, ring); }
        for (int i = 0; i < 2; ++i) { const int h = c >> 5, qb = (c & 31) + 32 * i;
            const int glo = 4 * qb - 4 < 0 ? 0 : (4 * qb - 4 > 248 ? 248 : 4 * qb - 4), ghi0 = 4 * qb - 1 < 0 ? 0 : (4 * qb - 1 > 248 ? 248 : 4 * qb - 1), ghi = ghi0 + 7;
            const int ntl = 4 + (ghi - glo + 1), ntp = (ntl + 1) & ~1;
            att::attn_unit<64, true>(WSP(bf16, WS_NQ) + ((size_t)h * NT + NC + qb * 256) * 64, 64, WSP(bf16, WS_NK) + (size_t)h * NT * 64, 64, WSP(bf16, WS_PN) + 1024 + h * 64, 1536,
                                     WSP(bf16, WS_OB) + (size_t)(NC + qb * 256) * 512 + h * 64, ntp, glo, ghi, qb, inp(F, 17) + ((size_t)l * 8 + h) * 465, ring); }
        { volatile LAS unsigned* tk = (volatile LAS unsigned*)(F.lds + MISC_OFF) + 12;
          constexpr int EB = CVT_NONFFN + CVT_FFN, EEND = CVT_NONFFN + NEXP * CVT_FFN, NE = (NEXP - 1) * CVT_FFN / 32;
          int own = CVT_FFN / 64, rest0 = EEND;
          if (moe) { unsigned ne = xb_ld(ctl + CW_CVT + l * 64 + 16); ne = ne > (unsigned)NE ? (unsigned)NE : ne; rest0 = EB + (int)ne * 32; own += (EEND - rest0 + 63) / 64; }
          for (;;) { __syncthreads(); if (F.tid == 0) tk[0] = xb_add(ctl + CW_CVT + l * 64, 1u);
              __syncthreads(); const int t = __builtin_amdgcn_readfirstlane((int)tk[0]); if (t >= own) break;
              if (t < CVT_FFN / 64) convert_items(F, l, CVT_NONFFN + t * 64 + F.wave, CVT_NONFFN + (t + 1) * 64, 8);
              else { const int i0 = rest0 + (t - CVT_FFN / 64) * 64, i1 = i0 + 64 < EEND ? i0 + 64 : EEND; convert_items(F, l, i0 + F.wave, i1, 8); } }
          if (!moe && l + 1 < DEPTH) {
              if (F.tid == 0) (void)xb_add(ctl + CW_CVT + l * 64 + 32, 1u);
              for (;;) { __syncthreads(); if (F.tid == 0) tk[0] = (xb_ld(ctl + CW_CVT + l * 64 + 32) < (unsigned)F.G) ? xb_add(ctl + CW_CVT + (l + 1) * 64 + 16, 1u) : 0x7fffffffu;
                  __syncthreads(); const int te = __builtin_amdgcn_readfirstlane((int)tk[0]); if (te >= NE) break;
                  convert_items(F, l + 1 < DEPTH ? l + 1 : l, EB + te * 32 + F.wave, EB + (te + 1) * 32, 8); } } }
        } PH_END
        PH_BEGIN LPH(6) { { pg8::SchedPlain S; S.T.init(nM, 2, F.G, bx); S.A = WSP(bf16, WS_Z); S.Bt = WSP(bf16, WS_WGLU); S.lda = 512; S.ldb = 512; S.pm0 = pm0;
            pg8::EpiGlu E{WSP(bf16, WS_Z), WSP(bf16, WS_OC), inp(F, 27) + l * 512}; pg8::gemm_phase(ring, 512, 512, 512, S, E); } } PH_END
        PH_BEGIN LPH(7) { { pg8::SchedMerge S; S.T.init(64, 4, F.G, bx); S.O = WSP(bf16, WS_OA); S.W = WSP(bf16, WS_WBR); S.pm0 = 1;
            pg8::EpiMerge E{WSP(bf16, WS_G), WSP(bf16, WS_M1)}; pg8::gemm_phase(ring, 512, 512, 512, S, E); }
            if (need_ctx) { pg8::SchedCtxMerge S; S.G = F.G; S.c = (c + 96) & 255; S.O = WSP(bf16, WS_OA); S.W = WSP(bf16, WS_WBR);
            pg8::EpiMergeCtx E{WSP(bf16, WS_G), WSP(bf16, WS_M1C)}; pg8::gemm_phase(ring, 512, 512, 512, S, E); } } PH_END
        PH_BEGIN LPH(8) { { pg8::SchedPlain S; S.T.init(64, 4, F.G, bx); S.A = WSP(bf16, WS_M1); S.Bt = WSP(bf16, WS_WOUT); S.lda = D; S.ldb = D; S.pm0 = 1;
            pg8::EpiResid E{WSP(bf16, WS_XS), modl + 2 * D, modc + 2 * D}; pg8::gemm_phase(ring, D, D, D, S, E); }
            if (need_ctx) { pg8::SchedCtxK S; S.nsl = 12; S.nks = 4; S.G = F.G; S.c = (c + 96) & 255; S.A = WSP(bf16, WS_M1C); S.astride = (size_t)256 * 1024; S.Bt = WSP(bf16, WS_WOUT); S.lda = D; S.ldb = D;
            pg8::EpiResidPart E{WSP(float, WS_PART), modc + 2 * D}; pg8::gemm_phase(ring, 256, D, D, S, E); } } PH_END
        PH_BEGIN LPH(9) { norm_phase<1>(F, l); } PH_END
        if (!moe) {
            PH_BEGIN LPH(10) { { pg8::SchedPlain S; S.T.init(nM, 22, F.G, bx); S.A = WSP(bf16, WS_H); S.Bt = WSP(bf16, WS_WGU); S.lda = D; S.ldb = D; S.pm0 = pm0;
                pg8::EpiUp E{WSP(bf16, WS_ACT)}; pg8::gemm_phase(ring, D, D, D, S, E); } } PH_END
            PH_BEGIN LPH(11) { { pg8::SchedPlain S; S.T.init(64, 4, F.G, bx); S.A = WSP(bf16, WS_ACT); S.Bt = WSP(bf16, WS_WD); S.lda = FF; S.ldb = FF; S.pm0 = 1;
                pg8::EpiResid E{WSP(bf16, WS_XS), modl + 5 * D, modc + 5 * D}; pg8::gemm_phase(ring, FF, FF, FF, S, E); }
                if (need_ctx) { pg8::SchedCtxK S; S.nsl = 11; S.nks = 11; S.G = F.G; S.c = (c + 96) & 255; S.A = WSP(bf16, WS_ACT); S.astride = 0; S.Bt = WSP(bf16, WS_WD); S.lda = FF; S.ldb = FF;
                pg8::EpiResidPart E{WSP(float, WS_PART), modc + 5 * D}; pg8::gemm_phase(ring, 256, FF, FF, S, E); } } PH_END
        } else {
            PH_BEGIN LPH(12) { moe_scatter(F, l); } PH_END
            LAS int* tst = (LAS int*)(F.lds + RING_BYTES + 2048);
            PH_BEGIN LPH(13) { { int base[9]; moe_bases((const unsigned*)ctl + CW_CNT + (l >> 1) * 8 * 64, base); __syncthreads();
                if (F.tid < 160) { int e = 0;
#pragma unroll
                    for (int j = 1; j < 8; ++j) e += (F.tid >= (base[j] >> 8)) ? 1 : 0;
                    tst[F.tid] = e; } __syncthreads();
                pg8::SchedMoe S; S.T.init(base[8] >> 8, 22, F.G, bx); S.A = WSP(bf16, WS_HS); S.W = WSP(bf16, WS_WGU); S.lda = D; S.ldb = D; S.wstride = (size_t)FF2 * D; S.tstart = tst;
                pg8::EpiUp E{WSP(bf16, WS_ACT)}; pg8::gemm_phase(ring, D, D, D, S, E); } } PH_END
            PH_BEGIN LPH(14) { { int base[9]; moe_bases((const unsigned*)ctl + CW_CNT + (l >> 1) * 8 * 64, base); __syncthreads();
                if (F.tid < 160) { int e = 0;
#pragma unroll
                    for (int j = 1; j < 8; ++j) e += (F.tid >= (base[j] >> 8)) ? 1 : 0;
                    tst[F.tid] = e; } __syncthreads();
                pg8::SchedMoeDown S; S.T.init(base[8] >> 8, 8, F.G, bx); S.A = WSP(bf16, WS_ACT); S.W = WSP(bf16, WS_WD); S.tstart = tst;
                pg8::EpiMoeY E{WSP(bf16, WS_Y), WSP(bf16, WS_Y2)}; pg8::gemm_phase(ring, 1408, FF, FF, S, E); } } PH_END
        }
    }
__global__ void __launch_bounds__(512, 2) mega(Args args) {
    extern __shared__ __attribute__((aligned(16))) unsigned char lds_raw[];
    Frame F; F.lds = (LAS unsigned char*)lds_raw; F.ws = (unsigned char*)(GAS unsigned char*)(unsigned long long)args.ws; F.out = (float*)(GAS float*)(unsigned long long)args.out;
    F.tid = threadIdx.x; F.lane = F.tid & 63; F.wave = __builtin_amdgcn_readfirstlane(F.tid >> 6);
    F.G = gridDim.x; { const int bx = blockIdx.x; F.vcu = (F.G % 8 == 0) ? (bx % 8) * (F.G / 8) + bx / 8 : bx; }
    F.gw = F.vcu * 8 + F.wave; F.NGW = F.G * 8;
    volatile LAS unsigned* MISC = (volatile LAS unsigned*)(F.lds + MISC_OFF);
    for (int u = F.tid; u < (LDS_BYTES - RING_BYTES) / 4; u += 512) ((LAS unsigned*)(F.lds + RING_BYTES))[u] = 0u;
    __syncthreads();
    if (F.tid < 39) { const unsigned long long pv = (unsigned long long)args.in[F.tid]; LAS unsigned* t = (LAS unsigned*)(F.lds + INTAB_OFF) + 2 * F.tid; t[0] = (unsigned)pv; t[1] = (unsigned)(pv >> 32); }
    __syncthreads();
    unsigned* ctl = WSP(unsigned, WS_CTL);
    XcdBarrier bar; bar.bar = ctl + CW_BAR; bar.x = 0; bar.st = nullptr;
    if (ONE_LAUNCH) bar = xcd_barrier_post(ctl + CW_BAR, MISC + 8);
    int ph = 0; const int lo = args.ph_lo, hi = args.ph_hi;
    LAS unsigned char* ring = F.lds;
    const int c = F.vcu;

    PH_BEGIN
#if DBG_THRASH == 1
    dbg_thrash(F);
#endif
    prologue0(F); PH_END
    PH_BEGIN prologue1(F); PH_END

    layer_body<0>(F, args, bar, ph, lo, hi, ring, c, ctl);
    if (DBG_NLAYERS > 1) layer_body<1>(F, args, bar, ph, lo, hi, ring, c, ctl);
    if (DBG_NLAYERS > 2) layer_body<2>(F, args, bar, ph, lo, hi, ring, c, ctl);
    if (DBG_NLAYERS > 3) layer_body<3>(F, args, bar, ph, lo, hi, ring, c, ctl);
    for (int xb_ = 0; xb_ < DBG_XB; ++xb_) { PH_BEGIN PH_END }
    PH_BEGIN
#if DBG_THRASH == 2
    dbg_thrash(F); __syncthreads();
#endif
    final_out(F, DBG_NLAYERS - 1);
    if (ONE_LAUNCH && xb_ld(ctl + CW_BAR + XB_TMO) != 0u) {
        const float qn = __builtin_nanf(""); for (size_t i = (size_t)blockIdx.x * 512 + F.tid; i < (size_t)NL * D; i += (size_t)F.G * 512) F.out[i] = qn; }
    PH_END
}

static int count_phases() { int n = 2; for (int l = 0; l < DBG_NLAYERS; ++l) n += 9 + (((l & 1) && !DBG_NOMOE) ? 3 : 2); return n + 1 + DBG_XB; }
extern "C" void kernel_launch(void* const* d_in, const int* in_sizes, int n_in, void* d_out, int out_size, void* d_ws, size_t ws_size, hipStream_t stream) {
    static int grid = 0;
    if (grid == 0) {
        if (n_in != 39 || out_size != NL * D || ws_size < WS_END) { fprintf(stderr, "kernel_launch: unexpected shapes: n_in %d out %d ws %zu (need %zu)\n", n_in, out_size, ws_size, (size_t)WS_END); grid = -1; return; }
        int dev = 0, cus = 0, per_cu = 0;
        if (hipGetDevice(&dev) != hipSuccess || hipDeviceGetAttribute(&cus, hipDeviceAttributeMultiprocessorCount, dev) != hipSuccess) { grid = -1; return; }
        if (hipFuncSetAttribute((const void*)mega, hipFuncAttributeMaxDynamicSharedMemorySize, LDS_BYTES) != hipSuccess) { fprintf(stderr, "kernel_launch: hipFuncSetAttribute failed\n"); grid = -1; return; }
        if (hipOccupancyMaxActiveBlocksPerMultiprocessor(&per_cu, (const void*)mega, 512, LDS_BYTES) != hipSuccess || per_cu < 1) fprintf(stderr, "kernel_launch: occupancy query reports %d\n", per_cu);
        (void)hipGetLastError();
        grid = cus;
    }
    if (grid < 0) return;
    (void)hipMemsetAsync((char*)d_ws + WS_CTL, 0, CTL_BYTES, stream);
#ifdef DBG_MEMSET_LO
    (void)hipMemsetAsync((char*)d_ws + (size_t)DBG_MEMSET_LO * MiB, 0, (size_t)(DBG_MEMSET_HI - DBG_MEMSET_LO) * MiB, stream);
#endif
    Args a{};
    for (int i = 0; i < 39; ++i) a.in[i] = (const float*)d_in[i];
    a.out = (float*)d_out; a.ws = (unsigned char*)d_ws;
    const int nph = count_phases();
#if ONE_LAUNCH
    a.ph_lo = 0; a.ph_hi = nph;
    hipLaunchKernelGGL(mega, dim3(grid), dim3(512), LDS_BYTES, stream, a);
#else
    for (int p = 0; p < nph; ++p) { a.ph_lo = p; a.ph_hi = p + 1; hipLaunchKernelGGL(mega, dim3(grid), dim3(512), LDS_BYTES, stream, a); }
#endif
    const hipError_t le = hipPeekAtLastError();
    if (le != hipSuccess) fprintf(stderr, "kernel_launch: launch failed: %s\n", hipGetErrorName(le));
}
```

```cpp
#include <hip/hip_runtime.h>
#include <cstdio>
#include <cstdint>

#define DBG_REPA 0
#ifndef DBG_THRASH
#define DBG_THRASH 0
#endif
#ifdef DBG_LDSZERO
#define DBG_LDSCLR { for (int u_ = threadIdx.x; u_ < RING_BYTES / 16; u_ += 512) ((LAS u32x4*)F.lds)[u_] = (u32x4){0u, 0u, 0u, 0u}; __syncthreads(); }
#else
#define DBG_LDSCLR
#endif
#ifndef DBG_XB
#define DBG_XB 0
#endif
#ifndef DBG_SP
#define DBG_SP 99
#endif
#ifndef DBG_DUMP
#define DBG_DUMP 0
#endif
#ifndef DBG_REPMASK
#define DBG_REPMASK 0
#endif
#define LPH(k) for (int rep_ = 0; rep_ < 1 + ((DBG_REPMASK >> (k)) & 1); ++rep_)
#ifndef DBG_YSRC
#define DBG_YSRC WS_Y
#endif
#ifndef DBG_NOMOE
#define DBG_NOMOE 0
#endif
#ifndef DBG_NLAYERS
#define DBG_NLAYERS 4
#endif
#ifndef ONE_LAUNCH
#define ONE_LAUNCH 1
#endif

#define GAS __attribute__((address_space(1)))
#define LAS __attribute__((address_space(3)))
typedef unsigned short bf16;
typedef short bf16x8 __attribute__((ext_vector_type(8)));
typedef short s16x4 __attribute__((ext_vector_type(4)));
typedef float f32x4 __attribute__((ext_vector_type(4)));
typedef float f32x16 __attribute__((ext_vector_type(16)));
typedef unsigned u32x4 __attribute__((ext_vector_type(4)));
typedef unsigned u32x2 __attribute__((ext_vector_type(2)));
typedef int i32x8 __attribute__((ext_vector_type(8)));

constexpr int D = 1024, NL = 16384, NC = 256, NT = NL + NC, DEPTH = 4;
constexpr int DINP = 5888;
constexpr int FF = 2816, FF2 = 5632, NEXP = 8;
constexpr float EPS = 1e-6f;
constexpr int S5T = 32, S5ROWS = 768, S5K = 768;
constexpr int MOE_ROWS = 35328;

constexpr size_t MiB = 1u << 20;
constexpr size_t WS_CTL = 0, CTL_BYTES = 1 * MiB;
constexpr size_t WS_MOD = 1 * MiB;
constexpr size_t WS_ROPE = 2 * MiB;
constexpr size_t WS_S5P = 4 * MiB;
constexpr size_t WS_KTAB = 11 * MiB;
constexpr size_t WS_REC = 19 * MiB;
constexpr size_t WS_WIN = 20 * MiB;
constexpr size_t WS_WUQ = 32 * MiB;
constexpr size_t WS_WUKV = 33 * MiB;
constexpr size_t WS_WGLU = 34 * MiB;
constexpr size_t WS_WBR = 35 * MiB;
constexpr size_t WS_WOUT = 38 * MiB;
constexpr size_t WS_WGU = 40 * MiB;
constexpr size_t WS_WD = 128 * MiB;
constexpr size_t WS_WY = 172 * MiB;
constexpr size_t WS_WEND = 196 * MiB;
constexpr size_t WS_AG = 204 * MiB;
constexpr size_t WS_E = 240 * MiB;
constexpr size_t WS_Z = 264 * MiB;
constexpr size_t WS_M1 = 240 * MiB;
constexpr size_t WS_XS = 281 * MiB;
constexpr size_t WS_OA = 346 * MiB;
constexpr size_t WS_OB = WS_OA + (size_t)NT * 512 * 2;
constexpr size_t WS_OC = WS_OB + (size_t)NT * 512 * 2;
constexpr size_t WS_H = 346 * MiB;
constexpr size_t WS_R1 = 395 * MiB;
constexpr size_t WS_G = WS_R1;
constexpr size_t WS_PN = WS_G + (size_t)NT * 3072 * 2;
constexpr size_t WS_PA = WS_PN + (size_t)NT * 1536 * 2;
constexpr size_t WS_QRAW = WS_PA + (size_t)NT * 768 * 2;
constexpr size_t WS_KVRAW = WS_QRAW + (size_t)NT * 768 * 2;
constexpr size_t WS_ACT = WS_R1;
constexpr size_t WS_R2 = 623 * MiB;
constexpr size_t WS_QF = WS_R2;
constexpr size_t WS_KF = WS_QF + (size_t)8 * NT * 96 * 2;
constexpr size_t WS_VF = WS_KF + (size_t)8 * NT * 96 * 2;
constexpr size_t WS_NQ = WS_VF + (size_t)8 * NT * 64 * 2;
constexpr size_t WS_NK = WS_NQ + (size_t)8 * NT * 64 * 2;
constexpr size_t WS_HS = WS_R2;
constexpr size_t WS_Y = WS_HS + (size_t)MOE_ROWS * 1024 * 2;
constexpr size_t WS_PART = 762 * MiB;
constexpr size_t WS_Y2 = 774 * MiB;
constexpr size_t WS_M1C = 843 * MiB;
constexpr size_t WS_END = 845 * MiB;
static_assert(WS_KVRAW + (size_t)NT * 1024 * 2 <= WS_R2 && WS_ACT + (size_t)MOE_ROWS * 2816 * 2 <= WS_R2, "region 1");
static_assert(WS_NK + (size_t)8 * NT * 64 * 2 <= WS_END && WS_Y + (size_t)MOE_ROWS * 1024 * 2 <= WS_END, "region 2");
static_assert(WS_OC + (size_t)NT * 512 * 2 <= WS_R1 && WS_Z + (size_t)NT * 512 * 2 <= WS_XS && WS_M1 + (size_t)NT * 1024 * 2 <= WS_XS, "map");
constexpr int CW_BAR = 4096;
constexpr int CW_CNT = 16384;

constexpr int RING_BYTES = 131072, MISC_OFF = RING_BYTES + 320, LDS_BYTES = 147456;

#define LDS_WAIT() asm volatile("s_waitcnt lgkmcnt(0)" ::: "memory")
#define VM_WAIT() asm volatile("s_waitcnt vmcnt(0)" ::: "memory")
#define SBAR() __builtin_amdgcn_sched_barrier(0)
__device__ __forceinline__ unsigned cvtpk(float lo, float hi) { unsigned r; asm volatile("v_cvt_pk_bf16_f32 %0, %1, %2" : "=v"(r) : "v"(lo), "v"(hi)); return r; }
__device__ __forceinline__ float bflo(unsigned w) { return __uint_as_float(w << 16); }
__device__ __forceinline__ float bfhi(unsigned w) { return __uint_as_float(w & 0xffff0000u); }
__device__ __forceinline__ bf16 f2bf(float f) { return (bf16)(cvtpk(f, 0.f) & 0xffffu); }
__device__ __forceinline__ float bf2f(bf16 b) { return __uint_as_float(((unsigned)b) << 16); }
__device__ __forceinline__ void unpack8(const u32x4 w, float (&f)[8]) { f[0] = bflo(w.x); f[1] = bfhi(w.x); f[2] = bflo(w.y); f[3] = bfhi(w.y); f[4] = bflo(w.z); f[5] = bfhi(w.z); f[6] = bflo(w.w); f[7] = bfhi(w.w); }
__device__ __forceinline__ u32x4 pack8(const f32x4 a, const f32x4 b) { u32x4 w; w.x = cvtpk(a[0], a[1]); w.y = cvtpk(a[2], a[3]); w.z = cvtpk(b[0], b[1]); w.w = cvtpk(b[2], b[3]); return w; }
__device__ __forceinline__ f32x4 ld4bf(const bf16* p) { const u32x2 w = *(const u32x2*)p; return (f32x4){bflo(w.x), bfhi(w.x), bflo(w.y), bfhi(w.y)}; }
__device__ __forceinline__ void st4bf(bf16* p, const f32x4 v) { u32x2 w; w.x = cvtpk(v[0], v[1]); w.y = cvtpk(v[2], v[3]); *(u32x2*)p = w; }
__device__ __forceinline__ float fsigmoid(float x) { return __builtin_amdgcn_rcpf(1.f + __builtin_amdgcn_exp2f(-1.4426950408889634f * x)); }
__device__ __forceinline__ float fsilu(float x) { return x * fsigmoid(x); }
__device__ __forceinline__ float fgelu_tanh(float x) { return x * fsigmoid(1.5957691216057308f * (x + 0.044715f * x * x * x)); }
__device__ __forceinline__ float wave_sum(float v) {
#pragma unroll
    for (int o = 1; o < 64; o <<= 1) v += __shfl_xor(v, o);
    return v;
}
__device__ __forceinline__ void sincos_rad(float a, float& s, float& c) {
    float rev = a * 0.15915494309189535f; rev = rev - floorf(rev);
    s = __builtin_amdgcn_sinf(rev); c = __builtin_amdgcn_cosf(rev);
}

#define XB_TMO      128
#define XB_XCNT(j)  (256  + 64 * (j))
#define XB_XSUB(j)  (1280 + 64 * (j))
#define XB_XGEN(j)  (2304 + 64 * (j))
#define XB_TOP      3328
#define XB_TOPGEN   3392
#define XCD_BAR_WORDS 3456
#define XB_SPIN_CAP (1u << 22)

__device__ __forceinline__ unsigned xb_ld(unsigned* p)              { return __hip_atomic_load(p, __ATOMIC_RELAXED, __HIP_MEMORY_SCOPE_AGENT); }
__device__ __forceinline__ unsigned xb_add(unsigned* p, unsigned v) { return __hip_atomic_fetch_add(p, v, __ATOMIC_RELAXED, __HIP_MEMORY_SCOPE_AGENT); }
__device__ __forceinline__ unsigned xb_xcc_id() { return (unsigned)__builtin_amdgcn_s_getreg((3 << 11) | 20) & 0xFu; }
#define XB_SPIN(cond, bar) do { unsigned _sp = 0; while (cond) { __builtin_amdgcn_s_sleep(1); \
    if ((++_sp & 255u) == 0u) { if (xb_ld(&(bar)[XB_TMO])) break; if (_sp > XB_SPIN_CAP) { atomicAdd(&(bar)[XB_TMO], 1u); break; } } } } while (0)

struct XcdBarrier { unsigned* bar; unsigned x; volatile LAS unsigned* st; };
__device__ __forceinline__ XcdBarrier xcd_barrier_post(unsigned* bar, volatile LAS unsigned* st) {
    XcdBarrier b; b.bar = bar; b.x = xb_xcc_id(); b.st = st;
    if (threadIdx.x == 0) (void)xb_add(&bar[XB_XCNT(b.x)], 1u);
    return b;
}
__device__ __forceinline__ void xcd_barrier_complete(unsigned* bar, unsigned x, unsigned& nloc, unsigned& nx) {
    const unsigned G = gridDim.x * gridDim.y * gridDim.z;
    unsigned sum, cnt, mine, sp = 0u;
    for (;;) {
        sum = 0u; cnt = 0u; mine = 0u;
#pragma unroll
        for (unsigned j = 0; j < 16; ++j) { const unsigned c = xb_ld(&bar[XB_XCNT(j)]); sum += c; cnt += (c > 0u) ? 1u : 0u; mine = (j == x) ? c : mine; }
        if (sum == G) break;
        __builtin_amdgcn_s_sleep(1);
        if ((++sp & 255u) == 0u) { if (xb_ld(&bar[XB_TMO])) break; if (sp > XB_SPIN_CAP) { atomicAdd(&bar[XB_TMO], 1u); break; } }
    }
    nloc = mine > 0u ? mine : 1u; nx = cnt > 0u ? cnt : 1u;
}
__device__ __forceinline__ void xcd_barrier(const XcdBarrier& b) {
    asm volatile("s_waitcnt vmcnt(0)" ::: "memory");
    __syncthreads();
    if (threadIdx.x == 0) {
        unsigned* bar = b.bar;
        __builtin_amdgcn_s_waitcnt(0);
        unsigned nloc = b.st[0], nx = b.st[1];
        if (nloc == 0u) { xcd_barrier_complete(bar, b.x, nloc, nx); b.st[0] = nloc; b.st[1] = nx; }
        const unsigned old = xb_add(&bar[XB_XSUB(b.x)], 1u);
        const unsigned gen = old / nloc;
        if (old + 1u == (gen + 1u) * nloc) {
            __builtin_amdgcn_fence(__ATOMIC_RELEASE, "agent");
            asm volatile("s_waitcnt vmcnt(0)" ::: "memory");
            const unsigned og = xb_add(&bar[XB_TOP], 1u);
            const unsigned tg = og / nx;
            if (og + 1u == (tg + 1u) * nx) xb_add(&bar[XB_TOPGEN], 1u);
            else XB_SPIN(xb_ld(&bar[XB_TOPGEN]) == tg, bar);
            __builtin_amdgcn_fence(__ATOMIC_ACQUIRE, "agent");
            xb_add(&bar[XB_XGEN(b.x)], 1u);
            asm volatile("s_waitcnt vmcnt(0)" ::: "memory");
        } else {
            XB_SPIN(xb_ld(&bar[XB_XGEN(b.x)]) == gen, bar);
            __builtin_amdgcn_fence(__ATOMIC_ACQUIRE, "agent");
            asm volatile("s_waitcnt vmcnt(0)" ::: "memory");
        }
    }
    __syncthreads();
}

namespace pg8 {
constexpr int BM = 256, BK = 64, HALF = 128, HTB = HALF * BK * 2, NXCD = 8, WGM = 8;
__host__ __device__ __forceinline__ int lds_byte(int r, int c) { const int st = (r >> 4) * 2 + (c >> 5), rr = r & 15, cc = c & 31, ob = rr * 64 + cc * 2; return st * 1024 + (ob ^ (((ob >> 9) & 1) << 5)); }
__host__ __device__ __forceinline__ void stage_rc(int b, int& R, int& C) { const int st = b / 1024, sb = b % 1024, swz = sb ^ (((sb >> 9) & 1) << 5); R = (st >> 1) * 16 + swz / 64; C = (st & 1) * 32 + (swz % 64) / 2; }
__host__ __device__ __forceinline__ int perm32(int rho) { const int n = rho >> 4, i = rho & 15; return 8 * (i >> 2) + 4 * n + (i & 3); }
struct Unit { int pm, pn, aux; };

struct TileOrder {
    int nM, nN, nwg, G, c;
    __device__ __forceinline__ void init(int nM_, int nN_, int G_, int c_) { nM = nM_; nN = nN_; nwg = nM * nN; G = G_; c = c_; }
    __device__ __forceinline__ bool tile(int i, int& pm, int& pn) const {
        const long L = (long)i * G + c; if (L >= nwg) return false;
        int wgid = (int)L; { const int q = nwg / NXCD, r = nwg % NXCD, xcd = wgid % NXCD, off = wgid / NXCD; wgid = (xcd < r ? xcd * (q + 1) : r * (q + 1) + (xcd - r) * q) + off; }
        const int nig = WGM * nN, gid = wgid / nig, fm = gid * WGM, gsz = (nM - fm) < WGM ? (nM - fm) : WGM;
        pm = fm + ((wgid % nig) % gsz); pn = (wgid % nig) / gsz; return true;
    }
};

typedef int i32x4_ __attribute__((ext_vector_type(4)));
__device__ __forceinline__ i32x8 cat8(const bf16x8 a, const bf16x8 b) { const i32x4_ x = __builtin_bit_cast(i32x4_, a), y = __builtin_bit_cast(i32x4_, b);
    return __builtin_shufflevector(x, y, 0, 1, 2, 3, 4, 5, 6, 7); }
__device__ __forceinline__ void mfma8_acc(f32x4& acc, const i32x8 a, const i32x8 b, const int sa, const int sb) {
    asm volatile("v_mfma_scale_f32_16x16x128_f8f6f4 %0, %1, %2, %0, %3, %4 op_sel_hi:[0,0,0]" : "+v"(acc) : "v"(a), "v"(b), "v"(sa), "v"(sb));
}
template <bool F8 = false, class Epi, class Sched>
__device__ __forceinline__ void gemm_phase(LAS unsigned char* lds, const int K, const int lda, const int ldb, const Sched& S, const Epi& E) {
    int tid_ = threadIdx.x; asm volatile("" : "+v"(tid_));
    const int tid = tid_, wid = __builtin_amdgcn_readfirstlane(tid >> 6), lane = tid & 63, wr = wid >> 2, wc = wid & 3, fr = lane & 15, fq = lane >> 4;
    const int nt = K / BK;
    unsigned voffA[2], voffB[2];
#pragma unroll
    for (int i = 0; i < 2; ++i) { int R, C; stage_rc(tid * 16 + i * 8192, R, C); const int Rb = (R & ~31) + perm32(R & 31);
        voffA[i] = (unsigned)(R * lda + C) * 2u; voffB[i] = (unsigned)(Rb * ldb + C) * 2u; }
    const size_t kstep = (size_t)(BK * 2);
    const size_t hstepA = (size_t)HALF * lda * 2, hstepB = (size_t)HALF * ldb * 2;
    const unsigned ldsw = (unsigned)wid * 1024u;
    const int aoff = lds_byte(wr * 64 + fr, fq * 8), boff = lds_byte(wc * 32 + fr, fq * 8);
#define PG8_SA(b, h) (((b) * 2 + (h)) * HTB)
#define PG8_SB(b, h) ((4 + (b) * 2 + (h)) * HTB)
#define PG8_STAGE(bufoff, gbase, voff) do { _Pragma("unroll") for (int _i = 0; _i < 2; ++_i) \
        __builtin_amdgcn_global_load_lds((const unsigned*)((const char*)(gbase) + (voff)[_i]), (LAS unsigned*)(lds + (bufoff) + ldsw + _i * 8192), 16, 0, 0); } while (0)
#define PG8_LDA(dst, b, h) do { _Pragma("unroll") for (int m = 0; m < 4; ++m) _Pragma("unroll") for (int k = 0; k < 2; ++k) dst[m][k] = *(const LAS bf16x8*)(lds + PG8_SA(b, h) + aoff + m * 2048 + k * 1024); } while (0)
#define PG8_LDB(dst, b, h) do { _Pragma("unroll") for (int n = 0; n < 2; ++n) _Pragma("unroll") for (int k = 0; k < 2; ++k) dst[n][k] = *(const LAS bf16x8*)(lds + PG8_SB(b, h) + boff + n * 2048 + k * 1024); } while (0)
#define PG8_MMA(ai, bj, At, Bt) do { __builtin_amdgcn_s_setprio(1); _Pragma("unroll") for (int m = 0; m < 4; ++m) _Pragma("unroll") for (int n = 0; n < 2; ++n) { \
        if constexpr (F8) mfma8_acc(acc[ai][bj][m][n], cat8(Bt[n][0], Bt[n][1]), cat8(At[m][0], At[m][1]), 122, 127); \
        else { _Pragma("unroll") for (int k = 0; k < 2; ++k) acc[ai][bj][m][n] = __builtin_amdgcn_mfma_f32_16x16x32_bf16(Bt[n][k], At[m][k], acc[ai][bj][m][n], 0, 0, 0); } } __builtin_amdgcn_s_setprio(0); } while (0)
#define PG8_LDA2(dst, b, h, m0) do { _Pragma("unroll") for (int mm = 0; mm < 2; ++mm) _Pragma("unroll") for (int k = 0; k < 2; ++k) dst[mm][k] = *(const LAS bf16x8*)(lds + PG8_SA(b, h) + aoff + ((m0) + mm) * 2048 + k * 1024); } while (0)
#define PG8_MMA2(ai, bj, m0, A2, Bt) do { __builtin_amdgcn_s_setprio(1); _Pragma("unroll") for (int mm = 0; mm < 2; ++mm) _Pragma("unroll") for (int n = 0; n < 2; ++n) \
        mfma8_acc(acc[ai][bj][(m0) + mm][n], cat8(Bt[n][0], Bt[n][1]), cat8(A2[mm][0], A2[mm][1]), 122, 127); __builtin_amdgcn_s_setprio(0); } while (0)
#define PG8_LDAX(b, h) do { PG8_LDA(At, b, h); } while (0)
#define PG8_MMAX(ai, b, h) do { PG8_MMA(ai, 0, At, B0); PG8_MMA(ai, 1, At, B1); } while (0)
#define PG8_WAIT_V(n) asm volatile("s_waitcnt vmcnt(" #n ")" ::: "memory")
#define PG8_WAIT_L(n) asm volatile("s_waitcnt lgkmcnt(" #n ")" ::: "memory")
#define PG8_BAR __builtin_amdgcn_s_barrier()
#define PG8_SCHED __builtin_amdgcn_sched_barrier(0)
    Unit cur, nxt; int ui = 0;
    if (!S.next(0, cur)) return;
    f32x4 acc[2][2][4][2];
#pragma unroll
    for (int a = 0; a < 2; ++a)
#pragma unroll
        for (int b = 0; b < 2; ++b)
#pragma unroll
            for (int m = 0; m < 4; ++m)
#pragma unroll
                for (int n = 0; n < 2; ++n) { acc[a][b][m][n] = (f32x4){0.f, 0.f, 0.f, 0.f}; }
    bf16x8 At[4][2], B0[2][2], B1[2][2];
    const char* cA = S.abase(cur); const char* cB = S.bbase(cur);
    PG8_STAGE(PG8_SB(0, 0), cB, voffB); PG8_STAGE(PG8_SB(0, 1), cB + hstepB, voffB); PG8_STAGE(PG8_SA(0, 0), cA, voffA); PG8_STAGE(PG8_SA(0, 1), cA + hstepA, voffA);
    if (wr == 1) PG8_BAR;
    PG8_WAIT_V(2); PG8_BAR;
    PG8_STAGE(PG8_SB(1, 0), cB + kstep, voffB); PG8_STAGE(PG8_SA(1, 0), cA + kstep, voffA); PG8_STAGE(PG8_SB(1, 1), cB + hstepB + kstep, voffB);
    PG8_WAIT_V(6); PG8_BAR;
    for (;;) {
        const bool has_next = S.next(ui + 1, nxt);
        const char* nA = has_next ? S.abase(nxt) : cA; const char* nB = has_next ? S.bbase(nxt) : cB;
#pragma clang loop unroll(disable)
        for (int t = 0; t < nt; t += 2) {
            const bool last = (t == nt - 2);
            const char* a1 = cA + (size_t)(t + 1) * kstep;
            const char* a2 = last ? nA : cA + (size_t)(t + 2) * kstep; const char* b2 = last ? nB : cB + (size_t)(t + 2) * kstep;
            const char* a3 = a2 + kstep; const char* b3 = b2 + kstep;
            PG8_LDB(B0, 0, 0); PG8_LDB(B1, 0, 1); PG8_SCHED; PG8_LDAX(0, 0); PG8_STAGE(PG8_SA(1, 1), a1 + hstepA, voffA);
            PG8_WAIT_V(8); PG8_WAIT_L(0); PG8_BAR; PG8_MMAX(0, 0, 0); PG8_BAR; PG8_SCHED;
            PG8_LDAX(0, 1); PG8_STAGE(PG8_SB(0, 0), b2, voffB); PG8_STAGE(PG8_SB(0, 1), b2 + hstepB, voffB); PG8_STAGE(PG8_SA(0, 0), a2, voffA);
            PG8_WAIT_V(8); PG8_WAIT_L(0); PG8_BAR; PG8_MMAX(1, 0, 1); PG8_BAR; PG8_SCHED;
            PG8_LDB(B0, 1, 0); PG8_LDB(B1, 1, 1); PG8_SCHED; PG8_LDAX(1, 0); PG8_STAGE(PG8_SA(0, 1), a2 + hstepA, voffA);
            PG8_WAIT_V(8); PG8_WAIT_L(0); PG8_BAR; PG8_MMAX(0, 1, 0); PG8_BAR; PG8_SCHED;
            PG8_LDAX(1, 1); PG8_STAGE(PG8_SB(1, 0), b3, voffB); PG8_STAGE(PG8_SB(1, 1), b3 + hstepB, voffB); PG8_STAGE(PG8_SA(1, 0), a3, voffA);
            PG8_WAIT_V(8); PG8_WAIT_L(0); PG8_BAR; PG8_MMAX(1, 1, 1); PG8_BAR; PG8_SCHED;
        }
        if (wr == 0) PG8_BAR;
        if constexpr (F8) asm volatile("s_nop 15\n\ts_nop 15" ::: "memory");
        E(acc, cur, wr, wc, fr, fq);
        if (!has_next) break;
#pragma unroll
        for (int a = 0; a < 2; ++a)
#pragma unroll
            for (int b = 0; b < 2; ++b)
#pragma unroll
                for (int m = 0; m < 4; ++m)
#pragma unroll
                    for (int n = 0; n < 2; ++n) { acc[a][b][m][n] = (f32x4){0.f, 0.f, 0.f, 0.f}; }
        cur = nxt; cA = nA; cB = nB; ++ui;
        if (wr == 1) PG8_BAR;
    }
    PG8_WAIT_V(0);
    PG8_BAR;
#undef PG8_SA
#undef PG8_SB
#undef PG8_STAGE
#undef PG8_LDA
#undef PG8_LDB
#undef PG8_MMAX
#undef PG8_LDAX
#undef PG8_MMA2
#undef PG8_LDA2
#undef PG8_MMA
#undef PG8_WAIT_V
#undef PG8_WAIT_L
#undef PG8_BAR
#undef PG8_SCHED
}

struct SchedPlain {
    TileOrder T; const bf16* A; const bf16* Bt; int lda, ldb, pm0;
    __device__ __forceinline__ bool next(int i, Unit& u) const { int pm, pn; if (!T.tile(i, pm, pn)) return false; u.pm = pm + pm0; u.pn = pn; u.aux = 0; return true; }
    __device__ __forceinline__ const char* abase(const Unit& u) const { return (const char*)(A + (size_t)u.pm * 256 * lda); }
    __device__ __forceinline__ const char* bbase(const Unit& u) const { return (const char*)(Bt + (size_t)u.pn * 256 * ldb); }
};
struct SchedMerge {
    TileOrder T; const bf16* O; const bf16* W; int pm0;
    __device__ __forceinline__ bool next(int i, Unit& u) const { int pm, pn; if (!T.tile(i / 3, pm, pn)) return false; u.pm = pm + pm0; u.pn = pn; u.aux = i % 3; return true; }
    __device__ __forceinline__ const char* abase(const Unit& u) const { return (const char*)(O + ((size_t)u.aux * NT + (size_t)u.pm * 256) * 512); }
    __device__ __forceinline__ const char* bbase(const Unit& u) const { return (const char*)(W + ((size_t)u.aux * 1024 + (size_t)u.pn * 256) * 512); }
};
struct SchedS5 {
    int nrt, nct, G, c; const bf16* A; const bf16* W; int brows, ldb;
    __device__ __forceinline__ bool next(int i, Unit& u) const { const int L = i * G + c; if (L >= 32 * nrt * nct) return false; u.aux = L / (nrt * nct); const int r = L % (nrt * nct); u.pm = r / nct; u.pn = r % nct; return true; }
    __device__ __forceinline__ const char* abase(const Unit& u) const { return (const char*)(A + ((size_t)u.aux * S5ROWS + (size_t)u.pm * 256) * S5K); }
    __device__ __forceinline__ const char* bbase(const Unit& u) const { return (const char*)(W + ((size_t)u.aux * brows + (size_t)u.pn * 256) * ldb); }
};
struct SchedMoe {
    TileOrder T; const bf16* A; const bf16* W; int lda, ldb; size_t wstride; const LAS int* tstart;
    __device__ __forceinline__ bool next(int i, Unit& u) const { int pm, pn; if (!T.tile(i, pm, pn)) return false; u.pm = pm; u.pn = pn; u.aux = __builtin_amdgcn_readfirstlane(tstart[pm]); return true; }
    __device__ __forceinline__ const char* abase(const Unit& u) const { return (const char*)(A + (size_t)u.pm * 256 * lda); }
    __device__ __forceinline__ const char* bbase(const Unit& u) const { return (const char*)(W + (size_t)u.aux * wstride + (size_t)u.pn * 256 * ldb); }
};

#define EPI_ROWS(u) const int row0 = (u).pm * 256 + wr * 64 + fr; const int cw0 = wc * 32 + 8 * fq;
struct EpiWin {
    bf16 *pA, *pN, *AG, *Gt;
    __device__ __forceinline__ void operator()(const f32x4 (&acc)[2][2][4][2], const Unit& u, int wr, int wc, int fr, int fq) const {
        EPI_ROWS(u) const int pn = u.pn;
#pragma unroll
        for (int ai = 0; ai < 2; ++ai)
#pragma unroll
            for (int m = 0; m < 4; ++m) { const int row = row0 + ai * 128 + m * 16;
#pragma unroll
                for (int bj = 0; bj < 2; ++bj) { const int cw = cw0 + bj * 128; const f32x4 v0 = acc[ai][bj][m][0], v1 = acc[ai][bj][m][1];
                    if (pn < 3) *(u32x4*)(pA + (size_t)row * 768 + pn * 256 + cw) = pack8(v0, v1);
                    else if (pn < 9) *(u32x4*)(pN + (size_t)row * 1536 + (pn - 3) * 256 + cw) = pack8(v0, v1);
                    else if (pn < 11) { const int ucol = (pn - 9) * 256 + cw, g = ucol >> 4, c = ucol & 15;
                        const int tk = row < NC ? row : row - NC; const int cr = (row < NC ? 512 : 0) + (tk >> 5), j = tk & 31;
                        *(u32x4*)(AG + ((size_t)g * S5ROWS + cr) * S5K + j * 16 + c) = pack8(v0, v1); }
                    else { f32x4 s0, s1;
#pragma unroll
                        for (int q = 0; q < 4; ++q) { s0[q] = fsigmoid(v0[q]); s1[q] = fsigmoid(v1[q]); }
                        *(u32x4*)(Gt + (size_t)row * 3072 + (pn - 11) * 256 + cw) = pack8(s0, s1); } } }
    }
};
struct EpiBf16 {
    bf16* O; int ldc;
    __device__ __forceinline__ void operator()(const f32x4 (&acc)[2][2][4][2], const Unit& u, int wr, int wc, int fr, int fq) const {
        EPI_ROWS(u)
#pragma unroll
        for (int ai = 0; ai < 2; ++ai)
#pragma unroll
            for (int m = 0; m < 4; ++m) { const int row = row0 + ai * 128 + m * 16;
#pragma unroll
                for (int bj = 0; bj < 2; ++bj) *(u32x4*)(O + (size_t)row * ldc + u.pn * 256 + cw0 + bj * 128) = pack8(acc[ai][bj][m][0], acc[ai][bj][m][1]); }
    }
};
struct EpiS5E {
    float* Eo;
    __device__ __forceinline__ void operator()(const f32x4 (&acc)[2][2][4][2], const Unit& u, int wr, int wc, int fr, int fq) const {
        EPI_ROWS(u)
#pragma unroll
        for (int ai = 0; ai < 2; ++ai)
#pragma unroll
            for (int m = 0; m < 4; ++m) { const int row = row0 + ai * 128 + m * 16;
#pragma unroll
                for (int bj = 0; bj < 2; ++bj) { float* p = Eo + ((size_t)u.aux * S5ROWS + row) * 256 + cw0 + bj * 128; *(f32x4*)p = acc[ai][bj][m][0]; *(f32x4*)(p + 4) = acc[ai][bj][m][1]; } }
    }
};
struct EpiS5Y {
    bf16* Z;
    __device__ __forceinline__ void operator()(const f32x4 (&acc)[2][2][4][2], const Unit& u, int wr, int wc, int fr, int fq) const {
        EPI_ROWS(u)
#pragma unroll
        for (int ai = 0; ai < 2; ++ai)
#pragma unroll
            for (int m = 0; m < 4; ++m) { const int cr = row0 + ai * 128 + m * 16;
                if (cr < 520) {
#pragma unroll
                for (int bj = 0; bj < 2; ++bj) { const int n = u.pn * 256 + cw0 + bj * 128, t = n >> 4, c = n & 15;
                    const int tok = cr < 512 ? NC + cr * 32 + t : (cr - 512) * 32 + t; f32x4 a, b;
#pragma unroll
                    for (int q = 0; q < 4; ++q) { a[q] = fgelu_tanh(acc[ai][bj][m][0][q]); b[q] = fgelu_tanh(acc[ai][bj][m][1][q]); }
                    *(u32x4*)(Z + (size_t)tok * 512 + u.aux * 16 + c) = pack8(a, b); } } }
    }
};
struct EpiGlu {
    const bf16* Z; bf16* O; const float* bias;
    __device__ __forceinline__ void operator()(const f32x4 (&acc)[2][2][4][2], const Unit& u, int wr, int wc, int fr, int fq) const {
        EPI_ROWS(u)
#pragma unroll
        for (int bj = 0; bj < 2; ++bj) { const int col = u.pn * 256 + cw0 + bj * 128; const f32x4 b0 = *(const f32x4*)(bias + col), b1 = *(const f32x4*)(bias + col + 4);
#pragma unroll
            for (int ai = 0; ai < 2; ++ai)
#pragma unroll
                for (int m = 0; m < 4; ++m) { const int row = row0 + ai * 128 + m * 16; float z[8]; unpack8(*(const u32x4*)(Z + (size_t)row * 512 + col), z); f32x4 a, b;
#pragma unroll
                    for (int q = 0; q < 4; ++q) { a[q] = z[q] * fsigmoid(acc[ai][bj][m][0][q] + b0[q]); b[q] = z[4 + q] * fsigmoid(acc[ai][bj][m][1][q] + b1[q]); }
                    *(u32x4*)(O + (size_t)row * 512 + col) = pack8(a, b); } }
    }
};
struct EpiMerge {
    const bf16* Gt; bf16* M1;
    __device__ __forceinline__ void operator()(const f32x4 (&acc)[2][2][4][2], const Unit& u, int wr, int wc, int fr, int fq) const {
        EPI_ROWS(u) const int br = u.aux;
#pragma unroll
        for (int ai = 0; ai < 2; ++ai)
#pragma unroll
            for (int m = 0; m < 4; ++m) { const int row = row0 + ai * 128 + m * 16;
#pragma unroll
                for (int bj = 0; bj < 2; ++bj) { const int col = u.pn * 256 + cw0 + bj * 128; float g[8]; unpack8(*(const u32x4*)(Gt + (size_t)row * 3072 + br * 1024 + col), g);
                    f32x4 a, b;
#pragma unroll
                    for (int q = 0; q < 4; ++q) { a[q] = g[q] * acc[ai][bj][m][0][q]; b[q] = g[4 + q] * acc[ai][bj][m][1][q]; }
                    bf16* mp = M1 + (size_t)row * 1024 + col;
                    if (br) { float o[8]; unpack8(*(const u32x4*)mp, o);
#pragma unroll
                        for (int q = 0; q < 4; ++q) { a[q] += o[q]; b[q] += o[4 + q]; } }
                    *(u32x4*)mp = pack8(a, b); } }
    }
};
struct EpiResid {
    bf16* xs; const float* ga_l; const float* ga_c;
    __device__ __forceinline__ void operator()(const f32x4 (&acc)[2][2][4][2], const Unit& u, int wr, int wc, int fr, int fq) const {
        EPI_ROWS(u) const float* ga = u.pm == 0 ? ga_c : ga_l;
#pragma unroll
        for (int bj = 0; bj < 2; ++bj) { const int col = u.pn * 256 + cw0 + bj * 128; const f32x4 g0 = *(const f32x4*)(ga + col), g1 = *(const f32x4*)(ga + col + 4);
#pragma unroll
            for (int ai = 0; ai < 2; ++ai)
#pragma unroll
                for (int m = 0; m < 4; ++m) { const int row = row0 + ai * 128 + m * 16; bf16* p = xs + (size_t)row * 1024 + col;
                    float x[8]; unpack8(*(const u32x4*)p, x); const f32x4 x0 = {x[0], x[1], x[2], x[3]}, x1 = {x[4], x[5], x[6], x[7]};
                    *(u32x4*)p = pack8(x0 + g0 * acc[ai][bj][m][0], x1 + g1 * acc[ai][bj][m][1]); } }
    }
};
struct SchedMoeDown {
    TileOrder T; const bf16* A; const bf16* W; const LAS int* tstart;
    __device__ __forceinline__ bool next(int i, Unit& u) const { int pm, pn; if (!T.tile(i, pm, pn)) return false; u.pm = pm; u.pn = pn; u.aux = __builtin_amdgcn_readfirstlane(tstart[pm]); return true; }
    __device__ __forceinline__ const char* abase(const Unit& u) const { return (const char*)(A + (size_t)u.pm * 256 * FF + (u.pn >> 2) * 1408); }
    __device__ __forceinline__ const char* bbase(const Unit& u) const { return (const char*)(W + (size_t)u.aux * D * FF + (size_t)(u.pn & 3) * 256 * FF + (u.pn >> 2) * 1408); }
};
struct EpiMoeY {
    bf16* Y0; bf16* Y1;
    __device__ __forceinline__ void operator()(const f32x4 (&acc)[2][2][4][2], const Unit& u, int wr, int wc, int fr, int fq) const {
        EPI_ROWS(u) bf16* O = (u.pn >> 2) ? Y1 : Y0; const int colt = (u.pn & 3) * 256;
#pragma unroll
        for (int ai = 0; ai < 2; ++ai)
#pragma unroll
            for (int m = 0; m < 4; ++m) { const int row = row0 + ai * 128 + m * 16;
#pragma unroll
                for (int bj = 0; bj < 2; ++bj) *(u32x4*)(O + (size_t)row * D + colt + cw0 + bj * 128) = pack8(acc[ai][bj][m][0], acc[ai][bj][m][1]); }
    }
};
struct SchedCtxK {
    int nsl, nks, G, c; const bf16* A; size_t astride; const bf16* Bt; int lda, ldb;
    __device__ __forceinline__ bool next(int i, Unit& u) const { const int L = i * G + c; if (L >= 4 * nsl) return false; u.pm = 0; u.pn = L & 3; u.aux = L >> 2; return true; }
    __device__ __forceinline__ const char* abase(const Unit& u) const { return (const char*)(A + (size_t)(u.aux / nks) * astride + (size_t)(u.aux % nks) * 256); }
    __device__ __forceinline__ const char* bbase(const Unit& u) const { return (const char*)(Bt + (size_t)u.pn * 256 * ldb + (size_t)(u.aux % nks) * 256); }
};
struct SchedCtxMerge {
    int G, c; const bf16* O; const bf16* W;
    __device__ __forceinline__ bool next(int i, Unit& u) const { const int L = i * G + c; if (L >= 12) return false; u.pm = 0; u.pn = L & 3; u.aux = L >> 2; return true; }
    __device__ __forceinline__ const char* abase(const Unit& u) const { return (const char*)(O + (size_t)u.aux * NT * 512); }
    __device__ __forceinline__ const char* bbase(const Unit& u) const { return (const char*)(W + ((size_t)u.aux * 1024 + (size_t)u.pn * 256) * 512); }
};
struct EpiMergeCtx {
    const bf16* Gt; bf16* M1C;
    __device__ __forceinline__ void operator()(const f32x4 (&acc)[2][2][4][2], const Unit& u, int wr, int wc, int fr, int fq) const {
        EPI_ROWS(u) const int br = u.aux;
#pragma unroll
        for (int ai = 0; ai < 2; ++ai)
#pragma unroll
            for (int m = 0; m < 4; ++m) { const int row = row0 + ai * 128 + m * 16;
#pragma unroll
                for (int bj = 0; bj < 2; ++bj) { const int col = u.pn * 256 + cw0 + bj * 128; float g[8]; unpack8(*(const u32x4*)(Gt + (size_t)row * 3072 + br * 1024 + col), g);
                    f32x4 a, b;
#pragma unroll
                    for (int q = 0; q < 4; ++q) { a[q] = g[q] * acc[ai][bj][m][0][q]; b[q] = g[4 + q] * acc[ai][bj][m][1][q]; }
                    *(u32x4*)(M1C + ((size_t)br * 256 + row) * 1024 + col) = pack8(a, b); } }
    }
};
struct EpiResidPart {
    float* part; const float* ga;
    __device__ __forceinline__ void operator()(const f32x4 (&acc)[2][2][4][2], const Unit& u, int wr, int wc, int fr, int fq) const {
        EPI_ROWS(u)
#pragma unroll
        for (int bj = 0; bj < 2; ++bj) { const int col = u.pn * 256 + cw0 + bj * 128; const f32x4 g0 = *(const f32x4*)(ga + col), g1 = *(const f32x4*)(ga + col + 4);
#pragma unroll
            for (int ai = 0; ai < 2; ++ai)
#pragma unroll
                for (int m = 0; m < 4; ++m) { const int row = row0 + ai * 128 + m * 16; float* p = part + ((size_t)u.aux * 256 + row) * 1024 + col;
                    *(f32x4*)p = g0 * acc[ai][bj][m][0]; *(f32x4*)(p + 4) = g1 * acc[ai][bj][m][1]; } }
    }
};
struct EpiUp {
    bf16* Act;
    __device__ __forceinline__ void operator()(const f32x4 (&acc)[2][2][4][2], const Unit& u, int wr, int wc, int fr, int fq) const {
        EPI_ROWS(u)
#pragma unroll
        for (int ai = 0; ai < 2; ++ai)
#pragma unroll
            for (int m = 0; m < 4; ++m) { const int row = row0 + ai * 128 + m * 16; f32x4 a, b;
#pragma unroll
                for (int q = 0; q < 4; ++q) { a[q] = fsilu(acc[ai][0][m][0][q]) * acc[ai][1][m][0][q]; b[q] = fsilu(acc[ai][0][m][1][q]) * acc[ai][1][m][1][q]; }
                *(u32x4*)(Act + (size_t)row * FF + u.pn * 128 + cw0) = pack8(a, b); }
    }
};
}

namespace att {
constexpr float THR = 8.f;
__device__ __forceinline__ int crow(int r, int hi) { return (r & 3) + 8 * (r >> 2) + 4 * hi; }
template <int DQK> struct Cst { static constexpr float SCALE = DQK == 96 ? 0.10206207261596575f : 0.125f; static constexpr float C = SCALE * 1.4426950408889634f; };

__device__ __forceinline__ void partialSM(f32x16& p0) {
#pragma unroll
    for (int r = 0; r < 16; ++r) p0[r] = __builtin_amdgcn_exp2f(p0[r]);
}
__device__ __forceinline__ void finishSM(f32x16& p0, f32x16& p1, float& l_reg, bf16x8& pa0, bf16x8& pa1, bf16x8& pa2, bf16x8& pa3) {
#pragma unroll
    for (int r = 0; r < 16; ++r) p1[r] = __builtin_amdgcn_exp2f(p1[r]);
    float ps = 0;
#pragma unroll
    for (int r = 0; r < 16; ++r) ps += p0[r];
#pragma unroll
    for (int r = 0; r < 16; ++r) ps += p1[r];
    { auto rr = __builtin_amdgcn_permlane32_swap(__float_as_uint(ps), __float_as_uint(ps), false, false);
      ps = __uint_as_float(rr[0]) + __uint_as_float(rr[1]); }
    l_reg += ps;
#define PK4(P, BASE, OUT) do { unsigned a0 = cvtpk(P[BASE + 0], P[BASE + 1]), a1 = cvtpk(P[BASE + 2], P[BASE + 3]);   \
    unsigned b0 = cvtpk(P[BASE + 4], P[BASE + 5]), b1 = cvtpk(P[BASE + 6], P[BASE + 7]);                              \
    auto r0 = __builtin_amdgcn_permlane32_swap(a0, b0, false, false); auto r1 = __builtin_amdgcn_permlane32_swap(a1, b1, false, false); \
    u32x4 w = {r0[0], r1[0], r0[1], r1[1]}; OUT = *reinterpret_cast<bf16x8*>(&w); } while (0)
    PK4(p0, 0, pa0); PK4(p0, 8, pa1); PK4(p1, 0, pa2); PK4(p1, 8, pa3);
#undef PK4
}
__device__ __forceinline__ int v_st(int k, int c) { const int kk = (k & ~0xC) | ((k & 4) << 1) | ((k & 8) >> 1); return ((kk >> 3) * 2 + (c >> 5)) * 512 + ((kk & 7) * 32 + (c & 31)) * 2; }
__device__ __forceinline__ int v_rd_base(int lane) { return ((lane & 3) << 3) | (((lane >> 2) & 3) << 6) | (((lane >> 4) & 1) << 5) | (((lane >> 5) & 1) << 8); }
constexpr int v_rd_off(int d0, int ks, int half) { return d0 * 512 + ks * 2048 + half * 1024; }
template <int OFF> __device__ __forceinline__ s16x4 tr_read(int vb) {
    s16x4 r; asm volatile("ds_read_b64_tr_b16 %0, %1 offset:%2" : "=&v"(r) : "v"(vb), "i"(OFF) : "memory"); return r;
}
template <int D0> __device__ __forceinline__ void pv_one(f32x16& od, int vb, bf16x8 pa0, bf16x8 pa1, bf16x8 pa2, bf16x8 pa3) {
    const s16x4 l0 = tr_read<v_rd_off(D0, 0, 0)>(vb), h0 = tr_read<v_rd_off(D0, 0, 1)>(vb), l1 = tr_read<v_rd_off(D0, 1, 0)>(vb), h1 = tr_read<v_rd_off(D0, 1, 1)>(vb);
    const s16x4 l2 = tr_read<v_rd_off(D0, 2, 0)>(vb), h2 = tr_read<v_rd_off(D0, 2, 1)>(vb), l3 = tr_read<v_rd_off(D0, 3, 0)>(vb), h3 = tr_read<v_rd_off(D0, 3, 1)>(vb);
    asm volatile("s_waitcnt lgkmcnt(0)" ::: "memory"); SBAR();
#define PK(L, H) (bf16x8){L[0], L[1], L[2], L[3], H[0], H[1], H[2], H[3]}
    od = __builtin_amdgcn_mfma_f32_32x32x16_bf16(pa0, PK(l0, h0), od, 0, 0, 0);
    od = __builtin_amdgcn_mfma_f32_32x32x16_bf16(pa1, PK(l1, h1), od, 0, 0, 0);
    od = __builtin_amdgcn_mfma_f32_32x32x16_bf16(pa2, PK(l2, h2), od, 0, 0, 0);
    od = __builtin_amdgcn_mfma_f32_32x32x16_bf16(pa3, PK(l3, h3), od, 0, 0, 0);
#undef PK
}

constexpr float V8_OFF = -3.0f;
__device__ __forceinline__ int v8_pos(int k) { const int kb = k >> 5, kk = k & 31; return 32 * ((kk >> 2) & 1) + 16 * kb + 4 * (kk >> 3) + (kk & 3); }
__device__ __forceinline__ int v8_byte(int dim, int pos) { return dim * 64 + ((((pos >> 4) ^ (dim >> 2)) & 3) << 4) + (pos & 15); }
__device__ __forceinline__ void finishSM8(f32x16& p0, f32x16& p1, i32x8& pk) {
#pragma unroll
    for (int r = 0; r < 16; ++r) p1[r] = __builtin_amdgcn_exp2f(p1[r]);
#pragma unroll
    for (int w = 0; w < 4; ++w) { int a = __builtin_amdgcn_cvt_pk_fp8_f32(p0[4 * w], p0[4 * w + 1], 0, false); pk[w] = __builtin_amdgcn_cvt_pk_fp8_f32(p0[4 * w + 2], p0[4 * w + 3], a, true);
                                  int b = __builtin_amdgcn_cvt_pk_fp8_f32(p1[4 * w], p1[4 * w + 1], 0, false); pk[4 + w] = __builtin_amdgcn_cvt_pk_fp8_f32(p1[4 * w + 2], p1[4 * w + 3], b, true); }
}
__device__ __forceinline__ i32x8 ld32(const LAS unsigned char* p) { const u32x4 lo = *(const LAS u32x4*)p, hi4 = *(const LAS u32x4*)(p + 16);
    return (i32x8){(int)lo[0], (int)lo[1], (int)lo[2], (int)lo[3], (int)hi4[0], (int)hi4[1], (int)hi4[2], (int)hi4[3]}; }
__device__ __forceinline__ void pv8_sum(f32x16& os, const i32x8 pk) {
    const i32x8 ones = {0x38383838, 0x38383838, 0x38383838, 0x38383838, 0x38383838, 0x38383838, 0x38383838, 0x38383838};
    os = __builtin_amdgcn_mfma_scale_f32_32x32x64_f8f6f4(pk, ones, os, 0, 0, 0, 0x7F7F7F7F, 0, 0x7F7F7F7F);
}
template <int D0> __device__ __forceinline__ void pv8_one(f32x16& od, const LAS unsigned char* vt, int r32, int hi, const i32x8 pk) {
    const LAS unsigned char* row = vt + (32 * D0 + r32) * 64; const int sw = (r32 >> 2) & 3;
    const u32x4 lo = *(const LAS u32x4*)(row + (((2 * hi) ^ sw) << 4)), hi4 = *(const LAS u32x4*)(row + (((2 * hi + 1) ^ sw) << 4));
    const i32x8 vb = {(int)lo[0], (int)lo[1], (int)lo[2], (int)lo[3], (int)hi4[0], (int)hi4[1], (int)hi4[2], (int)hi4[3]};
    od = __builtin_amdgcn_mfma_scale_f32_32x32x64_f8f6f4(pk, vb, od, 0, 0, 0, 0x7F7F7F7F, 0, 0x7F7F7F7F);
}

template <int DQK, bool NA, bool V8 = false>
__device__ __forceinline__ void attn_unit(const bf16* __restrict__ Qb, const int ldq, const bf16* __restrict__ Kh, const int ldk, const bf16* __restrict__ Vh, const int ldv,
                                          bf16* __restrict__ Ob, const int NT_, const int gr_lo, const int gr_hi, const int qb, const float* __restrict__ rpb, LAS unsigned char* lds) {
    constexpr int ND = DQK / 16, KST = DQK * 2 + 16, KCH = DQK / 8, SHK = 64 * KST, SHV = 64 * 64 * 2;
    constexpr float SCALE = Cst<DQK>::SCALE;
    int tid_ = threadIdx.x; asm volatile("" : "+v"(tid_));
    const int tid = tid_, wid = __builtin_amdgcn_readfirstlane(tid >> 6), lane = tid & 63, r32 = lane & 31, hi = lane >> 5;
    constexpr int NSLOT = V8 ? 4 : 2;
    LAS unsigned char* K_lds = lds; LAS unsigned char* V_lds = lds + NSLOT * SHK;
    LAS float* wsf = (LAS float*)(lds + NSLOT * SHK + NSLOT * SHV) + wid * 64; LAS float* li_l = wsf;
    LAS float* btab = (LAS float*)(lds + NSLOT * SHK + NSLOT * SHV + 2048 + 256);
    float l_reg = 0.f; f32x16 o[2] = {}, osum = {}; bf16x8 qr[ND]; i32x8 q8[2];
    if constexpr (V8) {
        const bf16* Qw = Qb + (size_t)(wid * 32 + r32) * ldq;
#pragma unroll
        for (int m = 0; m < 2; ++m)
#pragma unroll
            for (int c = 0; c < 4; ++c) { float f[8]; unpack8(*(const u32x4*)(Qw + (m == 0 ? 32 * hi : 64) + c * 8), f);
                const int w0 = __builtin_amdgcn_cvt_pk_fp8_f32(f[2], f[3], __builtin_amdgcn_cvt_pk_fp8_f32(f[0], f[1], 0, false), true), w1 = __builtin_amdgcn_cvt_pk_fp8_f32(f[6], f[7], __builtin_amdgcn_cvt_pk_fp8_f32(f[4], f[5], 0, false), true);
                q8[m][2 * c] = (m == 1 && hi) ? 0 : w0; q8[m][2 * c + 1] = (m == 1 && hi) ? 0 : w1; }
    } else { const bf16* Qw = Qb + (size_t)(wid * 32 + r32) * ldq + hi * 8;
#pragma unroll
      for (int d0 = 0; d0 < ND; ++d0) qr[d0] = *(const bf16x8*)(Qw + d0 * 16); }
    const int kc8 = tid < 448 ? tid : tid - 64;
    const int ka0 = r32 * 112 + 32 * hi, ka1 = hi ? 7168 : r32 * 112 + 64, ka1b = hi ? 7168 : (32 + r32) * 112 + 64;
    if constexpr (V8) { if (tid < 8) { *(LAS u32x4*)(lds + (tid >> 1) * SHK + 7168 + (tid & 1) * 16) = (u32x4){0u, 0u, 0u, 0u}; } }
    const int id0 = tid, rk0 = id0 / KCH, ck0 = id0 % KCH;
    const int id1 = 512 + (tid & 255), rk1 = id1 / KCH, ck1 = id1 % KCH;
    const int rv = tid >> 3, cv = tid & 7;
    const int kst0 = rk0 * KST + ck0 * 16, kst1 = rk1 * KST + ck1 * 16, vst = v_st(rv, cv * 8);
    const int vb0 = (int)(uintptr_t)V_lds + v_rd_base(lane);
    struct { bf16x8 k0, k1, v; u32x2 v8; } sr_[2];
    const int rqw = 4 * qb + (wid >> 1), cq = 32 * (wid & 1) + r32;
    const int r0w = rqw - 4 < 0 ? 0 : (rqw - 4 > 248 ? 248 : rqw - 4);
    const int c0 = cq - 8 < 0 ? 0 : (cq - 8 > 48 ? 48 : cq - 8);
    if constexpr (NA) { for (int i = tid; i < 465; i += 512) btab[i] = rpb[i] * 1.4426950408889634f; }
#define KB_OF(j) (NA ? ((j) < 4 ? 64 * (j) : NC + 64 * (gr_lo + (j) - 4 > gr_hi ? gr_hi : gr_lo + (j) - 4)) : 64 * (j))
#define SLOAD(i, j) do { const int kb_ = KB_OF(j); if constexpr (V8) sr_[i].k0 = *(const bf16x8*)((const unsigned char*)Kh + (size_t)(kb_ >> 6) * 7168 + kc8 * 16); else { sr_[i].k0 = *(const bf16x8*)(Kh + (size_t)(kb_ + rk0) * ldk + ck0 * 8); \
        if constexpr (DQK == 96) sr_[i].k1 = *(const bf16x8*)(Kh + (size_t)(kb_ + rk1) * ldk + ck1 * 8); } \
        if constexpr (V8) sr_[i].v8 = *(const u32x2*)((const unsigned char*)Vh + (size_t)(kb_ >> 6) * 4096 + tid * 8); else sr_[i].v = *(const bf16x8*)(Vh + (size_t)(kb_ + rv) * ldv + cv * 8); } while (0)
#define SWRITE(b, i) do { if constexpr (V8) *(LAS bf16x8*)(K_lds + (b) * SHK + kc8 * 16) = sr_[i].k0; else { *(LAS bf16x8*)(K_lds + (b) * SHK + kst0) = sr_[i].k0; if constexpr (DQK == 96) *(LAS bf16x8*)(K_lds + (b) * SHK + kst1) = sr_[i].k1; } \
        if constexpr (V8) *(LAS u32x2*)(V_lds + (b) * SHV + tid * 8) = sr_[i].v8; else *(LAS bf16x8*)(V_lds + (b) * SHV + vst) = sr_[i].v; } while (0)
#define SWAIT() do { if constexpr (DQK == 96 && !V8) asm volatile("s_waitcnt vmcnt(3)" ::: "memory"); else asm volatile("s_waitcnt vmcnt(2)" ::: "memory"); } while (0)
#define QKT(P0, P1, V, b, j) do { V = true; int gk_ = 0; if constexpr (NA) { if ((j) >= 4) { gk_ = gr_lo + (j) - 4; V = (gk_ <= gr_hi) && (gk_ >= r0w) && (gk_ <= r0w + 7); } } \
        if (V) { if constexpr (V8) { _Pragma("unroll") for (int r_ = 0; r_ < 16; ++r_) { P0[r_] = V8_OFF; P1[r_] = V8_OFF; } } else { P0 = f32x16{}; P1 = f32x16{}; } const LAS unsigned char* Ks_ = K_lds + (b) * SHK; \
            if constexpr (V8) { const i32x8 a00 = ld32(Ks_ + ka0), a01 = ld32(Ks_ + ka1), a10 = ld32(Ks_ + 3584 + ka0), a11 = ld32(Ks_ + ka1b); \
                P0 = __builtin_amdgcn_mfma_scale_f32_32x32x64_f8f6f4(a00, q8[0], P0, 0, 0, 0, 0x7F7F7F7F, 0, 0x7F7F7F7F); P1 = __builtin_amdgcn_mfma_scale_f32_32x32x64_f8f6f4(a10, q8[0], P1, 0, 0, 0, 0x7F7F7F7F, 0, 0x7F7F7F7F); \
                P0 = __builtin_amdgcn_mfma_scale_f32_32x32x64_f8f6f4(a01, q8[1], P0, 0, 0, 0, 0x7F7F7F7F, 0, 0x7F7F7F7F); P1 = __builtin_amdgcn_mfma_scale_f32_32x32x64_f8f6f4(a11, q8[1], P1, 0, 0, 0, 0x7F7F7F7F, 0, 0x7F7F7F7F); } else \
            _Pragma("unroll") for (int d0 = 0; d0 < ND; ++d0) { const int cb = (d0 * 16 + hi * 8) * 2; \
                const bf16x8 b0 = *(const LAS bf16x8*)(Ks_ + r32 * KST + cb); const bf16x8 b1 = *(const LAS bf16x8*)(Ks_ + (32 + r32) * KST + cb); \
                P0 = __builtin_amdgcn_mfma_f32_32x32x16_bf16(b0, qr[d0], P0, 0, 0, 0); P1 = __builtin_amdgcn_mfma_f32_32x32x16_bf16(b1, qr[d0], P1, 0, 0, 0); } \
            if constexpr (NA) { if ((j) >= 4) { const LAS float* bb_ = btab + (gk_ - rqw + 7) * 31 + (15 - cq) + 4 * hi; \
                _Pragma("unroll") for (int r = 0; r < 16; ++r) { const int ckc = (r & 3) + 8 * (r >> 2); const int ck = ckc + 4 * hi; \
                    P0[r] = (ck >= c0 && ck <= c0 + 15) ? P0[r] + bb_[ckc] : -1e30f; P1[r] = (ck + 32 >= c0 && ck + 32 <= c0 + 15) ? P1[r] + bb_[ckc + 32] : -1e30f; } } } } } while (0)
#define PSM(P0, V) do { if (V) partialSM(P0); } while (0)
#define FSM(P0, P1) do { if constexpr (V8) finishSM8(P0, P1, pk8); else finishSM(P0, P1, l_reg, pa0, pa1, pa2, pa3); } while (0)
#define PV(vbuf) do { if constexpr (V8) { pv8_one<0>(o[0], V_lds + (vbuf) * SHV, r32, hi, pk8); pv8_one<1>(o[1], V_lds + (vbuf) * SHV, r32, hi, pk8); pv8_sum(osum, pk8); } \
        else { pv_one<0>(o[0], vb0 + (vbuf) * SHV, pa0, pa1, pa2, pa3); pv_one<1>(o[1], vb0 + (vbuf) * SHV, pa0, pa1, pa2, pa3); } } while (0)
#define FSM_PV(P0, P1, V, vbuf) do { if (V) { FSM(P0, P1); SBAR(); PV(vbuf); } } while (0)
    f32x16 pA0, pA1, pB0, pB1; bf16x8 pa0, pa1, pa2, pa3; i32x8 pk8; bool vA, vB; const int NTl = NT_;
    if constexpr (V8) {
        const int NP = NTl >> 1;
        SLOAD(0, 0); SLOAD(1, 1); VM_WAIT(); SWRITE(0, 0); SWRITE(1, 1); __syncthreads();
#define PAIR(sb, nb, pp) do { const int jn_ = ((pp) + 1 < NP ? (pp) + 1 : (pp)) * 2; SLOAD(0, jn_); SLOAD(1, jn_ + 1); SBAR(); \
            QKT(pA0, pA1, vA, sb, 0); PSM(pA0, vA); SBAR(); \
            QKT(pB0, pB1, vB, (sb) + 1, 0); FSM(pA0, pA1); SBAR(); \
            PV(sb); PSM(pB0, vB); SBAR(); \
            FSM(pB0, pB1); SBAR(); PV((sb) + 1); \
            asm volatile("s_waitcnt vmcnt(0)" ::: "memory"); SWRITE(nb, 0); SWRITE((nb) + 1, 1); __syncthreads(); } while (0)
        for (int p = 0; p < NP; p += 2) { PAIR(0, 2, p); PAIR(2, 0, p + 1); }
#undef PAIR
    } else {
    SLOAD(0, 0); VM_WAIT(); SWRITE(0, 0); __syncthreads();
    QKT(pA0, pA1, vA, 0, 0); PSM(pA0, vA);
    SLOAD(1, 1); SLOAD(0, (2 < NTl ? 2 : NTl - 1));
    SWAIT(); SWRITE(1, 1); __syncthreads();
    for (int j = 1; j + 1 < NTl; j += 2) {
        SBAR(); QKT(pB0, pB1, vB, 1, j);
        if (vA) { FSM(pA0, pA1); } SBAR();
        SLOAD(1, j + 2); SBAR();
        if (vA) { PV(0); }
        PSM(pB0, vB);
        __syncthreads(); SWAIT(); SWRITE(0, 0);
        __syncthreads();
        SBAR(); QKT(pA0, pA1, vA, 0, j + 1);
        if (vB) { FSM(pB0, pB1); } SBAR();
        SLOAD(0, (j + 3 < NTl ? j + 3 : NTl - 1)); SBAR();
        if (vB) { PV(1); }
        PSM(pA0, vA);
        __syncthreads(); SWAIT(); SWRITE(1, 1);
        __syncthreads();
    }
    SBAR(); QKT(pB0, pB1, vB, 1, NTl - 1);
    FSM_PV(pA0, pA1, vA, 0); PSM(pB0, vB);
    FSM_PV(pB0, pB1, vB, 1);
    }
    if constexpr (!V8) { if (hi == 0) li_l[r32] = l_reg; asm volatile("s_waitcnt lgkmcnt(0)" ::: "memory"); }
    bf16* Ow = Ob + (size_t)(wid * 32) * 512;
#pragma unroll
    for (int r = 0; r < 16; ++r) { const int orow = crow(r, hi); float rl; if constexpr (V8) rl = __builtin_amdgcn_rcpf(osum[r]); else rl = __builtin_amdgcn_rcpf(li_l[orow]);
#pragma unroll
        for (int d0 = 0; d0 < 2; ++d0) Ow[(size_t)orow * 512 + d0 * 32 + r32] = f2bf(o[d0][r] * rl); }
    __syncthreads();
#undef KB_OF
#undef SLOAD
#undef SWRITE
#undef SWAIT
#undef QKT
#undef PSM
#undef FSM_PV
#undef FSM
#undef PV
}
}

struct Args { const float* in[39]; float* out; unsigned char* ws; int ph_lo, ph_hi; };
struct Frame {
    LAS unsigned char* lds; unsigned char* ws; float* out;
    int tid, lane, wave, vcu, G, gw, NGW;
};
#define WSP(T, off) ((T*)(F.ws + (off)))
constexpr int INTAB_OFF = RING_BYTES + 1024;
__device__ __forceinline__ const float* inp(const Frame& F, int i) {
    const LAS unsigned* t = (const LAS unsigned*)(F.lds + INTAB_OFF) + 2 * i;
    const unsigned lo = __builtin_amdgcn_readfirstlane(t[0]), hi = __builtin_amdgcn_readfirstlane(t[1]);
    return (const float*)(const GAS float*)(((unsigned long long)hi << 32) | lo);
}

struct CvtItem { const float* src; bf16* dst; const float* kscale; int ldw, ldt, k0; bool zero; bool f8; };
__device__ __forceinline__ void cvt_load(const CvtItem& d, f32x4 (&v)[8], int lane) {
#pragma unroll
    for (int i = 0; i < 8; ++i) { const int kk = 8 * i + (lane >> 3), n4 = (lane & 7) * 4; v[i] = d.zero ? (f32x4){0.f, 0.f, 0.f, 0.f} : __builtin_nontemporal_load((const f32x4*)(d.src + (size_t)kk * d.ldw + n4)); }
}
__device__ __forceinline__ void cvt_store(const CvtItem& d, f32x4 (&v)[8], LAS float* scr, int lane) {
#pragma unroll
    for (int i = 0; i < 8; ++i) { const int kk = 8 * i + (lane >> 3), n4 = (lane & 7) * 4; f32x4 x = v[i]; if (d.kscale) x *= d.kscale[d.k0 + kk];
        scr[kk * 33 + n4] = x[0]; scr[kk * 33 + n4 + 1] = x[1]; scr[kk * 33 + n4 + 2] = x[2]; scr[kk * 33 + n4 + 3] = x[3]; }
    LDS_WAIT(); asm volatile("" ::: "memory");
    const int c = lane & 7;
#pragma unroll
    for (int j = 0; j < 4; ++j) { const int n = (lane >> 3) + 8 * j; const LAS float* s = scr + (8 * c) * 33 + n;
        if (d.f8) { u32x2 o;
            o.x = (unsigned)__builtin_amdgcn_cvt_pk_fp8_f32(32.f * s[2 * 33], 32.f * s[3 * 33], __builtin_amdgcn_cvt_pk_fp8_f32(32.f * s[0 * 33], 32.f * s[1 * 33], 0, false), true);
            o.y = (unsigned)__builtin_amdgcn_cvt_pk_fp8_f32(32.f * s[6 * 33], 32.f * s[7 * 33], __builtin_amdgcn_cvt_pk_fp8_f32(32.f * s[4 * 33], 32.f * s[5 * 33], 0, false), true);
            *(u32x2*)(d.dst + (size_t)n * d.ldt + 4 * c) = o; }
        else { u32x4 o; o.x = cvtpk(s[0 * 33], s[1 * 33]); o.y = cvtpk(s[2 * 33], s[3 * 33]); o.z = cvtpk(s[4 * 33], s[5 * 33]); o.w = cvtpk(s[6 * 33], s[7 * 33]);
        *(u32x4*)(d.dst + (size_t)n * d.ldt + 8 * c) = o; } }
    LDS_WAIT(); asm volatile("" ::: "memory");
}
__device__ __forceinline__ CvtItem cvt_decode(Frame& F, int l, int it) {
#ifdef DBG_CONV8
    const int j = 0; const bool moe = (l & 1);
#else
    const int j = l >> 1; const bool moe = (l & 1) && !DBG_NOMOE;
#endif
    constexpr int I_WIN = (DINP / 32) * (D / 64), I_UQ = (768 / 32) * (384 / 64), I_UKV = (1024 / 32) * (256 / 64), I_GLU = (512 / 32) * (512 / 64), I_BR = (1024 / 32) * (512 / 64), I_OUT = (1024 / 32) * (1024 / 64);
    constexpr int I_GU = (FF2 / 32) * (D / 64), I_DN = (1024 / 32) * (FF / 64);
    CvtItem d; d.kscale = nullptr; d.zero = false; d.f8 = false; int r = it;
#define CVT_SET(W, LDW, C0, K0, WT, R0, LDT) do { d.ldw = (LDW); d.ldt = (LDT); d.k0 = (K0); d.src = (W) + (size_t)(K0) * (LDW) + (C0); d.dst = (WT) + (size_t)(R0) * (LDT) + (K0); } while (0)
    if (r < I_WIN) { const int nb = r % (DINP / 32), kb = r / (DINP / 32); const int n0 = nb * 32; const bool z = (n0 >= 672 && n0 < 768); const int c0 = n0 < 672 ? n0 : n0 - 96;
        CVT_SET(inp(F, 8) + (size_t)l * D * 5792, 5792, z ? 0 : c0, kb * 64, WSP(bf16, WS_WIN), n0, D); d.zero = z; return d; } r -= I_WIN;
    if (r < I_UQ) { const int nb = r % 24, kb = r / 24; CVT_SET(inp(F, 11) + (size_t)l * 384 * 768, 768, nb * 32, kb * 64, WSP(bf16, WS_WUQ), nb * 32, 384); d.kscale = inp(F, 9) + l * 384; return d; } r -= I_UQ;
    if (r < I_UKV) { const int nb = r % 32, kb = r / 32; CVT_SET(inp(F, 12) + (size_t)l * 256 * 1024, 1024, nb * 32, kb * 64, WSP(bf16, WS_WUKV), nb * 32, 256); d.kscale = inp(F, 10) + l * 256; return d; } r -= I_UKV;
    if (r < I_GLU) { const int nb = r % 16, kb = r / 16; CVT_SET(inp(F, 26) + (size_t)l * 512 * 512, 512, nb * 32, kb * 64, WSP(bf16, WS_WGLU), nb * 32, 512); return d; } r -= I_GLU;
    if (r < 3 * I_BR) { const int br = r / I_BR, q = r % I_BR, nb = q % 32, kb = q / 32; CVT_SET(inp(F, 28 + br) + (size_t)l * 512 * 1024, 1024, nb * 32, kb * 64, WSP(bf16, WS_WBR) + (size_t)br * 1024 * 512, nb * 32, 512); return d; } r -= 3 * I_BR;
    if (r < I_OUT) { const int nb = r % 32, kb = r / 32; CVT_SET(inp(F, 31) + (size_t)l * D * D, D, nb * 32, kb * 64, WSP(bf16, WS_WOUT), nb * 32, D); return d; } r -= I_OUT;
    const int e = r / (I_GU + I_DN); r = r % (I_GU + I_DN);
    const size_t eo = moe ? ((size_t)j * NEXP + e) : (size_t)j;
    if (r < I_GU) { const int nb = r % (FF2 / 32), kb = r / (FF2 / 32); const int n0 = nb * 32, t = n0 >> 8, i = n0 & 255; const bool up = i >= 128; const int c0 = t * 128 + (i & 127);
        const float* src = (moe ? (up ? inp(F, 37) : inp(F, 36)) : (up ? inp(F, 33) : inp(F, 32))) + eo * (size_t)D * FF;
        CVT_SET(src, FF, c0, kb * 64, WSP(bf16, WS_WGU) + (size_t)e * FF2 * D, n0, D);
        if (moe) { d.f8 = true; d.ldt = D / 2; d.dst = WSP(bf16, WS_WGU) + (size_t)e * FF2 * D / 2 + (size_t)n0 * (D / 2) + (kb * 64) / 2; }
        return d; } r -= I_GU;
    { const int nb = r % 32, kb = r / 32; const float* src = (moe ? inp(F, 38) : inp(F, 34)) + eo * (size_t)FF * D;
      CVT_SET(src, D, nb * 32, kb * 64, WSP(bf16, WS_WD) + (size_t)e * D * FF, nb * 32, FF); return d; }
#undef CVT_SET
}
constexpr int CVT_NONFFN = (DINP / 32) * (D / 64) + (768 / 32) * (384 / 64) + (1024 / 32) * (256 / 64) + (512 / 32) * (512 / 64) + 3 * (1024 / 32) * (512 / 64) + (1024 / 32) * (1024 / 64);
constexpr int CVT_FFN = (FF2 / 32) * (D / 64) + (1024 / 32) * (FF / 64);
#define CW_CVT 24576
__device__ __forceinline__ void convert_items(Frame& F, int l, int first, int end, int step) {
    LAS float* scr = (LAS float*)(F.lds + F.wave * 16384);
    const int total = end;
    int it = first; if (it >= total) return;
    CvtItem cur = cvt_decode(F, l, it); f32x4 va[8], vb[8]; cvt_load(cur, va, F.lane);
    for (;;) {
        const int itn = it + step; const bool more = itn < total; CvtItem nxt = cur;
        if (more) { nxt = cvt_decode(F, l, itn); cvt_load(nxt, vb, F.lane); }
        cvt_store(cur, va, scr, F.lane);
        if (!more) break;
#pragma unroll
        for (int i = 0; i < 8; ++i) va[i] = vb[i];
        cur = nxt; it = itn;
    }
}

__device__ __forceinline__ void prologue0(Frame& F) {
    if (F.vcu == 0 && F.tid < 16) WSP(unsigned, WS_CTL)[CW_CNT + (F.tid >> 3) * 8 * 64 + (F.tid & 7) * 64] = 0u;
    LAS float* red = (LAS float*)F.lds;
    LAS float* sv = (LAS float*)(F.lds + 16384);
    for (int i = F.tid; i < D; i += 512) { sv[i] = fsilu(inp(F, 1)[i]); sv[D + i] = fsilu(inp(F, 3)[i]); }
    __syncthreads();
    for (int it = F.vcu; it < DEPTH * 48; it += F.G) {
        const int l = it / 48, jb = it % 48, cq = F.lane & 31, kh = F.lane >> 5; const int j0 = jb * 128 + cq * 4;
        const float* W = inp(F, 4) + (size_t)l * D * 6144;
        f32x4 accl = {0.f, 0.f, 0.f, 0.f}, accc = {0.f, 0.f, 0.f, 0.f};
#pragma unroll 8
        for (int i = 0; i < 64; ++i) { const int k = F.wave * 128 + 2 * i + kh; const f32x4 w = *(const f32x4*)(W + (size_t)k * 6144 + j0); accl += w * sv[k]; accc += w * sv[D + k]; }
#pragma unroll
        for (int q = 0; q < 4; ++q) { accl[q] += __shfl_xor(accl[q], 32); accc[q] += __shfl_xor(accc[q], 32); }
        if (kh == 0) { *(LAS f32x4*)(red + (F.wave * 2 + 0) * 128 + cq * 4) = accl; *(LAS f32x4*)(red + (F.wave * 2 + 1) * 128 + cq * 4) = accc; }
        __syncthreads();
        if (F.tid < 256) { const int w = F.tid >> 7, jj = F.tid & 127; float sacc = 0.f;
#pragma unroll
          for (int q = 0; q < 8; ++q) sacc += red[(q * 2 + w) * 128 + jj];
          WSP(float, WS_MOD)[((size_t)l * 2 + w) * 6144 + jb * 128 + jj] = sacc + inp(F, 5)[l * 6144 + jb * 128 + jj]; }
        __syncthreads();
    }
    for (int idx = F.vcu * 512 + F.tid; idx < NL * 16; idx += F.G * 512) { const int n = idx >> 4, i = idx & 15; const float pos = (float)(i < 8 ? (n >> 6) : (n & 63));
        const float inv = __expf(-(float)(i & 7) * (9.210340371976184f / 8.f)); float s, c; sincos_rad(pos * inv, s, c);
        WSP(float, WS_ROPE)[idx] = c; WSP(float, WS_ROPE)[NL * 16 + idx] = s; }
    for (int idx = F.vcu * 512 + F.tid; idx < DEPTH * 2 * 32 * 64; idx += F.G * 512) {
        const int g = (idx >> 6) & 31, ld = idx >> 11;
        const float are = inp(F, 18)[idx], aim = inp(F, 19)[idx], dt = __expf(inp(F, 20)[ld * 32 + g]);
        const float er = __expf(are * dt); float sn, cs; sincos_rad(aim * dt, sn, cs);
        const float abr = er * cs, abi = er * sn;
        const float x = abr - 1.f, y = abi, den = 1.f / (are * are + aim * aim);
        const float cr = (x * are + y * aim) * den, ci = (y * are - x * aim) * den;
        float* P = WSP(float, WS_S5P) + (size_t)idx * 100;
        float pr = 1.f, pi = 0.f;
        for (int t = 0; t <= 32; ++t) { P[2 * t] = pr; P[2 * t + 1] = pi; const float nr = pr * abr - pi * abi, ni = pr * abi + pi * abr; pr = nr; pi = ni; }
        const float* bre = inp(F, 21) + (size_t)idx * 16; const float* bim = inp(F, 22) + (size_t)idx * 16;
        for (int c = 0; c < 16; ++c) { const float br = bre[c], bi = bim[c]; P[66 + 2 * c] = cr * br - ci * bi; P[67 + 2 * c] = cr * bi + ci * br; }
    }
}
__device__ __forceinline__ void prologue1(Frame& F) {
    LAS float* Pl = (LAS float*)F.lds;
    LAS float* Cr = Pl + 6400; LAS float* Ci = Cr + 1024;
    for (int ldg = F.vcu; ldg < DEPTH * 2 * 32; ldg += F.G) {
        __syncthreads();
        const float* P = WSP(float, WS_S5P) + (size_t)ldg * 6400; const float* cre = inp(F, 23) + (size_t)ldg * 1024; const float* cim = inp(F, 24) + (size_t)ldg * 1024;
        for (int i = F.tid; i < 6400; i += 512) Pl[i] = P[i];
        for (int i = F.tid; i < 1024; i += 512) { Cr[i] = cre[i]; Ci[i] = cim[i]; }
        __syncthreads();
        for (int e = F.tid; e < 32 * 256; e += 512) { const int cp = e & 15, c = (e >> 4) & 15, tau = e >> 8; float s = 0.f;
#pragma unroll 8
            for (int p = 0; p < 64; ++p) { const LAS float* Pp = Pl + p * 100; const float ar = Pp[2 * tau], ai = Pp[2 * tau + 1], br = Pp[66 + 2 * cp], bi = Pp[67 + 2 * cp];
                const float tr = ar * br - ai * bi, ti = ar * bi + ai * br; s += Cr[c * 64 + p] * tr - Ci[c * 64 + p] * ti; }
            WSP(float, WS_KTAB)[(size_t)ldg * 8192 + e] = s; }
    }
}
__device__ __forceinline__ void s5_tables(Frame& F, int l) {
    const float* KT = WSP(float, WS_KTAB) + (size_t)l * 2 * 32 * 32 * 256;
    const float* SP = WSP(float, WS_S5P) + (size_t)l * 2 * 32 * 64 * 100;
    bf16* WY = WSP(bf16, WS_WY); bf16* WE = WSP(bf16, WS_WEND);
    for (int idx = F.vcu * 512 + F.tid; idx < 32 * 512 * 96; idx += F.G * 512) {
        const int k8 = idx % 96, n = (idx / 96) & 511, g = idx / (96 * 512); const int t = n >> 4, c = n & 15;
        float v[8];
        if (k8 < 64) { const int j = k8 >> 1, c0 = (k8 & 1) * 8, dtj = t - j;
            if (dtj > 0) { const float* s = KT + ((((size_t)0 * 32 + g) * 32 + dtj) * 16 + c) * 16 + c0;
#pragma unroll
                for (int q = 0; q < 8; ++q) v[q] = s[q]; }
            else if (dtj < 0) { const float* s = KT + ((((size_t)1 * 32 + g) * 32 - dtj) * 16 + c) * 16 + c0;
#pragma unroll
                for (int q = 0; q < 8; ++q) v[q] = s[q]; }
            else { const float* s0 = KT + ((((size_t)0 * 32 + g) * 32) * 16 + c) * 16 + c0; const float* s1 = KT + ((((size_t)1 * 32 + g) * 32) * 16 + c) * 16 + c0; const float dsk = inp(F, 25)[l * 512 + g * 16 + c];
#pragma unroll
                for (int q = 0; q < 8; ++q) v[q] = s0[q] + s1[q] + ((c0 + q == c) ? dsk : 0.f); } }
        else { const int part = (k8 - 64) >> 3, dir = part >> 1, im = part & 1, p0 = ((k8 - 64) & 7) * 8; const int e = dir ? 32 - t : t + 1;
            const size_t ldg = ((size_t)(l * 2 + dir) * 32 + g);
            const float* cre = inp(F, 23) + (ldg * 16 + c) * 64 + p0; const float* cim = inp(F, 24) + (ldg * 16 + c) * 64 + p0;
#pragma unroll
            for (int q = 0; q < 8; ++q) { const float* Pp = SP + (((size_t)dir * 32 + g) * 64 + p0 + q) * 100; const float ar = Pp[2 * e], ai = Pp[2 * e + 1];
                v[q] = im ? -(cre[q] * ai + cim[q] * ar) : (cre[q] * ar - cim[q] * ai); } }
        u32x4 w; w.x = cvtpk(v[0], v[1]); w.y = cvtpk(v[2], v[3]); w.z = cvtpk(v[4], v[5]); w.w = cvtpk(v[6], v[7]);
        *(u32x4*)(WY + ((size_t)g * 512 + n) * 768 + k8 * 8) = w;
    }
    for (int idx = F.vcu * 512 + F.tid; idx < 32 * 256 * 64; idx += F.G * 512) {
        const int k8 = idx & 63, q_ = (idx >> 6) & 255, g = idx >> 14; const int j = k8 >> 1, c0 = (k8 & 1) * 8;
        const int dir = q_ >> 7, im = (q_ >> 6) & 1, p = q_ & 63; const int e = dir ? j : 31 - j;
        const float* Pp = SP + (((size_t)dir * 32 + g) * 64 + p) * 100; const float ar = Pp[2 * e], ai = Pp[2 * e + 1]; float v[8];
#pragma unroll
        for (int q = 0; q < 8; ++q) { const float br = Pp[66 + 2 * (c0 + q)], bi = Pp[67 + 2 * (c0 + q)]; v[q] = im ? (ar * bi + ai * br) : (ar * br - ai * bi); }
        u32x4 w; w.x = cvtpk(v[0], v[1]); w.y = cvtpk(v[2], v[3]); w.z = cvtpk(v[4], v[5]); w.w = cvtpk(v[6], v[7]);
        *(u32x4*)(WE + ((size_t)g * 256 + q_) * 512 + k8 * 8) = w;
    }
}

__device__ __forceinline__ void moe_bases(const unsigned* cnt, int (&base)[9]) {
    int b = 0;
#pragma unroll
    for (int e = 0; e < 8; ++e) { base[e] = b; const int c = (int)__hip_atomic_load(cnt + 64 * e, __ATOMIC_RELAXED, __HIP_MEMORY_SCOPE_AGENT); b += ((c + 255) >> 8) << 8; }
    base[8] = b;
}

template <int MODE>
__device__ __forceinline__ void norm_phase(Frame& F, int l) {
    bf16* xs = WSP(bf16, WS_XS); bf16* H = WSP(bf16, WS_H);
    const float* gn = inp(F, MODE == 0 ? 6 : 7) + l * D;
    const float* modl = WSP(float, WS_MOD) + ((size_t)l * 2 + 0) * 6144 + (MODE == 0 ? 0 : 3 * D);
    const float* modc = WSP(float, WS_MOD) + ((size_t)l * 2 + 1) * 6144 + (MODE == 0 ? 0 : 3 * D);
    const bool moe = (MODE == 1) && (l & 1) && !DBG_NOMOE;
    const bool comb = (MODE == 0) && l > 0 && ((l - 1) & 1) && !DBG_NOMOE;
    const int row_lo = (MODE == 1 && l == DEPTH - 1) ? NC : 0;
    int base[9];
    const unsigned* cntp = (const unsigned*)WSP(unsigned, WS_CTL) + CW_CNT + ((l - 1) >> 1) * 8 * 64;
    if (comb) moe_bases(cntp, base);
    LAS float* wr_l = (LAS float*)F.lds;
    LAS int* lcnt = (LAS int*)(F.lds + 32768); LAS int* wgbase = lcnt + 8; LAS unsigned* rowrec = (LAS unsigned*)(F.lds + 32768 + 256);
    if (moe) { const float* wrt = inp(F, 35) + (size_t)(l >> 1) * D * 8; for (int i = F.tid; i < D * 8; i += 512) wr_l[i] = wrt[i]; if (F.tid < 8) lcnt[F.tid] = 0; __syncthreads(); }
    int krow = 0;
    unsigned* cnt = WSP(unsigned, WS_CTL) + CW_CNT + (l >> 1) * 8 * 64;
    const float* ga2p_l = WSP(float, WS_MOD) + ((size_t)(l - 1) * 2 + 0) * 6144 + 5 * D; const float* ga2p_c = WSP(float, WS_MOD) + ((size_t)(l - 1) * 2 + 1) * 6144 + 5 * D;
    for (int m = row_lo + F.gw; m < NT; m += F.NGW) {
        f32x4 v[4];
        if (MODE == 0 && l == 0) { const float* src = m < NC ? inp(F, 2) + (size_t)m * D : inp(F, 0) + (size_t)(m - NC) * D;
#pragma unroll
            for (int j = 0; j < 4; ++j) v[j] = *(const f32x4*)(src + j * 256 + F.lane * 4); }
        else {
#ifdef DBG_SC1
#pragma unroll
            for (int j = 0; j < 4; ++j) {
#pragma unroll
                for (int q = 0; q < 4; ++q) v[j][q] = __hip_atomic_load(xs + (size_t)m * D + j * 256 + F.lane * 4 + q, __ATOMIC_RELAXED, __HIP_MEMORY_SCOPE_AGENT); }
#else
#pragma unroll
            for (int j = 0; j < 4; ++j) v[j] = ld4bf(xs + (size_t)m * D + j * 256 + F.lane * 4);
#endif
        }
        if (comb) { const unsigned* rec = WSP(unsigned, WS_REC) + (size_t)m * 8; const int e0 = rec[0], p0 = rec[1], e1 = rec[2], p1 = rec[3]; const float w0 = __uint_as_float(rec[4]), w1 = __uint_as_float(rec[5]);
            int r0 = 0, r1 = 0;
#pragma unroll
            for (int e = 0; e < 8; ++e) { r0 = (e == e0) ? base[e] + p0 : r0; r1 = (e == e1) ? base[e] + p1 : r1; }
            const bf16* Y0 = WSP(bf16, WS_Y) + (size_t)r0 * D; const bf16* Y1 = WSP(bf16, WS_Y) + (size_t)r1 * D; const float* ga = m < NC ? ga2p_c : ga2p_l; constexpr size_t YH = (size_t)(WS_Y2 - WS_Y) / 2;
#pragma unroll
            for (int j = 0; j < 4; ++j) { const int col = j * 256 + F.lane * 4; const u32x2 a = *(const u32x2*)(Y0 + col), b = *(const u32x2*)(Y1 + col), a2 = *(const u32x2*)(Y0 + YH + col), b2 = *(const u32x2*)(Y1 + YH + col); const f32x4 g = *(const f32x4*)(ga + col);
                v[j][0] += g[0] * (w0 * (bflo(a.x) + bflo(a2.x)) + w1 * (bflo(b.x) + bflo(b2.x))); v[j][1] += g[1] * (w0 * (bfhi(a.x) + bfhi(a2.x)) + w1 * (bfhi(b.x) + bfhi(b2.x)));
                v[j][2] += g[2] * (w0 * (bflo(a.y) + bflo(a2.y)) + w1 * (bflo(b.y) + bflo(b2.y))); v[j][3] += g[3] * (w0 * (bfhi(a.y) + bfhi(a2.y)) + w1 * (bfhi(b.y) + bfhi(b2.y))); } }
        const int npart = (m < NC) ? ((MODE == 1) ? (l < DEPTH - 1 ? 12 : 0) : ((l > 0 && !((l - 1) & 1)) ? 11 : 0)) : 0;
        if (npart) { const float* pp = WSP(float, WS_PART) + (size_t)m * D;
            for (int k = 0; k < npart; ++k) {
#pragma unroll
                for (int j = 0; j < 4; ++j) v[j] += *(const f32x4*)(pp + (size_t)k * 256 * D + j * 256 + F.lane * 4); } }
        if ((MODE == 0 && l == 0) || comb || npart) {
#pragma unroll
            for (int j = 0; j < 4; ++j) st4bf(xs + (size_t)m * D + j * 256 + F.lane * 4, v[j]); }
        float ss = 0.f;
#pragma unroll
        for (int j = 0; j < 4; ++j) ss += (v[j][0] * v[j][0] + v[j][1] * v[j][1]) + (v[j][2] * v[j][2] + v[j][3] * v[j][3]);
        const float r = 1.0f / sqrtf(wave_sum(ss) * (1.f / D) + EPS);
        const float* md = m < NC ? modc : modl;
        float lg[8] = {0.f, 0.f, 0.f, 0.f, 0.f, 0.f, 0.f, 0.f};
#pragma unroll
        for (int j = 0; j < 4; ++j) { const int col = j * 256 + F.lane * 4; const f32x4 g = *(const f32x4*)(gn + col), sh = *(const f32x4*)(md + col), sc = *(const f32x4*)(md + D + col);
            f32x4 h;
#pragma unroll
            for (int q = 0; q < 4; ++q) h[q] = (v[j][q] * r * g[q]) * (1.f + sc[q]) + sh[q];
            if (MODE == 1 && moe) *(unsigned*)((unsigned char*)H + (size_t)m * D + col) = (unsigned)__builtin_amdgcn_cvt_pk_fp8_f32(h[2], h[3], __builtin_amdgcn_cvt_pk_fp8_f32(h[0], h[1], 0, false), true);
            else { u32x2 w; w.x = cvtpk(h[0], h[1]); w.y = cvtpk(h[2], h[3]); *(u32x2*)(H + (size_t)m * D + col) = w; }
            if (moe) {
#pragma unroll
                for (int q = 0; q < 4; ++q) { const f32x4 wa = *(const LAS f32x4*)(wr_l + (col + q) * 8), wb = *(const LAS f32x4*)(wr_l + (col + q) * 8 + 4);
                    lg[0] += h[q] * wa[0]; lg[1] += h[q] * wa[1]; lg[2] += h[q] * wa[2]; lg[3] += h[q] * wa[3]; lg[4] += h[q] * wb[0]; lg[5] += h[q] * wb[1]; lg[6] += h[q] * wb[2]; lg[7] += h[q] * wb[3]; } } }
        if (moe) {
#pragma unroll
            for (int e = 0; e < 8; ++e) lg[e] = wave_sum(lg[e]);
            int i0 = 0; float v0 = lg[0];
#pragma unroll
            for (int e = 1; e < 8; ++e) if (lg[e] > v0) { v0 = lg[e]; i0 = e; }
            int i1 = -1; float v1 = -3.0e38f;
#pragma unroll
            for (int e = 0; e < 8; ++e) if (e != i0 && lg[e] > v1) { v1 = lg[e]; i1 = e; }
#ifdef DBG_FIXROUTE
            i0 = m & 7; i1 = (m + 1) & 7; v0 = 0.f; v1 = 0.f;
#endif
            if (F.lane == 0) { const float w1 = 1.f / (1.f + __expf(v0 - v1)), w0 = 1.f - w1;
                const unsigned p0 = (unsigned)__hip_atomic_fetch_add(lcnt + i0, 1, __ATOMIC_RELAXED, __HIP_MEMORY_SCOPE_WORKGROUP), p1 = (unsigned)__hip_atomic_fetch_add(lcnt + i1, 1, __ATOMIC_RELAXED, __HIP_MEMORY_SCOPE_WORKGROUP);
                LAS unsigned* rr = rowrec + (F.wave * 9 + krow) * 6; rr[0] = i0; rr[1] = p0; rr[2] = i1; rr[3] = p1; rr[4] = __float_as_uint(w0); rr[5] = __float_as_uint(w1); }
            ++krow;
        }
    }
    if (moe) {
        __syncthreads();
        if (F.tid < 8) wgbase[F.tid] = (int)__hip_atomic_fetch_add(cnt + 64 * F.tid, (unsigned)lcnt[F.tid], __ATOMIC_RELAXED, __HIP_MEMORY_SCOPE_AGENT);
        __syncthreads();
        if (F.lane == 0) { int k = 0; for (int m = row_lo + F.gw; m < NT; m += F.NGW, ++k) { const LAS unsigned* rr = rowrec + (F.wave * 9 + k) * 6; unsigned* rec = WSP(unsigned, WS_REC) + (size_t)m * 8;
            const unsigned e0 = rr[0], e1 = rr[2]; rec[0] = e0; rec[1] = rr[1] + (unsigned)wgbase[e0]; rec[2] = e1; rec[3] = rr[3] + (unsigned)wgbase[e1]; rec[4] = rr[4]; rec[5] = rr[5]; } }
    }
}
__device__ __forceinline__ void moe_scatter(Frame& F, int l) {
    int base[9]; moe_bases((const unsigned*)WSP(unsigned, WS_CTL) + CW_CNT + (l >> 1) * 8 * 64, base);
    const int row_lo = (l == DEPTH - 1) ? NC : 0;
    const bf16* H = WSP(bf16, WS_H); bf16* HS = WSP(bf16, WS_HS);
    for (int it = 2 * row_lo + F.gw; it < 2 * NT; it += F.NGW) { const int m = it >> 1, s = it & 1; const unsigned* rec = WSP(unsigned, WS_REC) + (size_t)m * 8; const int e = rec[2 * s], p = rec[2 * s + 1];
        int r = 0;
#pragma unroll
        for (int q = 0; q < 8; ++q) r = (q == e) ? base[q] + p : r;
        const u32x4* src = (const u32x4*)((const unsigned char*)H + (size_t)m * D); u32x4* dst = (u32x4*)((unsigned char*)HS + (size_t)r * D);
        dst[F.lane] = src[F.lane]; }
}
__device__ __forceinline__ void final_out(Frame& F, int l) {
#if DBG_DUMP == 9
    { const float* xs = WSP(float, WS_XS); for (int m = NC + ((F.gw + 1024 + 3) % F.NGW); m < NT; m += F.NGW) { for (int j = 0; j < 16; ++j) { const int col = j * 64 + F.lane; F.out[(size_t)(m - NC) * D + col] = xs[(size_t)m * D + col]; } } return; }
#elif DBG_DUMP == 10
    { const float* md = WSP(float, WS_MOD); for (int m = NC + F.gw; m < NT; m += F.NGW) { for (int j = 0; j < 16; ++j) { const int col = j * 64 + F.lane; F.out[(size_t)(m - NC) * D + col] = md[((size_t)(m - NC) * D + col) % 49152]; } } return; }
#elif DBG_DUMP
    { const bf16* src = WSP(bf16, DBG_DUMP == 1 ? WS_H : DBG_DUMP == 2 ? WS_G : DBG_DUMP == 3 ? WS_KVRAW : DBG_DUMP == 4 ? WS_OA : DBG_DUMP == 5 ? WS_M1 : DBG_DUMP == 6 ? WS_QF : DBG_DUMP == 7 ? WS_Z : WS_OC);
      const int ld = DBG_DUMP == 2 ? 3072 : (DBG_DUMP == 4 || DBG_DUMP == 7 || DBG_DUMP == 8) ? 512 : DBG_DUMP == 6 ? 96 : 1024;
      for (int m = NC + F.gw; m < NT; m += F.NGW) { for (int j = 0; j < 16; ++j) { const int col = j * 64 + F.lane; F.out[(size_t)(m - NC) * D + col] = bf2f(src[(size_t)m * ld + (col % ld)]); } } return; }
#endif
    if (!(l & 1) || DBG_NOMOE) { const bf16* xs = WSP(bf16, WS_XS); for (int m = NC + F.gw; m < NT; m += F.NGW) {
#pragma unroll
        for (int j = 0; j < 4; ++j) *(f32x4*)(F.out + (size_t)(m - NC) * D + j * 256 + F.lane * 4) = ld4bf(xs + (size_t)m * D + j * 256 + F.lane * 4); } return; }
    int base[9]; moe_bases((const unsigned*)WSP(unsigned, WS_CTL) + CW_CNT + (l >> 1) * 8 * 64, base);
    const bf16* xs = WSP(bf16, WS_XS); const float* ga = WSP(float, WS_MOD) + ((size_t)l * 2 + 0) * 6144 + 5 * D;
    for (int m = NC + F.gw; m < NT; m += F.NGW) { const unsigned* rec = WSP(unsigned, WS_REC) + (size_t)m * 8; const int e0 = rec[0], p0 = rec[1], e1 = rec[2], p1 = rec[3];
#ifndef DBG_NOREC
        const float w0 = __uint_as_float(rec[4]), w1 = __uint_as_float(rec[5]);
#endif
        int r0 = 0, r1 = 0;
#pragma unroll
        for (int e = 0; e < 8; ++e) { r0 = (e == e0) ? base[e] + p0 : r0; r1 = (e == e1) ? base[e] + p1 : r1; }
        const bf16* Y0 = WSP(bf16, DBG_YSRC) + (size_t)r0 * D; const bf16* Y1 = WSP(bf16, DBG_YSRC) + (size_t)r1 * D;
#ifdef DBG_DIRECTH
        Y0 = WSP(bf16, WS_H) + (size_t)m * D; Y1 = Y0;
#endif
#ifdef DBG_NOREC
        const float w0 = DBG_W, w1 = DBG_W;
#endif
#pragma unroll
        for (int j = 0; j < 4; ++j) { const int col = j * 256 + F.lane * 4; constexpr size_t YH = (size_t)(WS_Y2 - WS_Y) / 2; const u32x2 a = *(const u32x2*)(Y0 + col), b = *(const u32x2*)(Y1 + col), a2 = *(const u32x2*)(Y0 + YH + col), b2 = *(const u32x2*)(Y1 + YH + col); const f32x4 g = *(const f32x4*)(ga + col); f32x4 v = ld4bf(xs + (size_t)m * D + col);
            v[0] += g[0] * (w0 * (bflo(a.x) + bflo(a2.x)) + w1 * (bflo(b.x) + bflo(b2.x))); v[1] += g[1] * (w0 * (bfhi(a.x) + bfhi(a2.x)) + w1 * (bfhi(b.x) + bfhi(b2.x))); v[2] += g[2] * (w0 * (bflo(a.y) + bflo(a2.y)) + w1 * (bflo(b.y) + bflo(b2.y))); v[3] += g[3] * (w0 * (bfhi(a.y) + bfhi(a2.y)) + w1 * (bfhi(b.y) + bfhi(b2.y)));
            *(f32x4*)(F.out + (size_t)(m - NC) * D + col) = v; } }
}

__device__ __forceinline__ float sum8(float v) { v += __shfl_xor(v, 1); v += __shfl_xor(v, 2); v += __shfl_xor(v, 4); return v; }
__device__ __forceinline__ void finalize_phase(Frame& F, int l, int wg, int nwg) {
    const bf16* pA = WSP(bf16, WS_PA); const bf16* pN = WSP(bf16, WS_PN); const bf16* QR = WSP(bf16, WS_QRAW); const bf16* KVR = WSP(bf16, WS_KVRAW);
    bf16* QF = WSP(bf16, WS_QF); unsigned char* K8G = WSP(unsigned char, WS_KF); unsigned char* V8G = WSP(unsigned char, WS_VF); bf16* NQ = WSP(bf16, WS_NQ); bf16* NK = WSP(bf16, WS_NK);
    const float* gqn = inp(F, 13) + l * 96; const float* gkn = inp(F, 14) + l * 96; const float* gnq = inp(F, 15) + l * 64; const float* gnk = inp(F, 16) + l * 64;
    const float* COS = WSP(float, WS_ROPE); const float* SIN = COS + NL * 16;
    LAS unsigned char* buf = F.lds; LAS float* stats = (LAS float*)(F.lds + RING_BYTES + 4096); LAS unsigned char* krl = F.lds + RING_BYTES + 4096 + 512;
    const int tid0 = F.tid;
#define SWZ(c, row) (((c) & ~15) | (((c) ^ (row)) & 15))
#define PK8(f) (u32x4){cvtpk(f[0], f[1]), cvtpk(f[2], f[3]), cvtpk(f[4], f[5]), cvtpk(f[6], f[7])}
    for (int tg = wg; tg < NT / 64; tg += nwg) {
        int tid_ = tid0; asm volatile("" : "+v"(tid_));
        const int tid = tid_, lane = tid & 63, wave = __builtin_amdgcn_readfirstlane(tid >> 6), h = tid >> 6, tl = tid & 63;
        const int t0 = tg * 64, t = t0 + tl; const bool lat = t >= NC; const int n = t - NC;
        __syncthreads();
        { u32x4 va[8], vb[8]; float sq[8], skv[8];
#pragma unroll
          for (int i = 0; i < 8; ++i) { const bf16* row = pA + (size_t)(t0 + wave * 8 + i) * 768; va[i] = *(const u32x4*)(row + lane * 8); vb[i] = lane < 20 ? *(const u32x4*)(row + (64 + lane) * 8) : (u32x4){0u, 0u, 0u, 0u}; }
#pragma unroll
          for (int i = 0; i < 8; ++i) { float f[8]; unpack8(va[i], f); float ss = 0.f;
#pragma unroll
              for (int q = 0; q < 8; ++q) ss += f[q] * f[q];
              sq[i] = lane < 48 ? ss : 0.f; skv[i] = lane >= 48 ? ss : 0.f;
              if (lane < 16) { float g[8]; unpack8(vb[i], g);
#pragma unroll
                  for (int q = 0; q < 8; ++q) skv[i] += g[q] * g[q]; }
              else if (lane < 20) *(LAS u32x4*)(krl + (wave * 8 + i) * 64 + (lane - 16) * 16) = vb[i]; }
#pragma unroll
          for (int o = 1; o < 64; o <<= 1) {
#pragma unroll
              for (int i = 0; i < 8; ++i) { sq[i] += __shfl_xor(sq[i], o); skv[i] += __shfl_xor(skv[i], o); } }
          if (lane == 0) {
#pragma unroll
              for (int i = 0; i < 8; ++i) { stats[(wave * 8 + i) * 2] = 1.0f / sqrtf(sq[i] * (1.f / 384.f) + EPS); stats[(wave * 8 + i) * 2 + 1] = 1.0f / sqrtf(skv[i] * (1.f / 256.f) + EPS); } } }
#pragma unroll 8
        for (int i = 0; i < 12; ++i) { const int id = tid + 512 * i, row = id / 96, c = id % 96; *(LAS u32x4*)(buf + row * 1536 + SWZ(c, row) * 16) = *(const u32x4*)(QR + (size_t)(t0 + row) * 768 + c * 8); }
        __syncthreads();
        { LAS unsigned char* pq = buf + tl * 1536; const float rq = stats[tl * 2]; float ss = 0.f;
#define QCH(c) (pq + SWZ(h * 12 + (c), tl) * 16)
#pragma unroll
          for (int c = 0; c < 12; ++c) { float f[8]; unpack8(*(const LAS u32x4*)QCH(c), f);
#pragma unroll
              for (int q = 0; q < 8; ++q) { const float v = f[q] * rq; ss += v * v; } }
          const float sc = rq / sqrtf(ss * (1.f / 96.f) + EPS) * (0.10206207261596575f * 1.4426950408889634f);
#pragma unroll
          for (int c = 0; c < 8; ++c) { float f[8]; unpack8(*(const LAS u32x4*)QCH(c), f);
#pragma unroll
              for (int q = 0; q < 8; ++q) f[q] = f[q] * sc * gqn[c * 8 + q];
              *(LAS u32x4*)QCH(c) = PK8(f); }
#pragma unroll
          for (int cp = 0; cp < 2; ++cp) { float a[8], b[8]; unpack8(*(const LAS u32x4*)QCH(8 + cp), a); unpack8(*(const LAS u32x4*)QCH(10 + cp), b);
#pragma unroll
              for (int q = 0; q < 8; ++q) { a[q] = a[q] * sc * gqn[64 + cp * 8 + q]; b[q] = b[q] * sc * gqn[80 + cp * 8 + q]; }
              if (lat) {
#pragma unroll
                  for (int q = 0; q < 8; ++q) { const float cs = COS[(size_t)n * 16 + cp * 8 + q], sn = SIN[(size_t)n * 16 + cp * 8 + q]; const float ra = a[q] * cs - b[q] * sn, rb = a[q] * sn + b[q] * cs; a[q] = ra; b[q] = rb; } }
              *(LAS u32x4*)QCH(8 + cp) = PK8(a); *(LAS u32x4*)QCH(10 + cp) = PK8(b); } }
#undef QCH
        __syncthreads();
#pragma unroll 8
        for (int i = 0; i < 12; ++i) { const int id = tid + 512 * i, hh = id / 768, rem = id % 768, row = rem / 12, c = rem % 12;
            *(u32x4*)(QF + ((size_t)hh * NT + t0 + row) * 96 + c * 8) = *(const LAS u32x4*)(buf + row * 1536 + SWZ(hh * 12 + c, row) * 16); }
        __syncthreads();
#pragma unroll 8
        for (int i = 0; i < 16; ++i) { const int id = tid + 512 * i, row = id >> 7, c = id & 127; *(LAS u32x4*)(buf + row * 2048 + SWZ(c, row) * 16) = *(const u32x4*)(KVR + (size_t)(t0 + row) * 1024 + c * 8); }
        __syncthreads();
        unsigned v8r[16];
#define F8W(f, o) ((unsigned)__builtin_amdgcn_cvt_pk_fp8_f32(f[(o) + 2], f[(o) + 3], __builtin_amdgcn_cvt_pk_fp8_f32(f[(o)], f[(o) + 1], 0, false), true))
        { LAS unsigned char* pk = buf + tl * 2048; const LAS unsigned char* pr = krl + tl * 64;
#define KCHK(c) (pk + SWZ(h * 16 + (c), tl) * 16)
          const float rkv = stats[tl * 2 + 1]; float ss = 0.f;
#pragma unroll
          for (int c = 0; c < 8; ++c) { float f[8]; unpack8(*(const LAS u32x4*)KCHK(c), f);
#pragma unroll
              for (int q = 0; q < 8; ++q) { const float v = f[q] * rkv; ss += v * v; } }
#pragma unroll
          for (int c = 0; c < 4; ++c) { float f[8]; unpack8(*(const LAS u32x4*)(pr + c * 16), f);
#pragma unroll
              for (int q = 0; q < 8; ++q) ss += f[q] * f[q]; }
          const float rn = 1.0f / sqrtf(ss * (1.f / 96.f) + EPS), sc = rkv * rn; unsigned kw[16];
#pragma unroll
          for (int c = 0; c < 8; ++c) { float f[8]; unpack8(*(const LAS u32x4*)KCHK(c), f);
#pragma unroll
              for (int q = 0; q < 8; ++q) f[q] = f[q] * sc * gkn[c * 8 + q];
              kw[c * 2] = F8W(f, 0); kw[c * 2 + 1] = F8W(f, 4); }
          unsigned kr[8];
#pragma unroll
          for (int c = 8; c < 16; ++c) { float f[8]; unpack8(*(const LAS u32x4*)KCHK(c), f);
#pragma unroll
              for (int q = 0; q < 8; ++q) f[q] *= rkv;
              v8r[(c - 8) * 2] = F8W(f, 0); v8r[(c - 8) * 2 + 1] = F8W(f, 4); }
#pragma unroll
          for (int cp = 0; cp < 2; ++cp) { float a[8], b[8]; unpack8(*(const LAS u32x4*)(pr + cp * 16), a); unpack8(*(const LAS u32x4*)(pr + (2 + cp) * 16), b);
#pragma unroll
              for (int q = 0; q < 8; ++q) { a[q] = a[q] * rn * gkn[64 + cp * 8 + q]; b[q] = b[q] * rn * gkn[80 + cp * 8 + q]; }
              if (lat) {
#pragma unroll
                  for (int q = 0; q < 8; ++q) { const float cs = COS[(size_t)n * 16 + cp * 8 + q], sn = SIN[(size_t)n * 16 + cp * 8 + q]; const float ra = a[q] * cs - b[q] * sn, rb = a[q] * sn + b[q] * cs; a[q] = ra; b[q] = rb; } }
              kr[cp * 2] = F8W(a, 0); kr[cp * 2 + 1] = F8W(a, 4); kr[4 + cp * 2] = F8W(b, 0); kr[4 + cp * 2 + 1] = F8W(b, 4); }
#pragma unroll
          for (int w = 0; w < 4; ++w) *(LAS u32x4*)KCHK(w) = (u32x4){kw[4 * w], kw[4 * w + 1], kw[4 * w + 2], kw[4 * w + 3]};
          *(LAS u32x4*)KCHK(4) = (u32x4){kr[0], kr[1], kr[2], kr[3]}; *(LAS u32x4*)KCHK(5) = (u32x4){kr[4], kr[5], kr[6], kr[7]}; }
#undef F8W
        __syncthreads();
        int tq = tid; asm volatile("" : "+v"(tq));
#pragma unroll
        for (int i = 0; i < 6; ++i) { const int id = tq + 512 * i, hh = id / 384, r = id % 384, row = r / 6, w = r % 6;
            *(u32x4*)(K8G + ((size_t)hh * (NT / 64) + tg) * 7168 + row * 112 + w * 16) = *(const LAS u32x4*)(buf + row * 2048 + SWZ(hh * 16 + w, row) * 16); }
        __syncthreads();
        { int tl2 = tq & 63; const int pos = att::v8_pos(tl2); LAS unsigned char* vt = buf + (tq >> 6) * 4096 + (pos & 15);
          LAS unsigned char* vq[4];
#pragma unroll
          for (int x = 0; x < 4; ++x) vq[x] = vt + ((((pos >> 4) ^ x) & 3) << 4);
#pragma unroll
          for (int w = 0; w < 16; ++w)
#pragma unroll
              for (int b = 0; b < 4; ++b) vq[w & 3][(4 * w + b) * 64] = (unsigned char)(v8r[w] >> (8 * b)); }
        __syncthreads();
#pragma unroll
        for (int i = 0; i < 4; ++i) { const int id = tq + 512 * i, hh = id >> 8, off = (id & 255) * 16;
            *(u32x4*)(V8G + ((size_t)hh * (NT / 64) + tg) * 4096 + off) = *(const LAS u32x4*)(buf + hh * 4096 + off); }
        __syncthreads();
#pragma unroll 8
        for (int i = 0; i < 16; ++i) { const int id = tid + 512 * i, row = id >> 7, c = id & 127; *(LAS u32x4*)(buf + row * 2048 + SWZ(c, row) * 16) = *(const u32x4*)(pN + (size_t)(t0 + row) * 1536 + c * 8); }
        __syncthreads();
#pragma unroll
        for (int which = 0; which < 2; ++which) { LAS unsigned char* pn = buf + tl * 2048; const float* gg = which ? gnk : gnq; float ss = 0.f;
#pragma unroll
            for (int c = 0; c < 8; ++c) { float f[8]; unpack8(*(const LAS u32x4*)(pn + SWZ(which * 64 + h * 8 + c, tl) * 16), f);
#pragma unroll
                for (int q = 0; q < 8; ++q) ss += f[q] * f[q]; }
            const float rn = (which ? 1.0f : 0.125f * 1.4426950408889634f) / sqrtf(ss * (1.f / 64.f) + EPS);
#pragma unroll
            for (int c = 0; c < 8; ++c) { float f[8]; unpack8(*(const LAS u32x4*)(pn + SWZ(which * 64 + h * 8 + c, tl) * 16), f);
#pragma unroll
                for (int q = 0; q < 8; ++q) f[q] = f[q] * rn * gg[c * 8 + q];
                *(LAS u32x4*)(pn + SWZ(which * 64 + h * 8 + c, tl) * 16) = PK8(f); } }
        __syncthreads();
#pragma unroll 8
        for (int i = 0; i < 8; ++i) { const int id = tid + 512 * i, hh = id >> 9, row = (id & 511) >> 3, c = id & 7;
            *(u32x4*)(NQ + ((size_t)hh * NT + t0 + row) * 64 + c * 8) = *(const LAS u32x4*)(buf + row * 2048 + SWZ(hh * 8 + c, row) * 16);
            *(u32x4*)(NK + ((size_t)hh * NT + t0 + row) * 64 + c * 8) = *(const LAS u32x4*)(buf + row * 2048 + SWZ(64 + hh * 8 + c, row) * 16); }
    }
#undef PK8
#undef SWZ
#undef KCHK
}
__device__ __forceinline__ void s5_carry(Frame& F, int l, int cw) {
    const int idx = cw * 512 + F.tid; const int seg = idx & 7, p = (idx >> 3) & 63, g = (idx >> 9) & 31, dir = idx >> 14;
    const float* Pp = WSP(float, WS_S5P) + ((((size_t)l * 2 + dir) * 32 + g) * 64 + p) * 100; const float ar = Pp[64], ai = Pp[65];
    const float* E = WSP(float, WS_E) + (size_t)g * S5ROWS * 256 + dir * 128 + p; bf16* AG = WSP(bf16, WS_AG) + (size_t)g * S5ROWS * S5K + 512 + dir * 128 + p;
#define S5ROW(st) (dir == 0 ? ((st) < 8 ? 512 + (st) : (st) - 8) : 519 - (st))
    float tr = 0.f, ti = 0.f, pr = 1.f, pi = 0.f;
    for (int s0 = 0; s0 < 65; s0 += 5) { float er[5], ei[5];
#pragma unroll
        for (int q = 0; q < 5; ++q) { const int row = S5ROW(seg * 65 + s0 + q); er[q] = E[(size_t)row * 256]; ei[q] = E[(size_t)row * 256 + 64]; }
#pragma unroll
        for (int q = 0; q < 5; ++q) { const float nr = ar * tr - ai * ti + er[q], ni = ar * ti + ai * tr + ei[q]; tr = nr; ti = ni; const float qr = pr * ar - pi * ai, qi = pr * ai + pi * ar; pr = qr; pi = qi; } }
    float cr = 0.f, ci = 0.f, xr = 0.f, xi = 0.f; const int lb = F.lane & ~7;
#pragma unroll
    for (int k = 0; k < 8; ++k) { const float kr = __shfl(tr, lb + k), ki = __shfl(ti, lb + k); if (k == seg) { cr = xr; ci = xi; } const float nr = pr * xr - pi * xi + kr, ni = pr * xi + pi * xr + ki; xr = nr; xi = ni; }
    float sr = cr, si = ci;
    for (int s0 = 0; s0 < 65; s0 += 5) { float er[5], ei[5]; int rows[5];
#pragma unroll
        for (int q = 0; q < 5; ++q) { const int row = S5ROW(seg * 65 + s0 + q); rows[q] = row; er[q] = E[(size_t)row * 256]; ei[q] = E[(size_t)row * 256 + 64]; }
#pragma unroll
        for (int q = 0; q < 5; ++q) { AG[(size_t)rows[q] * S5K] = f2bf(sr); AG[(size_t)rows[q] * S5K + 64] = f2bf(si); const float nr = ar * sr - ai * si + er[q], ni = ar * si + ai * sr + ei[q]; sr = nr; si = ni; } }
#undef S5ROW
}
__device__ __forceinline__ void dbg_thrash(Frame& F) {
    f32x4 a = {0.f, 0.f, 0.f, 0.f};
    for (int w = 36; w < 39; ++w) { const f32x4* src = (const f32x4*)inp(F, w);
        for (size_t i = (size_t)F.vcu * 512 + F.tid; i < (size_t)11534336; i += (size_t)F.G * 512) a += src[i]; }
    if (a[0] + a[1] + a[2] + a[3] == 1.2345e33f) WSP(float, WS_E)[0] = a[0];
}
#define PH_BEGIN if (lo <= ph && ph < hi) { { int t_ = threadIdx.x; asm volatile("" : "+v"(t_)); F.tid = t_; F.lane = t_ & 63; unsigned long long w_ = (unsigned long long)args.ws; asm volatile("" : "+s"(w_)); F.ws = (unsigned char*)(GAS unsigned char*)w_; } DBG_LDSCLR
#define PH_END   if (ph + 1 < hi) xcd_barrier(bar); } ++ph;
template <int l>
__device__ __forceinline__ void layer_body(Frame& F, const Args& args, XcdBarrier& bar, int& ph, const int lo, const int hi, LAS unsigned char* ring, const int c, unsigned* ctl) {
    const int bx = blockIdx.x;
        const bool need_ctx = l < DEPTH - 1, moe = (l & 1) && !DBG_NOMOE;
        const int pm0 = need_ctx ? 0 : 1, nM = need_ctx ? 65 : 64;
        const float* modl = WSP(float, WS_MOD) + ((size_t)l * 2 + 0) * 6144; const float* modc = WSP(float, WS_MOD) + ((size_t)l * 2 + 1) * 6144;
        PH_BEGIN LPH(1) {
#if DBG_THRASH == 3
        if (l == 1) {   } else
#endif
        { for (int ra_ = 0; ra_ < 1 + DBG_REPA; ++ra_) { convert_items(F, l, F.gw, CVT_NONFFN, F.NGW);
        s5_tables(F, l); __syncthreads(); } norm_phase<0>(F, l); } } PH_END
        PH_BEGIN LPH(2) { { pg8::SchedPlain S; S.T.init(65, 23, F.G, bx); S.A = WSP(bf16, WS_H); S.Bt = WSP(bf16, WS_WIN); S.lda = D; S.ldb = D; S.pm0 = 0;
            pg8::EpiWin E{WSP(bf16, WS_PA), WSP(bf16, WS_PN), WSP(bf16, WS_AG), WSP(bf16, WS_G)};
            pg8::gemm_phase(ring, D, D, D, S, E); } } PH_END
        PH_BEGIN LPH(3) {
        { pg8::SchedPlain S; S.T.init(65, 3, F.G, bx); S.A = WSP(bf16, WS_PA); S.Bt = WSP(bf16, WS_WUQ); S.lda = 768; S.ldb = 384; S.pm0 = 0;
          pg8::EpiBf16 E{WSP(bf16, WS_QRAW), 768}; pg8::gemm_phase(ring, 384, 768, 384, S, E); }
        { pg8::SchedPlain S; S.T.init(65, 4, F.G, (bx + 61) & 255); S.A = WSP(bf16, WS_PA) + 384; S.Bt = WSP(bf16, WS_WUKV); S.lda = 768; S.ldb = 256; S.pm0 = 0;
          pg8::EpiBf16 E{WSP(bf16, WS_KVRAW), 1024}; pg8::gemm_phase(ring, 256, 768, 256, S, E); }
        { pg8::SchedS5 S; S.nrt = 3; S.nct = 1; S.G = F.G; S.c = (c + 57) & 255; S.A = WSP(bf16, WS_AG); S.W = WSP(bf16, WS_WEND); S.brows = 256; S.ldb = 512;
          pg8::EpiS5E E{WSP(float, WS_E)}; pg8::gemm_phase(ring, 512, S5K, 512, S, E); }
        } PH_END
        PH_BEGIN LPH(4) { if (c >= F.G - 64) s5_carry(F, l, c - (F.G - 64)); else finalize_phase(F, l, c, F.G - 64); } PH_END
        PH_BEGIN LPH(5) {
        { pg8::SchedS5 S; S.nrt = need_ctx ? 3 : 2; S.nct = 2; S.G = F.G; S.c = c; S.A = WSP(bf16, WS_AG); S.W = WSP(bf16, WS_WY); S.brows = 512; S.ldb = 768;
          pg8::EpiS5Y E{WSP(bf16, WS_Z)}; pg8::gemm_phase(ring, S5K, S5K, 768, S, E); }
        if (need_ctx && c >= 192 && c < 208) { const int u = c - 192, h = u & 7;
            if (u < 8) att::attn_unit<96, false, true>(WSP(bf16, WS_QF) + (size_t)h * NT * 96, 96, (const bf16*)(WSP(unsigned char, WS_KF) + (size_t)h * (NT / 64) * 7168), 96, (const bf16*)(WSP(unsigned char, WS_VF) + (size_t)h * (NT / 64) * 4096), 64, WSP(bf16, WS_OA) + h * 64, 4, 0, 0, 0, nullptr, ring);
            else att::attn_unit<64, false>(WSP(bf16, WS_NQ) + (size_t)h * NT * 64, 64, WSP(bf16, WS_NK) + (size_t)h * NT * 64, 64, WSP(bf16, WS_PN) + 1024 + h * 64, 1536, WSP(bf16, WS_OB) + h * 64, 4, 0, 0, 0, nullptr, ring); }
        for (int i = 0; i < 2; ++i) { const int h = c >> 5, qb = (c & 31) + 32 * i;
            att::attn_unit<96, false, true>(WSP(bf16, WS_QF) + ((size_t)h * NT + NC + qb * 256) * 96, 96, (const bf16*)(WSP(unsigned char, WS_KF) + (size_t)h * (NT / 64) * 7168), 96, (const bf16*)(WSP(unsigned char, WS_VF) + (size_t)h * (NT / 64) * 4096), 64,
                                      WSP(bf16, WS_OA) + (size_t)(NC + qb * 256) * 512 + h * 64, NT / 64, 0, 0, 0, nullptr, ring); }
        for (int i = 0; i < 2; ++i) { const int h = c >> 5, qb = (c & 31) + 32 * i;
            const int glo = 4 * qb - 4 < 0 ? 0 : (4 * qb - 4 > 248 ? 248 : 4 * qb - 4), ghi0 = 4 * qb - 1 < 0 ? 0 : (4 * qb - 1 > 248 ? 248 : 4 * qb - 1), ghi = ghi0 + 7;
            const int ntl = 4 + (ghi - glo + 1), ntp = (ntl + 1) & ~1;
            att::attn_unit<64, true>(WSP(bf16, WS_NQ) + ((size_t)h * NT + NC + qb * 256) * 64, 64, WSP(bf16, WS_NK) + (size_t)h * NT * 64, 64, WSP(bf16, WS_PN) + 1024 + h * 64, 1536,
                                     WSP(bf16, WS_OB) + (size_t)(NC + qb * 256) * 512 + h * 64, ntp, glo, ghi, qb, inp(F, 17) + ((size_t)l * 8 + h) * 465, ring); }
        { volatile LAS unsigned* tk = (volatile LAS unsigned*)(F.lds + MISC_OFF) + 12; const int ntk = (moe ? NEXP : 1) * (CVT_FFN / 64);
          for (;;) { __syncthreads(); if (F.tid == 0) tk[0] = xb_add(ctl + CW_CVT + l * 64, 1u);
              __syncthreads(); const int t = __builtin_amdgcn_readfirstlane((int)tk[0]); if (t >= ntk) break;
              convert_items(F, l, CVT_NONFFN + t * 64 + F.wave, CVT_NONFFN + (t + 1) * 64, 8); } }
        } PH_END
        PH_BEGIN LPH(6) { { pg8::SchedPlain S; S.T.init(nM, 2, F.G, bx); S.A = WSP(bf16, WS_Z); S.Bt = WSP(bf16, WS_WGLU); S.lda = 512; S.ldb = 512; S.pm0 = pm0;
            pg8::EpiGlu E{WSP(bf16, WS_Z), WSP(bf16, WS_OC), inp(F, 27) + l * 512}; pg8::gemm_phase(ring, 512, 512, 512, S, E); } } PH_END
        PH_BEGIN LPH(7) { { pg8::SchedMerge S; S.T.init(64, 4, F.G, bx); S.O = WSP(bf16, WS_OA); S.W = WSP(bf16, WS_WBR); S.pm0 = 1;
            pg8::EpiMerge E{WSP(bf16, WS_G), WSP(bf16, WS_M1)}; pg8::gemm_phase(ring, 512, 512, 512, S, E); }
            if (need_ctx) { pg8::SchedCtxMerge S; S.G = F.G; S.c = (c + 96) & 255; S.O = WSP(bf16, WS_OA); S.W = WSP(bf16, WS_WBR);
            pg8::EpiMergeCtx E{WSP(bf16, WS_G), WSP(bf16, WS_M1C)}; pg8::gemm_phase(ring, 512, 512, 512, S, E); } } PH_END
        PH_BEGIN LPH(8) { { pg8::SchedPlain S; S.T.init(64, 4, F.G, bx); S.A = WSP(bf16, WS_M1); S.Bt = WSP(bf16, WS_WOUT); S.lda = D; S.ldb = D; S.pm0 = 1;
            pg8::EpiResid E{WSP(bf16, WS_XS), modl + 2 * D, modc + 2 * D}; pg8::gemm_phase(ring, D, D, D, S, E); }
            if (need_ctx) { pg8::SchedCtxK S; S.nsl = 12; S.nks = 4; S.G = F.G; S.c = (c + 96) & 255; S.A = WSP(bf16, WS_M1C); S.astride = (size_t)256 * 1024; S.Bt = WSP(bf16, WS_WOUT); S.lda = D; S.ldb = D;
            pg8::EpiResidPart E{WSP(float, WS_PART), modc + 2 * D}; pg8::gemm_phase(ring, 256, D, D, S, E); } } PH_END
        PH_BEGIN LPH(9) { norm_phase<1>(F, l); } PH_END
        if (!moe) {
            PH_BEGIN LPH(10) { { pg8::SchedPlain S; S.T.init(nM, 22, F.G, bx); S.A = WSP(bf16, WS_H); S.Bt = WSP(bf16, WS_WGU); S.lda = D; S.ldb = D; S.pm0 = pm0;
                pg8::EpiUp E{WSP(bf16, WS_ACT)}; pg8::gemm_phase(ring, D, D, D, S, E); } } PH_END
            PH_BEGIN LPH(11) { { pg8::SchedPlain S; S.T.init(64, 4, F.G, bx); S.A = WSP(bf16, WS_ACT); S.Bt = WSP(bf16, WS_WD); S.lda = FF; S.ldb = FF; S.pm0 = 1;
                pg8::EpiResid E{WSP(bf16, WS_XS), modl + 5 * D, modc + 5 * D}; pg8::gemm_phase(ring, FF, FF, FF, S, E); }
                if (need_ctx) { pg8::SchedCtxK S; S.nsl = 11; S.nks = 11; S.G = F.G; S.c = (c + 96) & 255; S.A = WSP(bf16, WS_ACT); S.astride = 0; S.Bt = WSP(bf16, WS_WD); S.lda = FF; S.ldb = FF;
                pg8::EpiResidPart E{WSP(float, WS_PART), modc + 5 * D}; pg8::gemm_phase(ring, 256, FF, FF, S, E); } } PH_END
        } else {
            PH_BEGIN LPH(12) { moe_scatter(F, l); } PH_END
            LAS int* tst = (LAS int*)(F.lds + RING_BYTES + 2048);
            PH_BEGIN LPH(13) { { int base[9]; moe_bases((const unsigned*)ctl + CW_CNT + (l >> 1) * 8 * 64, base); __syncthreads();
                if (F.tid < 160) { int e = 0;
#pragma unroll
                    for (int j = 1; j < 8; ++j) e += (F.tid >= (base[j] >> 8)) ? 1 : 0;
                    tst[F.tid] = e; } __syncthreads();
                pg8::SchedMoe S; S.T.init(base[8] >> 8, 22, F.G, bx); S.A = WSP(bf16, WS_HS); S.W = WSP(bf16, WS_WGU); S.lda = D / 2; S.ldb = D / 2; S.wstride = (size_t)FF2 * D / 2; S.tstart = tst;
                pg8::EpiUp E{WSP(bf16, WS_ACT)}; pg8::gemm_phase<true>(ring, D / 2, D / 2, D / 2, S, E); } } PH_END
            PH_BEGIN LPH(14) { { int base[9]; moe_bases((const unsigned*)ctl + CW_CNT + (l >> 1) * 8 * 64, base); __syncthreads();
                if (F.tid < 160) { int e = 0;
#pragma unroll
                    for (int j = 1; j < 8; ++j) e += (F.tid >= (base[j] >> 8)) ? 1 : 0;
                    tst[F.tid] = e; } __syncthreads();
                pg8::SchedMoeDown S; S.T.init(base[8] >> 8, 8, F.G, bx); S.A = WSP(bf16, WS_ACT); S.W = WSP(bf16, WS_WD); S.tstart = tst;
                pg8::EpiMoeY E{WSP(bf16, WS_Y), WSP(bf16, WS_Y2)}; pg8::gemm_phase(ring, 1408, FF, FF, S, E); } } PH_END
        }
    }
__global__ void __launch_bounds__(512, 2) mega(Args args) {
    extern __shared__ __attribute__((aligned(16))) unsigned char lds_raw[];
    Frame F; F.lds = (LAS unsigned char*)lds_raw; F.ws = (unsigned char*)(GAS unsigned char*)(unsigned long long)args.ws; F.out = (float*)(GAS float*)(unsigned long long)args.out;
    F.tid = threadIdx.x; F.lane = F.tid & 63; F.wave = __builtin_amdgcn_readfirstlane(F.tid >> 6);
    F.G = gridDim.x; { const int bx = blockIdx.x; F.vcu = (F.G % 8 == 0) ? (bx % 8) * (F.G / 8) + bx / 8 : bx; }
    F.gw = F.vcu * 8 + F.wave; F.NGW = F.G * 8;
    volatile LAS unsigned* MISC = (volatile LAS unsigned*)(F.lds + MISC_OFF);
    for (int u = F.tid; u < (LDS_BYTES - RING_BYTES) / 4; u += 512) ((LAS unsigned*)(F.lds + RING_BYTES))[u] = 0u;
    __syncthreads();
    if (F.tid < 39) { const unsigned long long pv = (unsigned long long)args.in[F.tid]; LAS unsigned* t = (LAS unsigned*)(F.lds + INTAB_OFF) + 2 * F.tid; t[0] = (unsigned)pv; t[1] = (unsigned)(pv >> 32); }
    __syncthreads();
    unsigned* ctl = WSP(unsigned, WS_CTL);
    XcdBarrier bar; bar.bar = ctl + CW_BAR; bar.x = 0; bar.st = nullptr;
    if (ONE_LAUNCH) bar = xcd_barrier_post(ctl + CW_BAR, MISC + 8);
    int ph = 0; const int lo = args.ph_lo, hi = args.ph_hi;
    LAS unsigned char* ring = F.lds;
    const int c = F.vcu;

    PH_BEGIN
#if DBG_THRASH == 1
    dbg_thrash(F);
#endif
    prologue0(F); PH_END
    PH_BEGIN prologue1(F); PH_END

    layer_body<0>(F, args, bar, ph, lo, hi, ring, c, ctl);
    if (DBG_NLAYERS > 1) layer_body<1>(F, args, bar, ph, lo, hi, ring, c, ctl);
    if (DBG_NLAYERS > 2) layer_body<2>(F, args, bar, ph, lo, hi, ring, c, ctl);
    if (DBG_NLAYERS > 3) layer_body<3>(F, args, bar, ph, lo, hi, ring, c, ctl);
    for (int xb_ = 0; xb_ < DBG_XB; ++xb_) { PH_BEGIN PH_END }
    PH_BEGIN
#if DBG_THRASH == 2
    dbg_thrash(F); __syncthreads();
#endif
    final_out(F, DBG_NLAYERS - 1);
    if (ONE_LAUNCH && xb_ld(ctl + CW_BAR + XB_TMO) != 0u) {
        const float qn = __builtin_nanf(""); for (size_t i = (size_t)blockIdx.x * 512 + F.tid; i < (size_t)NL * D; i += (size_t)F.G * 512) F.out[i] = qn; }
    PH_END
}

static int count_phases() { int n = 2; for (int l = 0; l < DBG_NLAYERS; ++l) n += 9 + (((l & 1) && !DBG_NOMOE) ? 3 : 2); return n + 1 + DBG_XB; }
extern "C" void kernel_launch(void* const* d_in, const int* in_sizes, int n_in, void* d_out, int out_size, void* d_ws, size_t ws_size, hipStream_t stream) {
    static int grid = 0;
    if (grid == 0) {
        if (n_in != 39 || out_size != NL * D || ws_size < WS_END) { fprintf(stderr, "kernel_launch: unexpected shapes: n_in %d out %d ws %zu (need %zu)\n", n_in, out_size, ws_size, (size_t)WS_END); grid = -1; return; }
        int dev = 0, cus = 0, per_cu = 0;
        if (hipGetDevice(&dev) != hipSuccess || hipDeviceGetAttribute(&cus, hipDeviceAttributeMultiprocessorCount, dev) != hipSuccess) { grid = -1; return; }
        if (hipFuncSetAttribute((const void*)mega, hipFuncAttributeMaxDynamicSharedMemorySize, LDS_BYTES) != hipSuccess) { fprintf(stderr, "kernel_launch: hipFuncSetAttribute failed\n"); grid = -1; return; }
        if (hipOccupancyMaxActiveBlocksPerMultiprocessor(&per_cu, (const void*)mega, 512, LDS_BYTES) != hipSuccess || per_cu < 1) fprintf(stderr, "kernel_launch: occupancy query reports %d\n", per_cu);
        (void)hipGetLastError();
        grid = cus;
    }
    if (grid < 0) return;
    (void)hipMemsetAsync((char*)d_ws + WS_CTL, 0, CTL_BYTES, stream);
#ifdef DBG_MEMSET_LO
    (void)hipMemsetAsync((char*)d_ws + (size_t)DBG_MEMSET_LO * MiB, 0, (size_t)(DBG_MEMSET_HI - DBG_MEMSET_LO) * MiB, stream);
#endif
    Args a{};
    for (int i = 0; i < 39; ++i) a.in[i] = (const float*)d_in[i];
    a.out = (float*)d_out; a.ws = (unsigned char*)d_ws;
    const int nph = count_phases();
#if ONE_LAUNCH
    a.ph_lo = 0; a.ph_hi = nph;
    hipLaunchKernelGGL(mega, dim3(grid), dim3(512), LDS_BYTES, stream, a);
#else
    for (int p = 0; p < nph; ++p) { a.ph_lo = p; a.ph_hi = p + 1; hipLaunchKernelGGL(mega, dim3(grid), dim3(512), LDS_BYTES, stream, a); }
#endif
    const hipError_t le = hipPeekAtLastError();
    if (le != hipSuccess) fprintf(stderr, "kernel_launch: launch failed: %s\n", hipGetErrorName(le));
}
```

```cpp
#include <hip/hip_runtime.h>
#include <cstdio>
#include <cstdint>

#define DBG_REPA 0
#ifndef DBG_THRASH
#define DBG_THRASH 0
#endif
#ifdef DBG_LDSZERO
#define DBG_LDSCLR { for (int u_ = threadIdx.x; u_ < RING_BYTES / 16; u_ += 512) ((LAS u32x4*)F.lds)[u_] = (u32x4){0u, 0u, 0u, 0u}; __syncthreads(); }
#else
#define DBG_LDSCLR
#endif
#ifndef DBG_XB
#define DBG_XB 0
#endif
#ifndef DBG_SP
#define DBG_SP 99
#endif
#ifndef DBG_DUMP
#define DBG_DUMP 0
#endif
#ifndef DBG_REPMASK
#define DBG_REPMASK 0
#endif
#define LPH(k) for (int rep_ = 0; rep_ < 1 + ((DBG_REPMASK >> (k)) & 1); ++rep_)
#ifndef DBG_YSRC
#define DBG_YSRC WS_Y
#endif
#ifndef DBG_NOMOE
#define DBG_NOMOE 0
#endif
#ifndef DBG_NLAYERS
#define DBG_NLAYERS 4
#endif
#ifndef ONE_LAUNCH
#define ONE_LAUNCH 1
#endif

#define GAS __attribute__((address_space(1)))
#define LAS __attribute__((address_space(3)))
typedef unsigned short bf16;
typedef short bf16x8 __attribute__((ext_vector_type(8)));
typedef short s16x4 __attribute__((ext_vector_type(4)));
typedef float f32x4 __attribute__((ext_vector_type(4)));
typedef float f32x16 __attribute__((ext_vector_type(16)));
typedef unsigned u32x4 __attribute__((ext_vector_type(4)));
typedef unsigned u32x2 __attribute__((ext_vector_type(2)));
typedef int i32x8 __attribute__((ext_vector_type(8)));

constexpr int D = 1024, NL = 16384, NC = 256, NT = NL + NC, DEPTH = 4;
constexpr int DINP = 5888;
constexpr int FF = 2816, FF2 = 5632, NEXP = 8;
constexpr float EPS = 1e-6f;
constexpr int S5T = 32, S5ROWS = 768, S5K = 768;
constexpr int MOE_ROWS = 35328;

constexpr size_t MiB = 1u << 20;
constexpr size_t WS_CTL = 0, CTL_BYTES = 1 * MiB;
constexpr size_t WS_MOD = 1 * MiB;
constexpr size_t WS_ROPE = 2 * MiB;
constexpr size_t WS_S5P = 4 * MiB;
constexpr size_t WS_KTAB = 11 * MiB;
constexpr size_t WS_REC = 19 * MiB;
constexpr size_t WS_WIN = 20 * MiB;
constexpr size_t WS_WUQ = 32 * MiB;
constexpr size_t WS_WUKV = 33 * MiB;
constexpr size_t WS_WGLU = 34 * MiB;
constexpr size_t WS_WBR = 35 * MiB;
constexpr size_t WS_WOUT = 38 * MiB;
constexpr size_t WS_WGU = 40 * MiB;
constexpr size_t WS_WD = 128 * MiB;
constexpr size_t WS_WY = 172 * MiB;
constexpr size_t WS_WEND = 196 * MiB;
constexpr size_t WS_AG = 204 * MiB;
constexpr size_t WS_E = 240 * MiB;
constexpr size_t WS_Z = 264 * MiB;
constexpr size_t WS_M1 = 240 * MiB;
constexpr size_t WS_XS = 281 * MiB;
constexpr size_t WS_OA = 346 * MiB;
constexpr size_t WS_OB = WS_OA + (size_t)NT * 512 * 2;
constexpr size_t WS_OC = WS_OB + (size_t)NT * 512 * 2;
constexpr size_t WS_H = 346 * MiB;
constexpr size_t WS_R1 = 395 * MiB;
constexpr size_t WS_G = WS_R1;
constexpr size_t WS_PN = WS_G + (size_t)NT * 3072 * 2;
constexpr size_t WS_PA = WS_PN + (size_t)NT * 1536 * 2;
constexpr size_t WS_QRAW = WS_PA + (size_t)NT * 768 * 2;
constexpr size_t WS_KVRAW = WS_QRAW + (size_t)NT * 768 * 2;
constexpr size_t WS_ACT = WS_R1;
constexpr size_t WS_R2 = 623 * MiB;
constexpr size_t WS_QF = WS_R2;
constexpr size_t WS_KF = WS_QF + (size_t)8 * NT * 96 * 2;
constexpr size_t WS_VF = WS_KF + (size_t)8 * NT * 96 * 2;
constexpr size_t WS_NQ = WS_VF + (size_t)8 * NT * 64 * 2;
constexpr size_t WS_NK = WS_NQ + (size_t)8 * NT * 64 * 2;
constexpr size_t WS_HS = WS_R2;
constexpr size_t WS_Y = WS_HS + (size_t)MOE_ROWS * 1024 * 2;
constexpr size_t WS_PART = 762 * MiB;
constexpr size_t WS_Y2 = 774 * MiB;
constexpr size_t WS_M1C = 843 * MiB;
constexpr size_t WS_END = 845 * MiB;
static_assert(WS_KVRAW + (size_t)NT * 1024 * 2 <= WS_R2 && WS_ACT + (size_t)MOE_ROWS * 2816 * 2 <= WS_R2, "region 1");
static_assert(WS_NK + (size_t)8 * NT * 64 * 2 <= WS_END && WS_Y + (size_t)MOE_ROWS * 1024 * 2 <= WS_END, "region 2");
static_assert(WS_OC + (size_t)NT * 512 * 2 <= WS_R1 && WS_Z + (size_t)NT * 512 * 2 <= WS_XS && WS_M1 + (size_t)NT * 1024 * 2 <= WS_XS, "map");
constexpr int CW_BAR = 4096;
constexpr int CW_CNT = 16384;

constexpr int RING_BYTES = 131072, MISC_OFF = RING_BYTES + 320, LDS_BYTES = 147456;

#define LDS_WAIT() asm volatile("s_waitcnt lgkmcnt(0)" ::: "memory")
#define VM_WAIT() asm volatile("s_waitcnt vmcnt(0)" ::: "memory")
#define SBAR() __builtin_amdgcn_sched_barrier(0)
__device__ __forceinline__ unsigned cvtpk(float lo, float hi) { unsigned r; asm volatile("v_cvt_pk_bf16_f32 %0, %1, %2" : "=v"(r) : "v"(lo), "v"(hi)); return r; }
__device__ __forceinline__ float bflo(unsigned w) { return __uint_as_float(w << 16); }
__device__ __forceinline__ float bfhi(unsigned w) { return __uint_as_float(w & 0xffff0000u); }
__device__ __forceinline__ bf16 f2bf(float f) { return (bf16)(cvtpk(f, 0.f) & 0xffffu); }
__device__ __forceinline__ float bf2f(bf16 b) { return __uint_as_float(((unsigned)b) << 16); }
__device__ __forceinline__ void unpack8(const u32x4 w, float (&f)[8]) { f[0] = bflo(w.x); f[1] = bfhi(w.x); f[2] = bflo(w.y); f[3] = bfhi(w.y); f[4] = bflo(w.z); f[5] = bfhi(w.z); f[6] = bflo(w.w); f[7] = bfhi(w.w); }
__device__ __forceinline__ u32x4 pack8(const f32x4 a, const f32x4 b) { u32x4 w; w.x = cvtpk(a[0], a[1]); w.y = cvtpk(a[2], a[3]); w.z = cvtpk(b[0], b[1]); w.w = cvtpk(b[2], b[3]); return w; }
__device__ __forceinline__ f32x4 ld4bf(const bf16* p) { const u32x2 w = *(const u32x2*)p; return (f32x4){bflo(w.x), bfhi(w.x), bflo(w.y), bfhi(w.y)}; }
__device__ __forceinline__ void st4bf(bf16* p, const f32x4 v) { u32x2 w; w.x = cvtpk(v[0], v[1]); w.y = cvtpk(v[2], v[3]); *(u32x2*)p = w; }
__device__ __forceinline__ float fsigmoid(float x) { return __builtin_amdgcn_rcpf(1.f + __builtin_amdgcn_exp2f(-1.4426950408889634f * x)); }
__device__ __forceinline__ float fsilu(float x) { return x * fsigmoid(x); }
__device__ __forceinline__ float fgelu_tanh(float x) { return x * fsigmoid(1.5957691216057308f * (x + 0.044715f * x * x * x)); }
__device__ __forceinline__ float wave_sum(float v) {
#pragma unroll
    for (int o = 1; o < 64; o <<= 1) v += __shfl_xor(v, o);
    return v;
}
__device__ __forceinline__ void sincos_rad(float a, float& s, float& c) {
    float rev = a * 0.15915494309189535f; rev = rev - floorf(rev);
    s = __builtin_amdgcn_sinf(rev); c = __builtin_amdgcn_cosf(rev);
}

#define XB_TMO      128
#define XB_XCNT(j)  (256  + 64 * (j))
#define XB_XSUB(j)  (1280 + 64 * (j))
#define XB_XGEN(j)  (2304 + 64 * (j))
#define XB_TOP      3328
#define XB_TOPGEN   3392
#define XCD_BAR_WORDS 3456
#define XB_SPIN_CAP (1u << 22)

__device__ __forceinline__ unsigned xb_ld(unsigned* p)              { return __hip_atomic_load(p, __ATOMIC_RELAXED, __HIP_MEMORY_SCOPE_AGENT); }
__device__ __forceinline__ unsigned xb_add(unsigned* p, unsigned v) { return __hip_atomic_fetch_add(p, v, __ATOMIC_RELAXED, __HIP_MEMORY_SCOPE_AGENT); }
__device__ __forceinline__ unsigned xb_xcc_id() { return (unsigned)__builtin_amdgcn_s_getreg((3 << 11) | 20) & 0xFu; }
#define XB_SPIN(cond, bar) do { unsigned _sp = 0; while (cond) { __builtin_amdgcn_s_sleep(1); \
    if ((++_sp & 255u) == 0u) { if (xb_ld(&(bar)[XB_TMO])) break; if (_sp > XB_SPIN_CAP) { atomicAdd(&(bar)[XB_TMO], 1u); break; } } } } while (0)

struct XcdBarrier { unsigned* bar; unsigned x; volatile LAS unsigned* st; };
__device__ __forceinline__ XcdBarrier xcd_barrier_post(unsigned* bar, volatile LAS unsigned* st) {
    XcdBarrier b; b.bar = bar; b.x = xb_xcc_id(); b.st = st;
    if (threadIdx.x == 0) (void)xb_add(&bar[XB_XCNT(b.x)], 1u);
    return b;
}
__device__ __forceinline__ void xcd_barrier_complete(unsigned* bar, unsigned x, unsigned& nloc, unsigned& nx) {
    const unsigned G = gridDim.x * gridDim.y * gridDim.z;
    unsigned sum, cnt, mine, sp = 0u;
    for (;;) {
        sum = 0u; cnt = 0u; mine = 0u;
#pragma unroll
        for (unsigned j = 0; j < 16; ++j) { const unsigned c = xb_ld(&bar[XB_XCNT(j)]); sum += c; cnt += (c > 0u) ? 1u : 0u; mine = (j == x) ? c : mine; }
        if (sum == G) break;
        __builtin_amdgcn_s_sleep(1);
        if ((++sp & 255u) == 0u) { if (xb_ld(&bar[XB_TMO])) break; if (sp > XB_SPIN_CAP) { atomicAdd(&bar[XB_TMO], 1u); break; } }
    }
    nloc = mine > 0u ? mine : 1u; nx = cnt > 0u ? cnt : 1u;
}
__device__ __forceinline__ void xcd_barrier(const XcdBarrier& b) {
    asm volatile("s_waitcnt vmcnt(0)" ::: "memory");
    __syncthreads();
    if (threadIdx.x == 0) {
        unsigned* bar = b.bar;
        __builtin_amdgcn_s_waitcnt(0);
        unsigned nloc = b.st[0], nx = b.st[1];
        if (nloc == 0u) { xcd_barrier_complete(bar, b.x, nloc, nx); b.st[0] = nloc; b.st[1] = nx; }
        const unsigned old = xb_add(&bar[XB_XSUB(b.x)], 1u);
        const unsigned gen = old / nloc;
        if (old + 1u == (gen + 1u) * nloc) {
            __builtin_amdgcn_fence(__ATOMIC_RELEASE, "agent");
            asm volatile("s_waitcnt vmcnt(0)" ::: "memory");
            const unsigned og = xb_add(&bar[XB_TOP], 1u);
            const unsigned tg = og / nx;
            if (og + 1u == (tg + 1u) * nx) xb_add(&bar[XB_TOPGEN], 1u);
            else XB_SPIN(xb_ld(&bar[XB_TOPGEN]) == tg, bar);
            __builtin_amdgcn_fence(__ATOMIC_ACQUIRE, "agent");
            xb_add(&bar[XB_XGEN(b.x)], 1u);
            asm volatile("s_waitcnt vmcnt(0)" ::: "memory");
        } else {
            XB_SPIN(xb_ld(&bar[XB_XGEN(b.x)]) == gen, bar);
            __builtin_amdgcn_fence(__ATOMIC_ACQUIRE, "agent");
            asm volatile("s_waitcnt vmcnt(0)" ::: "memory");
        }
    }
    __syncthreads();
}

namespace pg8 {
constexpr int BM = 256, BK = 64, HALF = 128, HTB = HALF * BK * 2, NXCD = 8, WGM = 8;
__host__ __device__ __forceinline__ int lds_byte(int r, int c) { const int st = (r >> 4) * 2 + (c >> 5), rr = r & 15, cc = c & 31, ob = rr * 64 + cc * 2; return st * 1024 + (ob ^ (((ob >> 9) & 1) << 5)); }
__host__ __device__ __forceinline__ void stage_rc(int b, int& R, int& C) { const int st = b / 1024, sb = b % 1024, swz = sb ^ (((sb >> 9) & 1) << 5); R = (st >> 1) * 16 + swz / 64; C = (st & 1) * 32 + (swz % 64) / 2; }
__host__ __device__ __forceinline__ int perm32(int rho) { const int n = rho >> 4, i = rho & 15; return 8 * (i >> 2) + 4 * n + (i & 3); }
struct Unit { int pm, pn, aux; };

struct TileOrder {
    int nM, nN, nwg, G, c;
    __device__ __forceinline__ void init(int nM_, int nN_, int G_, int c_) { nM = nM_; nN = nN_; nwg = nM * nN; G = G_; c = c_; }
    __device__ __forceinline__ bool tile(int i, int& pm, int& pn) const {
        const long L = (long)i * G + c; if (L >= nwg) return false;
        int wgid = (int)L; { const int q = nwg / NXCD, r = nwg % NXCD, xcd = wgid % NXCD, off = wgid / NXCD; wgid = (xcd < r ? xcd * (q + 1) : r * (q + 1) + (xcd - r) * q) + off; }
        const int nig = WGM * nN, gid = wgid / nig, fm = gid * WGM, gsz = (nM - fm) < WGM ? (nM - fm) : WGM;
        pm = fm + ((wgid % nig) % gsz); pn = (wgid % nig) / gsz; return true;
    }
};

typedef int i32x4_ __attribute__((ext_vector_type(4)));
__device__ __forceinline__ i32x8 cat8(const bf16x8 a, const bf16x8 b) { const i32x4_ x = __builtin_bit_cast(i32x4_, a), y = __builtin_bit_cast(i32x4_, b);
    return __builtin_shufflevector(x, y, 0, 1, 2, 3, 4, 5, 6, 7); }
__device__ __forceinline__ void mfma8_acc(f32x4& acc, const i32x8 a, const i32x8 b, const int sa, const int sb) {
    asm volatile("v_mfma_scale_f32_16x16x128_f8f6f4 %0, %1, %2, %0, %3, %4 op_sel_hi:[0,0,0]" : "+v"(acc) : "v"(a), "v"(b), "v"(sa), "v"(sb));
}
template <bool F8 = false, bool VK = false, int SACT = 127, class Epi, class Sched>
__device__ __forceinline__ void gemm_phase(LAS unsigned char* lds, const int K, const int lda, const int ldb, const Sched& S, const Epi& E) {
    int tid_ = threadIdx.x; asm volatile("" : "+v"(tid_));
    const int tid = tid_, wid = __builtin_amdgcn_readfirstlane(tid >> 6), lane = tid & 63, wr = wid >> 2, wc = wid & 3, fr = lane & 15, fq = lane >> 4;
    int nt = K / BK;
    unsigned voffA[2], voffB[2];
#pragma unroll
    for (int i = 0; i < 2; ++i) { int R, C; stage_rc(tid * 16 + i * 8192, R, C); const int Rb = (R & ~31) + perm32(R & 31);
        voffA[i] = (unsigned)(R * lda + C) * 2u; voffB[i] = (unsigned)(Rb * ldb + C) * 2u; }
    const size_t kstep = (size_t)(BK * 2);
    const size_t hstepA = (size_t)HALF * lda * 2, hstepB = (size_t)HALF * ldb * 2;
    const unsigned ldsw = (unsigned)wid * 1024u;
    const int aoff = lds_byte(wr * 64 + fr, fq * 8), boff = lds_byte(wc * 32 + fr, fq * 8);
#define PG8_SA(b, h) (((b) * 2 + (h)) * HTB)
#define PG8_SB(b, h) ((4 + (b) * 2 + (h)) * HTB)
#define PG8_STAGE(bufoff, gbase, voff) do { _Pragma("unroll") for (int _i = 0; _i < 2; ++_i) \
        __builtin_amdgcn_global_load_lds((const unsigned*)((const char*)(gbase) + (voff)[_i]), (LAS unsigned*)(lds + (bufoff) + ldsw + _i * 8192), 16, 0, 0); } while (0)
#define PG8_LDA(dst, b, h) do { _Pragma("unroll") for (int m = 0; m < 4; ++m) _Pragma("unroll") for (int k = 0; k < 2; ++k) dst[m][k] = *(const LAS bf16x8*)(lds + PG8_SA(b, h) + aoff + m * 2048 + k * 1024); } while (0)
#define PG8_LDB(dst, b, h) do { _Pragma("unroll") for (int n = 0; n < 2; ++n) _Pragma("unroll") for (int k = 0; k < 2; ++k) dst[n][k] = *(const LAS bf16x8*)(lds + PG8_SB(b, h) + boff + n * 2048 + k * 1024); } while (0)
#define PG8_MMA(ai, bj, At, Bt) do { __builtin_amdgcn_s_setprio(1); _Pragma("unroll") for (int m = 0; m < 4; ++m) _Pragma("unroll") for (int n = 0; n < 2; ++n) { \
        if constexpr (F8) mfma8_acc(acc[ai][bj][m][n], cat8(Bt[n][0], Bt[n][1]), cat8(At[m][0], At[m][1]), 122, SACT); \
        else { _Pragma("unroll") for (int k = 0; k < 2; ++k) acc[ai][bj][m][n] = __builtin_amdgcn_mfma_f32_16x16x32_bf16(Bt[n][k], At[m][k], acc[ai][bj][m][n], 0, 0, 0); } } __builtin_amdgcn_s_setprio(0); } while (0)
#define PG8_LDA2(dst, b, h, m0) do { _Pragma("unroll") for (int mm = 0; mm < 2; ++mm) _Pragma("unroll") for (int k = 0; k < 2; ++k) dst[mm][k] = *(const LAS bf16x8*)(lds + PG8_SA(b, h) + aoff + ((m0) + mm) * 2048 + k * 1024); } while (0)
#define PG8_MMA2(ai, bj, m0, A2, Bt) do { __builtin_amdgcn_s_setprio(1); _Pragma("unroll") for (int mm = 0; mm < 2; ++mm) _Pragma("unroll") for (int n = 0; n < 2; ++n) \
        mfma8_acc(acc[ai][bj][(m0) + mm][n], cat8(Bt[n][0], Bt[n][1]), cat8(A2[mm][0], A2[mm][1]), 122, 127); __builtin_amdgcn_s_setprio(0); } while (0)
#define PG8_LDAX(b, h) do { PG8_LDA(At, b, h); } while (0)
#define PG8_MMAX(ai, b, h) do { PG8_MMA(ai, 0, At, B0); PG8_MMA(ai, 1, At, B1); } while (0)
#define PG8_WAIT_V(n) asm volatile("s_waitcnt vmcnt(" #n ")" ::: "memory")
#define PG8_WAIT_L(n) asm volatile("s_waitcnt lgkmcnt(" #n ")" ::: "memory")
#define PG8_BAR __builtin_amdgcn_s_barrier()
#define PG8_SCHED __builtin_amdgcn_sched_barrier(0)
    Unit cur, nxt; int ui = 0;
    if (!S.next(0, cur)) return;
    f32x4 acc[2][2][4][2];
#pragma unroll
    for (int a = 0; a < 2; ++a)
#pragma unroll
        for (int b = 0; b < 2; ++b)
#pragma unroll
            for (int m = 0; m < 4; ++m)
#pragma unroll
                for (int n = 0; n < 2; ++n) { acc[a][b][m][n] = (f32x4){0.f, 0.f, 0.f, 0.f}; }
    bf16x8 At[4][2], B0[2][2], B1[2][2];
    const char* cA = S.abase(cur); const char* cB = S.bbase(cur);
    PG8_STAGE(PG8_SB(0, 0), cB, voffB); PG8_STAGE(PG8_SB(0, 1), cB + hstepB, voffB); PG8_STAGE(PG8_SA(0, 0), cA, voffA); PG8_STAGE(PG8_SA(0, 1), cA + hstepA, voffA);
    if (wr == 1) PG8_BAR;
    PG8_WAIT_V(2); PG8_BAR;
    PG8_STAGE(PG8_SB(1, 0), cB + kstep, voffB); PG8_STAGE(PG8_SA(1, 0), cA + kstep, voffA); PG8_STAGE(PG8_SB(1, 1), cB + hstepB + kstep, voffB);
    PG8_WAIT_V(6); PG8_BAR;
    for (;;) {
        if constexpr (VK) nt = S.knt(cur);
        const bool has_next = S.next(ui + 1, nxt);
        const char* nA = has_next ? S.abase(nxt) : cA; const char* nB = has_next ? S.bbase(nxt) : cB;
#pragma clang loop unroll(disable)
        for (int t = 0; t < nt; t += 2) {
            const bool last = (t == nt - 2);
            const char* a1 = cA + (size_t)(t + 1) * kstep;
            const char* a2 = last ? nA : cA + (size_t)(t + 2) * kstep; const char* b2 = last ? nB : cB + (size_t)(t + 2) * kstep;
            const char* a3 = a2 + kstep; const char* b3 = b2 + kstep;
            PG8_LDB(B0, 0, 0); PG8_LDB(B1, 0, 1); PG8_SCHED; PG8_LDAX(0, 0); PG8_STAGE(PG8_SA(1, 1), a1 + hstepA, voffA);
            PG8_WAIT_V(8); PG8_WAIT_L(0); PG8_BAR; PG8_MMAX(0, 0, 0); PG8_BAR; PG8_SCHED;
            PG8_LDAX(0, 1); PG8_STAGE(PG8_SB(0, 0), b2, voffB); PG8_STAGE(PG8_SB(0, 1), b2 + hstepB, voffB); PG8_STAGE(PG8_SA(0, 0), a2, voffA);
            PG8_WAIT_V(8); PG8_WAIT_L(0); PG8_BAR; PG8_MMAX(1, 0, 1); PG8_BAR; PG8_SCHED;
            PG8_LDB(B0, 1, 0); PG8_LDB(B1, 1, 1); PG8_SCHED; PG8_LDAX(1, 0); PG8_STAGE(PG8_SA(0, 1), a2 + hstepA, voffA);
            PG8_WAIT_V(8); PG8_WAIT_L(0); PG8_BAR; PG8_MMAX(0, 1, 0); PG8_BAR; PG8_SCHED;
            PG8_LDAX(1, 1); PG8_STAGE(PG8_SB(1, 0), b3, voffB); PG8_STAGE(PG8_SB(1, 1), b3 + hstepB, voffB); PG8_STAGE(PG8_SA(1, 0), a3, voffA);
            PG8_WAIT_V(8); PG8_WAIT_L(0); PG8_BAR; PG8_MMAX(1, 1, 1); PG8_BAR; PG8_SCHED;
        }
        if (wr == 0) PG8_BAR;
        if constexpr (F8) asm volatile("s_nop 15\n\ts_nop 15" ::: "memory");
        E(acc, cur, wr, wc, fr, fq);
        if (!has_next) break;
#pragma unroll
        for (int a = 0; a < 2; ++a)
#pragma unroll
            for (int b = 0; b < 2; ++b)
#pragma unroll
                for (int m = 0; m < 4; ++m)
#pragma unroll
                    for (int n = 0; n < 2; ++n) { acc[a][b][m][n] = (f32x4){0.f, 0.f, 0.f, 0.f}; }
        cur = nxt; cA = nA; cB = nB; ++ui;
        if (wr == 1) PG8_BAR;
    }
    PG8_WAIT_V(0);
    PG8_BAR;
#undef PG8_SA
#undef PG8_SB
#undef PG8_STAGE
#undef PG8_LDA
#undef PG8_LDB
#undef PG8_MMAX
#undef PG8_LDAX
#undef PG8_MMA2
#undef PG8_LDA2
#undef PG8_MMA
#undef PG8_WAIT_V
#undef PG8_WAIT_L
#undef PG8_BAR
#undef PG8_SCHED
}

struct SchedPlain {
    TileOrder T; const bf16* A; const bf16* Bt; int lda, ldb, pm0;
    __device__ __forceinline__ bool next(int i, Unit& u) const { int pm, pn; if (!T.tile(i, pm, pn)) return false; u.pm = pm + pm0; u.pn = pn; u.aux = 0; return true; }
    __device__ __forceinline__ const char* abase(const Unit& u) const { return (const char*)(A + (size_t)u.pm * 256 * lda); }
    __device__ __forceinline__ const char* bbase(const Unit& u) const { return (const char*)(Bt + (size_t)u.pn * 256 * ldb); }
};
struct SchedMerge {
    TileOrder T; const bf16* O; const bf16* W; int pm0;
    __device__ __forceinline__ bool next(int i, Unit& u) const { int pm, pn; if (!T.tile(i / 3, pm, pn)) return false; u.pm = pm + pm0; u.pn = pn; u.aux = i % 3; return true; }
    __device__ __forceinline__ const char* abase(const Unit& u) const { return (const char*)(O + ((size_t)u.aux * NT + (size_t)u.pm * 256) * 512); }
    __device__ __forceinline__ const char* bbase(const Unit& u) const { return (const char*)(W + ((size_t)u.aux * 1024 + (size_t)u.pn * 256) * 512); }
};
struct SchedS5 {
    int nrt, nct, G, c; const bf16* A; const bf16* W; int brows, ldb;
    __device__ __forceinline__ bool next(int i, Unit& u) const { const int L = i * G + c; if (L >= 32 * nrt * nct) return false; u.aux = L / (nrt * nct); const int r = L % (nrt * nct); u.pm = r / nct; u.pn = r % nct; return true; }
    __device__ __forceinline__ const char* abase(const Unit& u) const { return (const char*)(A + ((size_t)u.aux * S5ROWS + (size_t)u.pm * 256) * S5K); }
    __device__ __forceinline__ const char* bbase(const Unit& u) const { return (const char*)(W + ((size_t)u.aux * brows + (size_t)u.pn * 256) * ldb); }
};
struct SchedMoe {
    TileOrder T; const bf16* A; const bf16* W; int lda, ldb; size_t wstride; const LAS int* tstart;
    __device__ __forceinline__ bool next(int i, Unit& u) const { int pm, pn; if (!T.tile(i, pm, pn)) return false; u.pm = pm; u.pn = pn; u.aux = __builtin_amdgcn_readfirstlane(tstart[pm]); return true; }
    __device__ __forceinline__ const char* abase(const Unit& u) const { return (const char*)(A + (size_t)u.pm * 256 * lda); }
    __device__ __forceinline__ const char* bbase(const Unit& u) const { return (const char*)(W + (size_t)u.aux * wstride + (size_t)u.pn * 256 * ldb); }
};

#define EPI_ROWS(u) const int row0 = (u).pm * 256 + wr * 64 + fr; const int cw0 = wc * 32 + 8 * fq;
struct EpiWin {
    bf16 *pA, *pN, *AG, *Gt;
    __device__ __forceinline__ void operator()(const f32x4 (&acc)[2][2][4][2], const Unit& u, int wr, int wc, int fr, int fq) const {
        EPI_ROWS(u) const int pn = u.pn;
#pragma unroll
        for (int ai = 0; ai < 2; ++ai)
#pragma unroll
            for (int m = 0; m < 4; ++m) { const int row = row0 + ai * 128 + m * 16;
#pragma unroll
                for (int bj = 0; bj < 2; ++bj) { const int cw = cw0 + bj * 128; const f32x4 v0 = acc[ai][bj][m][0], v1 = acc[ai][bj][m][1];
                    if (pn < 3) *(u32x4*)(pA + (size_t)row * 768 + pn * 256 + cw) = pack8(v0, v1);
                    else if (pn < 9) *(u32x4*)(pN + (size_t)row * 1536 + (pn - 3) * 256 + cw) = pack8(v0, v1);
                    else if (pn < 11) { const int ucol = (pn - 9) * 256 + cw, g = ucol >> 4, c = ucol & 15;
                        const int tk = row < NC ? row : row - NC; const int cr = (row < NC ? 512 : 0) + (tk >> 5), j = tk & 31;
                        *(u32x4*)(AG + ((size_t)g * S5ROWS + cr) * S5K + j * 16 + c) = pack8(v0, v1); }
                    else { f32x4 s0, s1;
#pragma unroll
                        for (int q = 0; q < 4; ++q) { s0[q] = fsigmoid(v0[q]); s1[q] = fsigmoid(v1[q]); }
                        *(u32x4*)(Gt + (size_t)row * 3072 + (pn - 11) * 256 + cw) = pack8(s0, s1); } } }
    }
};
struct EpiBf16 {
    bf16* O; int ldc;
    __device__ __forceinline__ void operator()(const f32x4 (&acc)[2][2][4][2], const Unit& u, int wr, int wc, int fr, int fq) const {
        EPI_ROWS(u)
#pragma unroll
        for (int ai = 0; ai < 2; ++ai)
#pragma unroll
            for (int m = 0; m < 4; ++m) { const int row = row0 + ai * 128 + m * 16;
#pragma unroll
                for (int bj = 0; bj < 2; ++bj) *(u32x4*)(O + (size_t)row * ldc + u.pn * 256 + cw0 + bj * 128) = pack8(acc[ai][bj][m][0], acc[ai][bj][m][1]); }
    }
};
struct EpiS5E {
    float* Eo;
    __device__ __forceinline__ void operator()(const f32x4 (&acc)[2][2][4][2], const Unit& u, int wr, int wc, int fr, int fq) const {
        EPI_ROWS(u)
#pragma unroll
        for (int ai = 0; ai < 2; ++ai)
#pragma unroll
            for (int m = 0; m < 4; ++m) { const int row = row0 + ai * 128 + m * 16;
#pragma unroll
                for (int bj = 0; bj < 2; ++bj) { float* p = Eo + ((size_t)u.aux * S5ROWS + row) * 256 + cw0 + bj * 128; *(f32x4*)p = acc[ai][bj][m][0]; *(f32x4*)(p + 4) = acc[ai][bj][m][1]; } }
    }
};
struct EpiS5Y {
    bf16* Z;
    __device__ __forceinline__ void operator()(const f32x4 (&acc)[2][2][4][2], const Unit& u, int wr, int wc, int fr, int fq) const {
        EPI_ROWS(u)
#pragma unroll
        for (int ai = 0; ai < 2; ++ai)
#pragma unroll
            for (int m = 0; m < 4; ++m) { const int cr = row0 + ai * 128 + m * 16;
                if (cr < 520) {
#pragma unroll
                for (int bj = 0; bj < 2; ++bj) { const int n = u.pn * 256 + cw0 + bj * 128, t = n >> 4, c = n & 15;
                    const int tok = cr < 512 ? NC + cr * 32 + t : (cr - 512) * 32 + t; f32x4 a, b;
#pragma unroll
                    for (int q = 0; q < 4; ++q) { a[q] = fgelu_tanh(acc[ai][bj][m][0][q]); b[q] = fgelu_tanh(acc[ai][bj][m][1][q]); }
                    *(u32x4*)(Z + (size_t)tok * 512 + u.aux * 16 + c) = pack8(a, b); } } }
    }
};
struct EpiGlu {
    const bf16* Z; bf16* O; const float* bias;
    __device__ __forceinline__ void operator()(const f32x4 (&acc)[2][2][4][2], const Unit& u, int wr, int wc, int fr, int fq) const {
        EPI_ROWS(u)
#pragma unroll
        for (int bj = 0; bj < 2; ++bj) { const int col = u.pn * 256 + cw0 + bj * 128; const f32x4 b0 = *(const f32x4*)(bias + col), b1 = *(const f32x4*)(bias + col + 4);
#pragma unroll
            for (int ai = 0; ai < 2; ++ai)
#pragma unroll
                for (int m = 0; m < 4; ++m) { const int row = row0 + ai * 128 + m * 16; float z[8]; unpack8(*(const u32x4*)(Z + (size_t)row * 512 + col), z); f32x4 a, b;
#pragma unroll
                    for (int q = 0; q < 4; ++q) { a[q] = z[q] * fsigmoid(acc[ai][bj][m][0][q] + b0[q]); b[q] = z[4 + q] * fsigmoid(acc[ai][bj][m][1][q] + b1[q]); }
                    *(u32x4*)(O + (size_t)row * 512 + col) = pack8(a, b); } }
    }
};
struct EpiMerge {
    const bf16* Gt; bf16* M1;
    __device__ __forceinline__ void operator()(const f32x4 (&acc)[2][2][4][2], const Unit& u, int wr, int wc, int fr, int fq) const {
        EPI_ROWS(u) const int br = u.aux;
#pragma unroll
        for (int ai = 0; ai < 2; ++ai)
#pragma unroll
            for (int m = 0; m < 4; ++m) { const int row = row0 + ai * 128 + m * 16;
#pragma unroll
                for (int bj = 0; bj < 2; ++bj) { const int col = u.pn * 256 + cw0 + bj * 128; float g[8]; unpack8(*(const u32x4*)(Gt + (size_t)row * 3072 + br * 1024 + col), g);
                    f32x4 a, b;
#pragma unroll
                    for (int q = 0; q < 4; ++q) { a[q] = g[q] * acc[ai][bj][m][0][q]; b[q] = g[4 + q] * acc[ai][bj][m][1][q]; }
                    bf16* mp = M1 + (size_t)row * 1024 + col;
                    if (br) { float o[8]; unpack8(*(const u32x4*)mp, o);
#pragma unroll
                        for (int q = 0; q < 4; ++q) { a[q] += o[q]; b[q] += o[4 + q]; } }
                    *(u32x4*)mp = pack8(a, b); } }
    }
};
struct EpiResid {
    bf16* xs; const float* ga_l; const float* ga_c;
    __device__ __forceinline__ void operator()(const f32x4 (&acc)[2][2][4][2], const Unit& u, int wr, int wc, int fr, int fq) const {
        EPI_ROWS(u) const float* ga = u.pm == 0 ? ga_c : ga_l;
#pragma unroll
        for (int bj = 0; bj < 2; ++bj) { const int col = u.pn * 256 + cw0 + bj * 128; const f32x4 g0 = *(const f32x4*)(ga + col), g1 = *(const f32x4*)(ga + col + 4);
#pragma unroll
            for (int ai = 0; ai < 2; ++ai)
#pragma unroll
                for (int m = 0; m < 4; ++m) { const int row = row0 + ai * 128 + m * 16; bf16* p = xs + (size_t)row * 1024 + col;
                    float x[8]; unpack8(*(const u32x4*)p, x); const f32x4 x0 = {x[0], x[1], x[2], x[3]}, x1 = {x[4], x[5], x[6], x[7]};
                    *(u32x4*)p = pack8(x0 + g0 * acc[ai][bj][m][0], x1 + g1 * acc[ai][bj][m][1]); } }
    }
};
struct SchedMoeDown {
    TileOrder T; const bf16* A; const bf16* W; const LAS int* tstart;
    __device__ __forceinline__ bool next(int i, Unit& u) const { int pm, pn; if (!T.tile(i, pm, pn)) return false; u.pm = pm; u.pn = pn; u.aux = __builtin_amdgcn_readfirstlane(tstart[pm]); return true; }
    __device__ __forceinline__ const char* abase(const Unit& u) const { return (const char*)(A + (size_t)u.pm * 256 * FF + (u.pn >> 2) * 1408); }
    __device__ __forceinline__ const char* bbase(const Unit& u) const { return (const char*)(W + (size_t)u.aux * D * FF + (size_t)(u.pn & 3) * 256 * FF + (u.pn >> 2) * 1408); }
};
struct SchedMoeDown8 {
    TileOrder T; const bf16* A; const bf16* W; const LAS int* tstart;
    __device__ __forceinline__ bool next(int i, Unit& u) const { int pm, pn; if (!T.tile(i, pm, pn)) return false; u.pm = pm; u.pn = pn; u.aux = __builtin_amdgcn_readfirstlane(tstart[pm]); return true; }
    __device__ __forceinline__ int knt(const Unit& u) const { return (u.pn >> 2) ? 10 : 12; }
    __device__ __forceinline__ const char* abase(const Unit& u) const { return (const char*)(A + (size_t)u.pm * 256 * (FF / 2) + (u.pn >> 2) * 768); }
    __device__ __forceinline__ const char* bbase(const Unit& u) const { return (const char*)(W + (size_t)u.aux * D * (FF / 2) + (size_t)(u.pn & 3) * 256 * (FF / 2) + (u.pn >> 2) * 768); }
};
struct EpiMoeY {
    bf16* Y0; bf16* Y1;
    __device__ __forceinline__ void operator()(const f32x4 (&acc)[2][2][4][2], const Unit& u, int wr, int wc, int fr, int fq) const {
        EPI_ROWS(u) bf16* O = (u.pn >> 2) ? Y1 : Y0; const int colt = (u.pn & 3) * 256;
#pragma unroll
        for (int ai = 0; ai < 2; ++ai)
#pragma unroll
            for (int m = 0; m < 4; ++m) { const int row = row0 + ai * 128 + m * 16;
#pragma unroll
                for (int bj = 0; bj < 2; ++bj) *(u32x4*)(O + (size_t)row * D + colt + cw0 + bj * 128) = pack8(acc[ai][bj][m][0], acc[ai][bj][m][1]); }
    }
};
struct SchedCtxK {
    int nsl, nks, G, c; const bf16* A; size_t astride; const bf16* Bt; int lda, ldb;
    __device__ __forceinline__ bool next(int i, Unit& u) const { const int L = i * G + c; if (L >= 4 * nsl) return false; u.pm = 0; u.pn = L & 3; u.aux = L >> 2; return true; }
    __device__ __forceinline__ const char* abase(const Unit& u) const { return (const char*)(A + (size_t)(u.aux / nks) * astride + (size_t)(u.aux % nks) * 256); }
    __device__ __forceinline__ const char* bbase(const Unit& u) const { return (const char*)(Bt + (size_t)u.pn * 256 * ldb + (size_t)(u.aux % nks) * 256); }
};
struct SchedCtxMerge {
    int G, c; const bf16* O; const bf16* W;
    __device__ __forceinline__ bool next(int i, Unit& u) const { const int L = i * G + c; if (L >= 12) return false; u.pm = 0; u.pn = L & 3; u.aux = L >> 2; return true; }
    __device__ __forceinline__ const char* abase(const Unit& u) const { return (const char*)(O + (size_t)u.aux * NT * 512); }
    __device__ __forceinline__ const char* bbase(const Unit& u) const { return (const char*)(W + ((size_t)u.aux * 1024 + (size_t)u.pn * 256) * 512); }
};
struct EpiMergeCtx {
    const bf16* Gt; bf16* M1C;
    __device__ __forceinline__ void operator()(const f32x4 (&acc)[2][2][4][2], const Unit& u, int wr, int wc, int fr, int fq) const {
        EPI_ROWS(u) const int br = u.aux;
#pragma unroll
        for (int ai = 0; ai < 2; ++ai)
#pragma unroll
            for (int m = 0; m < 4; ++m) { const int row = row0 + ai * 128 + m * 16;
#pragma unroll
                for (int bj = 0; bj < 2; ++bj) { const int col = u.pn * 256 + cw0 + bj * 128; float g[8]; unpack8(*(const u32x4*)(Gt + (size_t)row * 3072 + br * 1024 + col), g);
                    f32x4 a, b;
#pragma unroll
                    for (int q = 0; q < 4; ++q) { a[q] = g[q] * acc[ai][bj][m][0][q]; b[q] = g[4 + q] * acc[ai][bj][m][1][q]; }
                    *(u32x4*)(M1C + ((size_t)br * 256 + row) * 1024 + col) = pack8(a, b); } }
    }
};
struct EpiResidPart {
    float* part; const float* ga;
    __device__ __forceinline__ void operator()(const f32x4 (&acc)[2][2][4][2], const Unit& u, int wr, int wc, int fr, int fq) const {
        EPI_ROWS(u)
#pragma unroll
        for (int bj = 0; bj < 2; ++bj) { const int col = u.pn * 256 + cw0 + bj * 128; const f32x4 g0 = *(const f32x4*)(ga + col), g1 = *(const f32x4*)(ga + col + 4);
#pragma unroll
            for (int ai = 0; ai < 2; ++ai)
#pragma unroll
                for (int m = 0; m < 4; ++m) { const int row = row0 + ai * 128 + m * 16; float* p = part + ((size_t)u.aux * 256 + row) * 1024 + col;
                    *(f32x4*)p = g0 * acc[ai][bj][m][0]; *(f32x4*)(p + 4) = g1 * acc[ai][bj][m][1]; } }
    }
};
struct EpiUp8 {
    unsigned char* Act;
    __device__ __forceinline__ void operator()(const f32x4 (&acc)[2][2][4][2], const Unit& u, int wr, int wc, int fr, int fq) const {
        EPI_ROWS(u)
#pragma unroll
        for (int ai = 0; ai < 2; ++ai)
#pragma unroll
            for (int m = 0; m < 4; ++m) { const int row = row0 + ai * 128 + m * 16; f32x4 a, b;
#pragma unroll
                for (int q = 0; q < 4; ++q) { a[q] = 4.f * fsilu(acc[ai][0][m][0][q]) * acc[ai][1][m][0][q]; b[q] = 4.f * fsilu(acc[ai][0][m][1][q]) * acc[ai][1][m][1][q]; }
                u32x2 w; w.x = (unsigned)__builtin_amdgcn_cvt_pk_fp8_f32(a[2], a[3], __builtin_amdgcn_cvt_pk_fp8_f32(a[0], a[1], 0, false), true);
                w.y = (unsigned)__builtin_amdgcn_cvt_pk_fp8_f32(b[2], b[3], __builtin_amdgcn_cvt_pk_fp8_f32(b[0], b[1], 0, false), true);
                *(u32x2*)(Act + (size_t)row * FF + u.pn * 128 + cw0) = w; }
    }
};
struct EpiUp {
    bf16* Act;
    __device__ __forceinline__ void operator()(const f32x4 (&acc)[2][2][4][2], const Unit& u, int wr, int wc, int fr, int fq) const {
        EPI_ROWS(u)
#pragma unroll
        for (int ai = 0; ai < 2; ++ai)
#pragma unroll
            for (int m = 0; m < 4; ++m) { const int row = row0 + ai * 128 + m * 16; f32x4 a, b;
#pragma unroll
                for (int q = 0; q < 4; ++q) { a[q] = fsilu(acc[ai][0][m][0][q]) * acc[ai][1][m][0][q]; b[q] = fsilu(acc[ai][0][m][1][q]) * acc[ai][1][m][1][q]; }
                *(u32x4*)(Act + (size_t)row * FF + u.pn * 128 + cw0) = pack8(a, b); }
    }
};
}

namespace att {
constexpr float THR = 8.f;
__device__ __forceinline__ int crow(int r, int hi) { return (r & 3) + 8 * (r >> 2) + 4 * hi; }
template <int DQK> struct Cst { static constexpr float SCALE = DQK == 96 ? 0.10206207261596575f : 0.125f; static constexpr float C = SCALE * 1.4426950408889634f; };

__device__ __forceinline__ void partialSM(f32x16& p0) {
#pragma unroll
    for (int r = 0; r < 16; ++r) p0[r] = __builtin_amdgcn_exp2f(p0[r]);
}
__device__ __forceinline__ void finishSM(f32x16& p0, f32x16& p1, float& l_reg, bf16x8& pa0, bf16x8& pa1, bf16x8& pa2, bf16x8& pa3) {
#pragma unroll
    for (int r = 0; r < 16; ++r) p1[r] = __builtin_amdgcn_exp2f(p1[r]);
    float ps = 0;
#pragma unroll
    for (int r = 0; r < 16; ++r) ps += p0[r];
#pragma unroll
    for (int r = 0; r < 16; ++r) ps += p1[r];
    { auto rr = __builtin_amdgcn_permlane32_swap(__float_as_uint(ps), __float_as_uint(ps), false, false);
      ps = __uint_as_float(rr[0]) + __uint_as_float(rr[1]); }
    l_reg += ps;
#define PK4(P, BASE, OUT) do { unsigned a0 = cvtpk(P[BASE + 0], P[BASE + 1]), a1 = cvtpk(P[BASE + 2], P[BASE + 3]);   \
    unsigned b0 = cvtpk(P[BASE + 4], P[BASE + 5]), b1 = cvtpk(P[BASE + 6], P[BASE + 7]);                              \
    auto r0 = __builtin_amdgcn_permlane32_swap(a0, b0, false, false); auto r1 = __builtin_amdgcn_permlane32_swap(a1, b1, false, false); \
    u32x4 w = {r0[0], r1[0], r0[1], r1[1]}; OUT = *reinterpret_cast<bf16x8*>(&w); } while (0)
    PK4(p0, 0, pa0); PK4(p0, 8, pa1); PK4(p1, 0, pa2); PK4(p1, 8, pa3);
#undef PK4
}
__device__ __forceinline__ int v_st(int k, int c) { const int kk = (k & ~0xC) | ((k & 4) << 1) | ((k & 8) >> 1); return ((kk >> 3) * 2 + (c >> 5)) * 512 + ((kk & 7) * 32 + (c & 31)) * 2; }
__device__ __forceinline__ int v_rd_base(int lane) { return ((lane & 3) << 3) | (((lane >> 2) & 3) << 6) | (((lane >> 4) & 1) << 5) | (((lane >> 5) & 1) << 8); }
constexpr int v_rd_off(int d0, int ks, int half) { return d0 * 512 + ks * 2048 + half * 1024; }
template <int OFF> __device__ __forceinline__ s16x4 tr_read(int vb) {
    s16x4 r; asm volatile("ds_read_b64_tr_b16 %0, %1 offset:%2" : "=&v"(r) : "v"(vb), "i"(OFF) : "memory"); return r;
}
template <int D0> __device__ __forceinline__ void pv_one(f32x16& od, int vb, bf16x8 pa0, bf16x8 pa1, bf16x8 pa2, bf16x8 pa3) {
    const s16x4 l0 = tr_read<v_rd_off(D0, 0, 0)>(vb), h0 = tr_read<v_rd_off(D0, 0, 1)>(vb), l1 = tr_read<v_rd_off(D0, 1, 0)>(vb), h1 = tr_read<v_rd_off(D0, 1, 1)>(vb);
    const s16x4 l2 = tr_read<v_rd_off(D0, 2, 0)>(vb), h2 = tr_read<v_rd_off(D0, 2, 1)>(vb), l3 = tr_read<v_rd_off(D0, 3, 0)>(vb), h3 = tr_read<v_rd_off(D0, 3, 1)>(vb);
    asm volatile("s_waitcnt lgkmcnt(0)" ::: "memory"); SBAR();
#define PK(L, H) (bf16x8){L[0], L[1], L[2], L[3], H[0], H[1], H[2], H[3]}
    od = __builtin_amdgcn_mfma_f32_32x32x16_bf16(pa0, PK(l0, h0), od, 0, 0, 0);
    od = __builtin_amdgcn_mfma_f32_32x32x16_bf16(pa1, PK(l1, h1), od, 0, 0, 0);
    od = __builtin_amdgcn_mfma_f32_32x32x16_bf16(pa2, PK(l2, h2), od, 0, 0, 0);
    od = __builtin_amdgcn_mfma_f32_32x32x16_bf16(pa3, PK(l3, h3), od, 0, 0, 0);
#undef PK
}

constexpr float V8_OFF = -3.0f;
__device__ __forceinline__ int v8_pos(int k) { const int kb = k >> 5, kk = k & 31; return 32 * ((kk >> 2) & 1) + 16 * kb + 4 * (kk >> 3) + (kk & 3); }
__device__ __forceinline__ int v8_byte(int dim, int pos) { return dim * 64 + ((((pos >> 4) ^ (dim >> 2)) & 3) << 4) + (pos & 15); }
__device__ __forceinline__ void finishSM8(f32x16& p0, f32x16& p1, i32x8& pk) {
#pragma unroll
    for (int r = 0; r < 16; ++r) p1[r] = __builtin_amdgcn_exp2f(p1[r]);
#pragma unroll
    for (int w = 0; w < 4; ++w) { int a = __builtin_amdgcn_cvt_pk_fp8_f32(p0[4 * w], p0[4 * w + 1], 0, false); pk[w] = __builtin_amdgcn_cvt_pk_fp8_f32(p0[4 * w + 2], p0[4 * w + 3], a, true);
                                  int b = __builtin_amdgcn_cvt_pk_fp8_f32(p1[4 * w], p1[4 * w + 1], 0, false); pk[4 + w] = __builtin_amdgcn_cvt_pk_fp8_f32(p1[4 * w + 2], p1[4 * w + 3], b, true); }
}
__device__ __forceinline__ i32x8 ld32(const LAS unsigned char* p) { const u32x4 lo = *(const LAS u32x4*)p, hi4 = *(const LAS u32x4*)(p + 16);
    return (i32x8){(int)lo[0], (int)lo[1], (int)lo[2], (int)lo[3], (int)hi4[0], (int)hi4[1], (int)hi4[2], (int)hi4[3]}; }
__device__ __forceinline__ void pv8_sum(f32x16& os, const i32x8 pk) {
    const i32x8 ones = {0x38383838, 0x38383838, 0x38383838, 0x38383838, 0x38383838, 0x38383838, 0x38383838, 0x38383838};
    os = __builtin_amdgcn_mfma_scale_f32_32x32x64_f8f6f4(pk, ones, os, 0, 0, 0, 0x7F7F7F7F, 0, 0x7F7F7F7F);
}
template <int D0> __device__ __forceinline__ void pv8_one(f32x16& od, const LAS unsigned char* vt, int r32, int hi, const i32x8 pk) {
    const LAS unsigned char* row = vt + (32 * D0 + r32) * 64; const int sw = (r32 >> 2) & 3;
    const u32x4 lo = *(const LAS u32x4*)(row + (((2 * hi) ^ sw) << 4)), hi4 = *(const LAS u32x4*)(row + (((2 * hi + 1) ^ sw) << 4));
    const i32x8 vb = {(int)lo[0], (int)lo[1], (int)lo[2], (int)lo[3], (int)hi4[0], (int)hi4[1], (int)hi4[2], (int)hi4[3]};
    od = __builtin_amdgcn_mfma_scale_f32_32x32x64_f8f6f4(pk, vb, od, 0, 0, 0, 0x7F7F7F7F, 0, 0x7F7F7F7F);
}

template <int DQK, bool NA, bool V8 = false>
__device__ __forceinline__ void attn_unit(const bf16* __restrict__ Qb, const int ldq, const bf16* __restrict__ Kh, const int ldk, const bf16* __restrict__ Vh, const int ldv,
                                          bf16* __restrict__ Ob, const int NT_, const int gr_lo, const int gr_hi, const int qb, const float* __restrict__ rpb, LAS unsigned char* lds) {
    constexpr int ND = DQK / 16, KST = DQK * 2 + 16, KCH = DQK / 8, SHK = 64 * KST, SHV = 64 * 64 * 2;
    constexpr float SCALE = Cst<DQK>::SCALE;
    int tid_ = threadIdx.x; asm volatile("" : "+v"(tid_));
    const int tid = tid_, wid = __builtin_amdgcn_readfirstlane(tid >> 6), lane = tid & 63, r32 = lane & 31, hi = lane >> 5;
    constexpr int NSLOT = V8 ? 4 : 2;
    LAS unsigned char* K_lds = lds; LAS unsigned char* V_lds = lds + NSLOT * SHK;
    LAS float* wsf = (LAS float*)(lds + NSLOT * SHK + NSLOT * SHV) + wid * 64; LAS float* li_l = wsf;
    LAS float* btab = (LAS float*)(lds + NSLOT * SHK + NSLOT * SHV + 2048 + 256);
    float l_reg = 0.f; f32x16 o[2] = {}, osum = {}; bf16x8 qr[ND]; i32x8 q8[2];
    if constexpr (V8) {
        const bf16* Qw = Qb + (size_t)(wid * 32 + r32) * ldq;
#pragma unroll
        for (int m = 0; m < 2; ++m)
#pragma unroll
            for (int c = 0; c < 4; ++c) { float f[8]; unpack8(*(const u32x4*)(Qw + (m == 0 ? 32 * hi : 64) + c * 8), f);
                const int w0 = __builtin_amdgcn_cvt_pk_fp8_f32(f[2], f[3], __builtin_amdgcn_cvt_pk_fp8_f32(f[0], f[1], 0, false), true), w1 = __builtin_amdgcn_cvt_pk_fp8_f32(f[6], f[7], __builtin_amdgcn_cvt_pk_fp8_f32(f[4], f[5], 0, false), true);
                q8[m][2 * c] = (m == 1 && hi) ? 0 : w0; q8[m][2 * c + 1] = (m == 1 && hi) ? 0 : w1; }
    } else { const bf16* Qw = Qb + (size_t)(wid * 32 + r32) * ldq + hi * 8;
#pragma unroll
      for (int d0 = 0; d0 < ND; ++d0) qr[d0] = *(const bf16x8*)(Qw + d0 * 16); }
    const int kc8 = tid < 448 ? tid : tid - 64;
    const int ka0 = r32 * 112 + 32 * hi, ka1 = hi ? 7168 : r32 * 112 + 64, ka1b = hi ? 7168 : (32 + r32) * 112 + 64;
    if constexpr (V8) { if (tid < 8) { *(LAS u32x4*)(lds + (tid >> 1) * SHK + 7168 + (tid & 1) * 16) = (u32x4){0u, 0u, 0u, 0u}; } }
    const int id0 = tid, rk0 = id0 / KCH, ck0 = id0 % KCH;
    const int id1 = 512 + (tid & 255), rk1 = id1 / KCH, ck1 = id1 % KCH;
    const int rv = tid >> 3, cv = tid & 7;
    const int kst0 = rk0 * KST + ck0 * 16, kst1 = rk1 * KST + ck1 * 16, vst = v_st(rv, cv * 8);
    const int vb0 = (int)(uintptr_t)V_lds + v_rd_base(lane);
    struct { bf16x8 k0, k1, v; u32x2 v8; } sr_[2];
    const int rqw = 4 * qb + (wid >> 1), cq = 32 * (wid & 1) + r32;
    const int r0w = rqw - 4 < 0 ? 0 : (rqw - 4 > 248 ? 248 : rqw - 4);
    const int c0 = cq - 8 < 0 ? 0 : (cq - 8 > 48 ? 48 : cq - 8);
    if constexpr (NA) { for (int i = tid; i < 465; i += 512) btab[i] = rpb[i] * 1.4426950408889634f; }
#define KB_OF(j) (NA ? ((j) < 4 ? 64 * (j) : NC + 64 * (gr_lo + (j) - 4 > gr_hi ? gr_hi : gr_lo + (j) - 4)) : 64 * (j))
#define SLOAD(i, j) do { const int kb_ = KB_OF(j); if constexpr (V8) sr_[i].k0 = *(const bf16x8*)((const unsigned char*)Kh + (size_t)(kb_ >> 6) * 7168 + kc8 * 16); else { sr_[i].k0 = *(const bf16x8*)(Kh + (size_t)(kb_ + rk0) * ldk + ck0 * 8); \
        if constexpr (DQK == 96) sr_[i].k1 = *(const bf16x8*)(Kh + (size_t)(kb_ + rk1) * ldk + ck1 * 8); } \
        if constexpr (V8) sr_[i].v8 = *(const u32x2*)((const unsigned char*)Vh + (size_t)(kb_ >> 6) * 4096 + tid * 8); else sr_[i].v = *(const bf16x8*)(Vh + (size_t)(kb_ + rv) * ldv + cv * 8); } while (0)
#define SWRITE(b, i) do { if constexpr (V8) *(LAS bf16x8*)(K_lds + (b) * SHK + kc8 * 16) = sr_[i].k0; else { *(LAS bf16x8*)(K_lds + (b) * SHK + kst0) = sr_[i].k0; if constexpr (DQK == 96) *(LAS bf16x8*)(K_lds + (b) * SHK + kst1) = sr_[i].k1; } \
        if constexpr (V8) *(LAS u32x2*)(V_lds + (b) * SHV + tid * 8) = sr_[i].v8; else *(LAS bf16x8*)(V_lds + (b) * SHV + vst) = sr_[i].v; } while (0)
#define SWAIT() do { if constexpr (DQK == 96 && !V8) asm volatile("s_waitcnt vmcnt(3)" ::: "memory"); else asm volatile("s_waitcnt vmcnt(2)" ::: "memory"); } while (0)
#define QKT(P0, P1, V, b, j) do { V = true; int gk_ = 0; if constexpr (NA) { if ((j) >= 4) { gk_ = gr_lo + (j) - 4; V = (gk_ <= gr_hi) && (gk_ >= r0w) && (gk_ <= r0w + 7); } } \
        if (V) { if constexpr (V8) { _Pragma("unroll") for (int r_ = 0; r_ < 16; ++r_) { P0[r_] = V8_OFF; P1[r_] = V8_OFF; } } else { P0 = f32x16{}; P1 = f32x16{}; } const LAS unsigned char* Ks_ = K_lds + (b) * SHK; \
            if constexpr (V8) { const i32x8 a00 = ld32(Ks_ + ka0), a01 = ld32(Ks_ + ka1), a10 = ld32(Ks_ + 3584 + ka0), a11 = ld32(Ks_ + ka1b); \
                P0 = __builtin_amdgcn_mfma_scale_f32_32x32x64_f8f6f4(a00, q8[0], P0, 0, 0, 0, 0x7F7F7F7F, 0, 0x7F7F7F7F); P1 = __builtin_amdgcn_mfma_scale_f32_32x32x64_f8f6f4(a10, q8[0], P1, 0, 0, 0, 0x7F7F7F7F, 0, 0x7F7F7F7F); \
                P0 = __builtin_amdgcn_mfma_scale_f32_32x32x64_f8f6f4(a01, q8[1], P0, 0, 0, 0, 0x7F7F7F7F, 0, 0x7F7F7F7F); P1 = __builtin_amdgcn_mfma_scale_f32_32x32x64_f8f6f4(a11, q8[1], P1, 0, 0, 0, 0x7F7F7F7F, 0, 0x7F7F7F7F); } else \
            _Pragma("unroll") for (int d0 = 0; d0 < ND; ++d0) { const int cb = (d0 * 16 + hi * 8) * 2; \
                const bf16x8 b0 = *(const LAS bf16x8*)(Ks_ + r32 * KST + cb); const bf16x8 b1 = *(const LAS bf16x8*)(Ks_ + (32 + r32) * KST + cb); \
                P0 = __builtin_amdgcn_mfma_f32_32x32x16_bf16(b0, qr[d0], P0, 0, 0, 0); P1 = __builtin_amdgcn_mfma_f32_32x32x16_bf16(b1, qr[d0], P1, 0, 0, 0); } \
            if constexpr (NA) { if ((j) >= 4) { const LAS float* bb_ = btab + (gk_ - rqw + 7) * 31 + (15 - cq) + 4 * hi; \
                _Pragma("unroll") for (int r = 0; r < 16; ++r) { const int ckc = (r & 3) + 8 * (r >> 2); const int ck = ckc + 4 * hi; \
                    P0[r] = (ck >= c0 && ck <= c0 + 15) ? P0[r] + bb_[ckc] : -1e30f; P1[r] = (ck + 32 >= c0 && ck + 32 <= c0 + 15) ? P1[r] + bb_[ckc + 32] : -1e30f; } } } } } while (0)
#define PSM(P0, V) do { if (V) partialSM(P0); } while (0)
#define FSM(P0, P1) do { if constexpr (V8) finishSM8(P0, P1, pk8); else finishSM(P0, P1, l_reg, pa0, pa1, pa2, pa3); } while (0)
#define PV(vbuf) do { if constexpr (V8) { pv8_one<0>(o[0], V_lds + (vbuf) * SHV, r32, hi, pk8); pv8_one<1>(o[1], V_lds + (vbuf) * SHV, r32, hi, pk8); pv8_sum(osum, pk8); } \
        else { pv_one<0>(o[0], vb0 + (vbuf) * SHV, pa0, pa1, pa2, pa3); pv_one<1>(o[1], vb0 + (vbuf) * SHV, pa0, pa1, pa2, pa3); } } while (0)
#define FSM_PV(P0, P1, V, vbuf) do { if (V) { FSM(P0, P1); SBAR(); PV(vbuf); } } while (0)
    f32x16 pA0, pA1, pB0, pB1; bf16x8 pa0, pa1, pa2, pa3; i32x8 pk8; bool vA, vB; const int NTl = NT_;
    if constexpr (V8) {
        const int NP = NTl >> 1;
        SLOAD(0, 0); SLOAD(1, 1); VM_WAIT(); SWRITE(0, 0); SWRITE(1, 1); __syncthreads();
#define PAIR(sb, nb, pp) do { const int jn_ = ((pp) + 1 < NP ? (pp) + 1 : (pp)) * 2; SLOAD(0, jn_); SLOAD(1, jn_ + 1); SBAR(); \
            QKT(pA0, pA1, vA, sb, 0); PSM(pA0, vA); SBAR(); \
            QKT(pB0, pB1, vB, (sb) + 1, 0); FSM(pA0, pA1); SBAR(); \
            PV(sb); PSM(pB0, vB); SBAR(); \
            FSM(pB0, pB1); SBAR(); PV((sb) + 1); \
            asm volatile("s_waitcnt vmcnt(0)" ::: "memory"); SWRITE(nb, 0); SWRITE((nb) + 1, 1); __syncthreads(); } while (0)
        for (int p = 0; p < NP; p += 2) { PAIR(0, 2, p); PAIR(2, 0, p + 1); }
#undef PAIR
    } else {
    SLOAD(0, 0); VM_WAIT(); SWRITE(0, 0); __syncthreads();
    QKT(pA0, pA1, vA, 0, 0); PSM(pA0, vA);
    SLOAD(1, 1); SLOAD(0, (2 < NTl ? 2 : NTl - 1));
    SWAIT(); SWRITE(1, 1); __syncthreads();
    for (int j = 1; j + 1 < NTl; j += 2) {
        SBAR(); QKT(pB0, pB1, vB, 1, j);
        if (vA) { FSM(pA0, pA1); } SBAR();
        SLOAD(1, j + 2); SBAR();
        if (vA) { PV(0); }
        PSM(pB0, vB);
        __syncthreads(); SWAIT(); SWRITE(0, 0);
        __syncthreads();
        SBAR(); QKT(pA0, pA1, vA, 0, j + 1);
        if (vB) { FSM(pB0, pB1); } SBAR();
        SLOAD(0, (j + 3 < NTl ? j + 3 : NTl - 1)); SBAR();
        if (vB) { PV(1); }
        PSM(pA0, vA);
        __syncthreads(); SWAIT(); SWRITE(1, 1);
        __syncthreads();
    }
    SBAR(); QKT(pB0, pB1, vB, 1, NTl - 1);
    FSM_PV(pA0, pA1, vA, 0); PSM(pB0, vB);
    FSM_PV(pB0, pB1, vB, 1);
    }
    if constexpr (!V8) { if (hi == 0) li_l[r32] = l_reg; asm volatile("s_waitcnt lgkmcnt(0)" ::: "memory"); }
    bf16* Ow = Ob + (size_t)(wid * 32) * 512;
#pragma unroll
    for (int r = 0; r < 16; ++r) { const int orow = crow(r, hi); float rl; if constexpr (V8) rl = __builtin_amdgcn_rcpf(osum[r]); else rl = __builtin_amdgcn_rcpf(li_l[orow]);
#pragma unroll
        for (int d0 = 0; d0 < 2; ++d0) Ow[(size_t)orow * 512 + d0 * 32 + r32] = f2bf(o[d0][r] * rl); }
    __syncthreads();
#undef KB_OF
#undef SLOAD
#undef SWRITE
#undef SWAIT
#undef QKT
#undef PSM
#undef FSM_PV
#undef FSM
#undef PV
}
}

struct Args { const float* in[39]; float* out; unsigned char* ws; int ph_lo, ph_hi; };
struct Frame {
    LAS unsigned char* lds; unsigned char* ws; float* out;
    int tid, lane, wave, vcu, G, gw, NGW;
};
#define WSP(T, off) ((T*)(F.ws + (off)))
constexpr int INTAB_OFF = RING_BYTES + 1024;
__device__ __forceinline__ const float* inp(const Frame& F, int i) {
    const LAS unsigned* t = (const LAS unsigned*)(F.lds + INTAB_OFF) + 2 * i;
    const unsigned lo = __builtin_amdgcn_readfirstlane(t[0]), hi = __builtin_amdgcn_readfirstlane(t[1]);
    return (const float*)(const GAS float*)(((unsigned long long)hi << 32) | lo);
}

struct CvtItem { const float* src; bf16* dst; const float* kscale; int ldw, ldt, k0; bool zero; bool f8; };
__device__ __forceinline__ void cvt_load(const CvtItem& d, f32x4 (&v)[8], int lane) {
#pragma unroll
    for (int i = 0; i < 8; ++i) { const int kk = 8 * i + (lane >> 3), n4 = (lane & 7) * 4; v[i] = d.zero ? (f32x4){0.f, 0.f, 0.f, 0.f} : __builtin_nontemporal_load((const f32x4*)(d.src + (size_t)kk * d.ldw + n4)); }
}
__device__ __forceinline__ void cvt_store(const CvtItem& d, f32x4 (&v)[8], LAS float* scr, int lane) {
#pragma unroll
    for (int i = 0; i < 8; ++i) { const int kk = 8 * i + (lane >> 3), n4 = (lane & 7) * 4; f32x4 x = v[i]; if (d.kscale) x *= d.kscale[d.k0 + kk];
        scr[kk * 33 + n4] = x[0]; scr[kk * 33 + n4 + 1] = x[1]; scr[kk * 33 + n4 + 2] = x[2]; scr[kk * 33 + n4 + 3] = x[3]; }
    LDS_WAIT(); asm volatile("" ::: "memory");
    const int c = lane & 7;
#pragma unroll
    for (int j = 0; j < 4; ++j) { const int n = (lane >> 3) + 8 * j; const LAS float* s = scr + (8 * c) * 33 + n;
        if (d.f8) { u32x2 o;
            o.x = (unsigned)__builtin_amdgcn_cvt_pk_fp8_f32(32.f * s[2 * 33], 32.f * s[3 * 33], __builtin_amdgcn_cvt_pk_fp8_f32(32.f * s[0 * 33], 32.f * s[1 * 33], 0, false), true);
            o.y = (unsigned)__builtin_amdgcn_cvt_pk_fp8_f32(32.f * s[6 * 33], 32.f * s[7 * 33], __builtin_amdgcn_cvt_pk_fp8_f32(32.f * s[4 * 33], 32.f * s[5 * 33], 0, false), true);
            *(u32x2*)(d.dst + (size_t)n * d.ldt + 4 * c) = o; }
        else { u32x4 o; o.x = cvtpk(s[0 * 33], s[1 * 33]); o.y = cvtpk(s[2 * 33], s[3 * 33]); o.z = cvtpk(s[4 * 33], s[5 * 33]); o.w = cvtpk(s[6 * 33], s[7 * 33]);
        *(u32x4*)(d.dst + (size_t)n * d.ldt + 8 * c) = o; } }
    LDS_WAIT(); asm volatile("" ::: "memory");
}
__device__ __forceinline__ CvtItem cvt_decode(Frame& F, int l, int it) {
#ifdef DBG_CONV8
    const int j = 0; const bool moe = (l & 1);
#else
    const int j = l >> 1; const bool moe = (l & 1) && !DBG_NOMOE;
#endif
    constexpr int I_WIN = (DINP / 32) * (D / 64), I_UQ = (768 / 32) * (384 / 64), I_UKV = (1024 / 32) * (256 / 64), I_GLU = (512 / 32) * (512 / 64), I_BR = (1024 / 32) * (512 / 64), I_OUT = (1024 / 32) * (1024 / 64);
    constexpr int I_GU = (FF2 / 32) * (D / 64), I_DN = (1024 / 32) * (FF / 64);
    CvtItem d; d.kscale = nullptr; d.zero = false; d.f8 = false; int r = it;
#define CVT_SET(W, LDW, C0, K0, WT, R0, LDT) do { d.ldw = (LDW); d.ldt = (LDT); d.k0 = (K0); d.src = (W) + (size_t)(K0) * (LDW) + (C0); d.dst = (WT) + (size_t)(R0) * (LDT) + (K0); } while (0)
    if (r < I_WIN) { const int nb = r % (DINP / 32), kb = r / (DINP / 32); const int n0 = nb * 32; const bool z = (n0 >= 672 && n0 < 768); const int c0 = n0 < 672 ? n0 : n0 - 96;
        CVT_SET(inp(F, 8) + (size_t)l * D * 5792, 5792, z ? 0 : c0, kb * 64, WSP(bf16, WS_WIN), n0, D); d.zero = z; return d; } r -= I_WIN;
    if (r < I_UQ) { const int nb = r % 24, kb = r / 24; CVT_SET(inp(F, 11) + (size_t)l * 384 * 768, 768, nb * 32, kb * 64, WSP(bf16, WS_WUQ), nb * 32, 384); d.kscale = inp(F, 9) + l * 384; return d; } r -= I_UQ;
    if (r < I_UKV) { const int nb = r % 32, kb = r / 32; CVT_SET(inp(F, 12) + (size_t)l * 256 * 1024, 1024, nb * 32, kb * 64, WSP(bf16, WS_WUKV), nb * 32, 256); d.kscale = inp(F, 10) + l * 256; return d; } r -= I_UKV;
    if (r < I_GLU) { const int nb = r % 16, kb = r / 16; CVT_SET(inp(F, 26) + (size_t)l * 512 * 512, 512, nb * 32, kb * 64, WSP(bf16, WS_WGLU), nb * 32, 512); return d; } r -= I_GLU;
    if (r < 3 * I_BR) { const int br = r / I_BR, q = r % I_BR, nb = q % 32, kb = q / 32; CVT_SET(inp(F, 28 + br) + (size_t)l * 512 * 1024, 1024, nb * 32, kb * 64, WSP(bf16, WS_WBR) + (size_t)br * 1024 * 512, nb * 32, 512); return d; } r -= 3 * I_BR;
    if (r < I_OUT) { const int nb = r % 32, kb = r / 32; CVT_SET(inp(F, 31) + (size_t)l * D * D, D, nb * 32, kb * 64, WSP(bf16, WS_WOUT), nb * 32, D); return d; } r -= I_OUT;
    const int e = r / (I_GU + I_DN); r = r % (I_GU + I_DN);
    const size_t eo = moe ? ((size_t)j * NEXP + e) : (size_t)j;
    if (r < I_GU) { const int nb = r % (FF2 / 32), kb = r / (FF2 / 32); const int n0 = nb * 32, t = n0 >> 8, i = n0 & 255; const bool up = i >= 128; const int c0 = t * 128 + (i & 127);
        const float* src = (moe ? (up ? inp(F, 37) : inp(F, 36)) : (up ? inp(F, 33) : inp(F, 32))) + eo * (size_t)D * FF;
        CVT_SET(src, FF, c0, kb * 64, WSP(bf16, WS_WGU) + (size_t)e * FF2 * D, n0, D);
        if (moe) { d.f8 = true; d.ldt = D / 2; d.dst = WSP(bf16, WS_WGU) + (size_t)e * FF2 * D / 2 + (size_t)n0 * (D / 2) + (kb * 64) / 2; }
        return d; } r -= I_GU;
    { const int nb = r % 32, kb = r / 32; const float* src = (moe ? inp(F, 38) : inp(F, 34)) + eo * (size_t)FF * D;
      CVT_SET(src, D, nb * 32, kb * 64, WSP(bf16, WS_WD) + (size_t)e * D * FF, nb * 32, FF);
      if (moe) { d.f8 = true; d.ldt = FF / 2; d.dst = WSP(bf16, WS_WD) + (size_t)e * D * (FF / 2) + (size_t)(nb * 32) * (FF / 2) + (kb * 64) / 2; }
      return d; }
#undef CVT_SET
}
constexpr int CVT_NONFFN = (DINP / 32) * (D / 64) + (768 / 32) * (384 / 64) + (1024 / 32) * (256 / 64) + (512 / 32) * (512 / 64) + 3 * (1024 / 32) * (512 / 64) + (1024 / 32) * (1024 / 64);
constexpr int CVT_FFN = (FF2 / 32) * (D / 64) + (1024 / 32) * (FF / 64);
#define CW_CVT 24576
__device__ __forceinline__ void convert_items(Frame& F, int l, int first, int end, int step) {
    LAS float* scr = (LAS float*)(F.lds + F.wave * 16384);
    const int total = end;
    int it = first; if (it >= total) return;
    CvtItem cur = cvt_decode(F, l, it); f32x4 va[8], vb[8]; cvt_load(cur, va, F.lane);
    for (;;) {
        const int itn = it + step; const bool more = itn < total; CvtItem nxt = cur;
        if (more) { nxt = cvt_decode(F, l, itn); cvt_load(nxt, vb, F.lane); }
        cvt_store(cur, va, scr, F.lane);
        if (!more) break;
#pragma unroll
        for (int i = 0; i < 8; ++i) va[i] = vb[i];
        cur = nxt; it = itn;
    }
}

__device__ __forceinline__ void prologue0(Frame& F) {
    if (F.vcu == 0 && F.tid < 16) WSP(unsigned, WS_CTL)[CW_CNT + (F.tid >> 3) * 8 * 64 + (F.tid & 7) * 64] = 0u;
    LAS float* red = (LAS float*)F.lds;
    LAS float* sv = (LAS float*)(F.lds + 16384);
    for (int i = F.tid; i < D; i += 512) { sv[i] = fsilu(inp(F, 1)[i]); sv[D + i] = fsilu(inp(F, 3)[i]); }
    __syncthreads();
    for (int it = F.vcu; it < DEPTH * 48; it += F.G) {
        const int l = it / 48, jb = it % 48, cq = F.lane & 31, kh = F.lane >> 5; const int j0 = jb * 128 + cq * 4;
        const float* W = inp(F, 4) + (size_t)l * D * 6144;
        f32x4 accl = {0.f, 0.f, 0.f, 0.f}, accc = {0.f, 0.f, 0.f, 0.f};
#pragma unroll 8
        for (int i = 0; i < 64; ++i) { const int k = F.wave * 128 + 2 * i + kh; const f32x4 w = *(const f32x4*)(W + (size_t)k * 6144 + j0); accl += w * sv[k]; accc += w * sv[D + k]; }
#pragma unroll
        for (int q = 0; q < 4; ++q) { accl[q] += __shfl_xor(accl[q], 32); accc[q] += __shfl_xor(accc[q], 32); }
        if (kh == 0) { *(LAS f32x4*)(red + (F.wave * 2 + 0) * 128 + cq * 4) = accl; *(LAS f32x4*)(red + (F.wave * 2 + 1) * 128 + cq * 4) = accc; }
        __syncthreads();
        if (F.tid < 256) { const int w = F.tid >> 7, jj = F.tid & 127; float sacc = 0.f;
#pragma unroll
          for (int q = 0; q < 8; ++q) sacc += red[(q * 2 + w) * 128 + jj];
          WSP(float, WS_MOD)[((size_t)l * 2 + w) * 6144 + jb * 128 + jj] = sacc + inp(F, 5)[l * 6144 + jb * 128 + jj]; }
        __syncthreads();
    }
    for (int idx = F.vcu * 512 + F.tid; idx < NL * 16; idx += F.G * 512) { const int n = idx >> 4, i = idx & 15; const float pos = (float)(i < 8 ? (n >> 6) : (n & 63));
        const float inv = __expf(-(float)(i & 7) * (9.210340371976184f / 8.f)); float s, c; sincos_rad(pos * inv, s, c);
        WSP(float, WS_ROPE)[idx] = c; WSP(float, WS_ROPE)[NL * 16 + idx] = s; }
    for (int idx = F.vcu * 512 + F.tid; idx < DEPTH * 2 * 32 * 64; idx += F.G * 512) {
        const int g = (idx >> 6) & 31, ld = idx >> 11;
        const float are = inp(F, 18)[idx], aim = inp(F, 19)[idx], dt = __expf(inp(F, 20)[ld * 32 + g]);
        const float er = __expf(are * dt); float sn, cs; sincos_rad(aim * dt, sn, cs);
        const float abr = er * cs, abi = er * sn;
        const float x = abr - 1.f, y = abi, den = 1.f / (are * are + aim * aim);
        const float cr = (x * are + y * aim) * den, ci = (y * are - x * aim) * den;
        float* P = WSP(float, WS_S5P) + (size_t)idx * 100;
        float pr = 1.f, pi = 0.f;
        for (int t = 0; t <= 32; ++t) { P[2 * t] = pr; P[2 * t + 1] = pi; const float nr = pr * abr - pi * abi, ni = pr * abi + pi * abr; pr = nr; pi = ni; }
        const float* bre = inp(F, 21) + (size_t)idx * 16; const float* bim = inp(F, 22) + (size_t)idx * 16;
        for (int c = 0; c < 16; ++c) { const float br = bre[c], bi = bim[c]; P[66 + 2 * c] = cr * br - ci * bi; P[67 + 2 * c] = cr * bi + ci * br; }
    }
}
__device__ __forceinline__ void prologue1(Frame& F) {
    LAS float* Pl = (LAS float*)F.lds;
    LAS float* Cr = Pl + 6400; LAS float* Ci = Cr + 1024;
    for (int ldg = F.vcu; ldg < DEPTH * 2 * 32; ldg += F.G) {
        __syncthreads();
        const float* P = WSP(float, WS_S5P) + (size_t)ldg * 6400; const float* cre = inp(F, 23) + (size_t)ldg * 1024; const float* cim = inp(F, 24) + (size_t)ldg * 1024;
        for (int i = F.tid; i < 6400; i += 512) Pl[i] = P[i];
        for (int i = F.tid; i < 1024; i += 512) { Cr[i] = cre[i]; Ci[i] = cim[i]; }
        __syncthreads();
        for (int e = F.tid; e < 32 * 256; e += 512) { const int cp = e & 15, c = (e >> 4) & 15, tau = e >> 8; float s = 0.f;
#pragma unroll 8
            for (int p = 0; p < 64; ++p) { const LAS float* Pp = Pl + p * 100; const float ar = Pp[2 * tau], ai = Pp[2 * tau + 1], br = Pp[66 + 2 * cp], bi = Pp[67 + 2 * cp];
                const float tr = ar * br - ai * bi, ti = ar * bi + ai * br; s += Cr[c * 64 + p] * tr - Ci[c * 64 + p] * ti; }
            WSP(float, WS_KTAB)[(size_t)ldg * 8192 + e] = s; }
    }
}
__device__ __forceinline__ void s5_tables(Frame& F, int l) {
    const float* KT = WSP(float, WS_KTAB) + (size_t)l * 2 * 32 * 32 * 256;
    const float* SP = WSP(float, WS_S5P) + (size_t)l * 2 * 32 * 64 * 100;
    bf16* WY = WSP(bf16, WS_WY); bf16* WE = WSP(bf16, WS_WEND);
    for (int idx = F.vcu * 512 + F.tid; idx < 32 * 512 * 96; idx += F.G * 512) {
        const int k8 = idx % 96, n = (idx / 96) & 511, g = idx / (96 * 512); const int t = n >> 4, c = n & 15;
        float v[8];
        if (k8 < 64) { const int j = k8 >> 1, c0 = (k8 & 1) * 8, dtj = t - j;
            if (dtj > 0) { const float* s = KT + ((((size_t)0 * 32 + g) * 32 + dtj) * 16 + c) * 16 + c0;
#pragma unroll
                for (int q = 0; q < 8; ++q) v[q] = s[q]; }
            else if (dtj < 0) { const float* s = KT + ((((size_t)1 * 32 + g) * 32 - dtj) * 16 + c) * 16 + c0;
#pragma unroll
                for (int q = 0; q < 8; ++q) v[q] = s[q]; }
            else { const float* s0 = KT + ((((size_t)0 * 32 + g) * 32) * 16 + c) * 16 + c0; const float* s1 = KT + ((((size_t)1 * 32 + g) * 32) * 16 + c) * 16 + c0; const float dsk = inp(F, 25)[l * 512 + g * 16 + c];
#pragma unroll
                for (int q = 0; q < 8; ++q) v[q] = s0[q] + s1[q] + ((c0 + q == c) ? dsk : 0.f); } }
        else { const int part = (k8 - 64) >> 3, dir = part >> 1, im = part & 1, p0 = ((k8 - 64) & 7) * 8; const int e = dir ? 32 - t : t + 1;
            const size_t ldg = ((size_t)(l * 2 + dir) * 32 + g);
            const float* cre = inp(F, 23) + (ldg * 16 + c) * 64 + p0; const float* cim = inp(F, 24) + (ldg * 16 + c) * 64 + p0;
#pragma unroll
            for (int q = 0; q < 8; ++q) { const float* Pp = SP + (((size_t)dir * 32 + g) * 64 + p0 + q) * 100; const float ar = Pp[2 * e], ai = Pp[2 * e + 1];
                v[q] = im ? -(cre[q] * ai + cim[q] * ar) : (cre[q] * ar - cim[q] * ai); } }
        u32x4 w; w.x = cvtpk(v[0], v[1]); w.y = cvtpk(v[2], v[3]); w.z = cvtpk(v[4], v[5]); w.w = cvtpk(v[6], v[7]);
        *(u32x4*)(WY + ((size_t)g * 512 + n) * 768 + k8 * 8) = w;
    }
    for (int idx = F.vcu * 512 + F.tid; idx < 32 * 256 * 64; idx += F.G * 512) {
        const int k8 = idx & 63, q_ = (idx >> 6) & 255, g = idx >> 14; const int j = k8 >> 1, c0 = (k8 & 1) * 8;
        const int dir = q_ >> 7, im = (q_ >> 6) & 1, p = q_ & 63; const int e = dir ? j : 31 - j;
        const float* Pp = SP + (((size_t)dir * 32 + g) * 64 + p) * 100; const float ar = Pp[2 * e], ai = Pp[2 * e + 1]; float v[8];
#pragma unroll
        for (int q = 0; q < 8; ++q) { const float br = Pp[66 + 2 * (c0 + q)], bi = Pp[67 + 2 * (c0 + q)]; v[q] = im ? (ar * bi + ai * br) : (ar * br - ai * bi); }
        u32x4 w; w.x = cvtpk(v[0], v[1]); w.y = cvtpk(v[2], v[3]); w.z = cvtpk(v[4], v[5]); w.w = cvtpk(v[6], v[7]);
        *(u32x4*)(WE + ((size_t)g * 256 + q_) * 512 + k8 * 8) = w;
    }
}

__device__ __forceinline__ void moe_bases(const unsigned* cnt, int (&base)[9]) {
    int b = 0;
#pragma unroll
    for (int e = 0; e < 8; ++e) { base[e] = b; const int c = (int)__hip_atomic_load(cnt + 64 * e, __ATOMIC_RELAXED, __HIP_MEMORY_SCOPE_AGENT); b += ((c + 255) >> 8) << 8; }
    base[8] = b;
}

template <int MODE>
__device__ __forceinline__ void norm_phase(Frame& F, int l) {
    bf16* xs = WSP(bf16, WS_XS); bf16* H = WSP(bf16, WS_H);
    const float* gn = inp(F, MODE == 0 ? 6 : 7) + l * D;
    const float* modl = WSP(float, WS_MOD) + ((size_t)l * 2 + 0) * 6144 + (MODE == 0 ? 0 : 3 * D);
    const float* modc = WSP(float, WS_MOD) + ((size_t)l * 2 + 1) * 6144 + (MODE == 0 ? 0 : 3 * D);
    const bool moe = (MODE == 1) && (l & 1) && !DBG_NOMOE;
    const bool comb = (MODE == 0) && l > 0 && ((l - 1) & 1) && !DBG_NOMOE;
    const int row_lo = (MODE == 1 && l == DEPTH - 1) ? NC : 0;
    int base[9];
    const unsigned* cntp = (const unsigned*)WSP(unsigned, WS_CTL) + CW_CNT + ((l - 1) >> 1) * 8 * 64;
    if (comb) moe_bases(cntp, base);
    LAS float* wr_l = (LAS float*)F.lds;
    LAS int* lcnt = (LAS int*)(F.lds + 32768); LAS int* wgbase = lcnt + 8; LAS unsigned* rowrec = (LAS unsigned*)(F.lds + 32768 + 256);
    if (moe) { const float* wrt = inp(F, 35) + (size_t)(l >> 1) * D * 8; for (int i = F.tid; i < D * 8; i += 512) wr_l[i] = wrt[i]; if (F.tid < 8) lcnt[F.tid] = 0; __syncthreads(); }
    int krow = 0;
    unsigned* cnt = WSP(unsigned, WS_CTL) + CW_CNT + (l >> 1) * 8 * 64;
    const float* ga2p_l = WSP(float, WS_MOD) + ((size_t)(l - 1) * 2 + 0) * 6144 + 5 * D; const float* ga2p_c = WSP(float, WS_MOD) + ((size_t)(l - 1) * 2 + 1) * 6144 + 5 * D;
    for (int m = row_lo + F.gw; m < NT; m += F.NGW) {
        f32x4 v[4];
        if (MODE == 0 && l == 0) { const float* src = m < NC ? inp(F, 2) + (size_t)m * D : inp(F, 0) + (size_t)(m - NC) * D;
#pragma unroll
            for (int j = 0; j < 4; ++j) v[j] = *(const f32x4*)(src + j * 256 + F.lane * 4); }
        else {
#ifdef DBG_SC1
#pragma unroll
            for (int j = 0; j < 4; ++j) {
#pragma unroll
                for (int q = 0; q < 4; ++q) v[j][q] = __hip_atomic_load(xs + (size_t)m * D + j * 256 + F.lane * 4 + q, __ATOMIC_RELAXED, __HIP_MEMORY_SCOPE_AGENT); }
#else
#pragma unroll
            for (int j = 0; j < 4; ++j) v[j] = ld4bf(xs + (size_t)m * D + j * 256 + F.lane * 4);
#endif
        }
        if (comb) { const unsigned* rec = WSP(unsigned, WS_REC) + (size_t)m * 8; const int e0 = rec[0], p0 = rec[1], e1 = rec[2], p1 = rec[3]; const float w0 = __uint_as_float(rec[4]), w1 = __uint_as_float(rec[5]);
            int r0 = 0, r1 = 0;
#pragma unroll
            for (int e = 0; e < 8; ++e) { r0 = (e == e0) ? base[e] + p0 : r0; r1 = (e == e1) ? base[e] + p1 : r1; }
            const bf16* Y0 = WSP(bf16, WS_Y) + (size_t)r0 * D; const bf16* Y1 = WSP(bf16, WS_Y) + (size_t)r1 * D; const float* ga = m < NC ? ga2p_c : ga2p_l; constexpr size_t YH = (size_t)(WS_Y2 - WS_Y) / 2;
#pragma unroll
            for (int j = 0; j < 4; ++j) { const int col = j * 256 + F.lane * 4; const u32x2 a = *(const u32x2*)(Y0 + col), b = *(const u32x2*)(Y1 + col), a2 = *(const u32x2*)(Y0 + YH + col), b2 = *(const u32x2*)(Y1 + YH + col); const f32x4 g = *(const f32x4*)(ga + col);
                v[j][0] += g[0] * (w0 * (bflo(a.x) + bflo(a2.x)) + w1 * (bflo(b.x) + bflo(b2.x))); v[j][1] += g[1] * (w0 * (bfhi(a.x) + bfhi(a2.x)) + w1 * (bfhi(b.x) + bfhi(b2.x)));
                v[j][2] += g[2] * (w0 * (bflo(a.y) + bflo(a2.y)) + w1 * (bflo(b.y) + bflo(b2.y))); v[j][3] += g[3] * (w0 * (bfhi(a.y) + bfhi(a2.y)) + w1 * (bfhi(b.y) + bfhi(b2.y))); } }
        const int npart = (m < NC) ? ((MODE == 1) ? (l < DEPTH - 1 ? 12 : 0) : ((l > 0 && !((l - 1) & 1)) ? 11 : 0)) : 0;
        if (npart) { const float* pp = WSP(float, WS_PART) + (size_t)m * D;
            for (int k = 0; k < npart; ++k) {
#pragma unroll
                for (int j = 0; j < 4; ++j) v[j] += *(const f32x4*)(pp + (size_t)k * 256 * D + j * 256 + F.lane * 4); } }
        if ((MODE == 0 && l == 0) || comb || npart) {
#pragma unroll
            for (int j = 0; j < 4; ++j) st4bf(xs + (size_t)m * D + j * 256 + F.lane * 4, v[j]); }
        float ss = 0.f;
#pragma unroll
        for (int j = 0; j < 4; ++j) ss += (v[j][0] * v[j][0] + v[j][1] * v[j][1]) + (v[j][2] * v[j][2] + v[j][3] * v[j][3]);
        const float r = 1.0f / sqrtf(wave_sum(ss) * (1.f / D) + EPS);
        const float* md = m < NC ? modc : modl;
        float lg[8] = {0.f, 0.f, 0.f, 0.f, 0.f, 0.f, 0.f, 0.f};
#pragma unroll
        for (int j = 0; j < 4; ++j) { const int col = j * 256 + F.lane * 4; const f32x4 g = *(const f32x4*)(gn + col), sh = *(const f32x4*)(md + col), sc = *(const f32x4*)(md + D + col);
            f32x4 h;
#pragma unroll
            for (int q = 0; q < 4; ++q) h[q] = (v[j][q] * r * g[q]) * (1.f + sc[q]) + sh[q];
            if (MODE == 1 && moe) *(unsigned*)((unsigned char*)H + (size_t)m * D + col) = (unsigned)__builtin_amdgcn_cvt_pk_fp8_f32(h[2], h[3], __builtin_amdgcn_cvt_pk_fp8_f32(h[0], h[1], 0, false), true);
            else { u32x2 w; w.x = cvtpk(h[0], h[1]); w.y = cvtpk(h[2], h[3]); *(u32x2*)(H + (size_t)m * D + col) = w; }
            if (moe) {
#pragma unroll
                for (int q = 0; q < 4; ++q) { const f32x4 wa = *(const LAS f32x4*)(wr_l + (col + q) * 8), wb = *(const LAS f32x4*)(wr_l + (col + q) * 8 + 4);
                    lg[0] += h[q] * wa[0]; lg[1] += h[q] * wa[1]; lg[2] += h[q] * wa[2]; lg[3] += h[q] * wa[3]; lg[4] += h[q] * wb[0]; lg[5] += h[q] * wb[1]; lg[6] += h[q] * wb[2]; lg[7] += h[q] * wb[3]; } } }
        if (moe) {
#pragma unroll
            for (int e = 0; e < 8; ++e) lg[e] = wave_sum(lg[e]);
            int i0 = 0; float v0 = lg[0];
#pragma unroll
            for (int e = 1; e < 8; ++e) if (lg[e] > v0) { v0 = lg[e]; i0 = e; }
            int i1 = -1; float v1 = -3.0e38f;
#pragma unroll
            for (int e = 0; e < 8; ++e) if (e != i0 && lg[e] > v1) { v1 = lg[e]; i1 = e; }
#ifdef DBG_FIXROUTE
            i0 = m & 7; i1 = (m + 1) & 7; v0 = 0.f; v1 = 0.f;
#endif
            if (F.lane == 0) { const float w1 = 1.f / (1.f + __expf(v0 - v1)), w0 = 1.f - w1;
                const unsigned p0 = (unsigned)__hip_atomic_fetch_add(lcnt + i0, 1, __ATOMIC_RELAXED, __HIP_MEMORY_SCOPE_WORKGROUP), p1 = (unsigned)__hip_atomic_fetch_add(lcnt + i1, 1, __ATOMIC_RELAXED, __HIP_MEMORY_SCOPE_WORKGROUP);
                LAS unsigned* rr = rowrec + (F.wave * 9 + krow) * 6; rr[0] = i0; rr[1] = p0; rr[2] = i1; rr[3] = p1; rr[4] = __float_as_uint(w0); rr[5] = __float_as_uint(w1); }
            ++krow;
        }
    }
    if (moe) {
        __syncthreads();
        if (F.tid < 8) wgbase[F.tid] = (int)__hip_atomic_fetch_add(cnt + 64 * F.tid, (unsigned)lcnt[F.tid], __ATOMIC_RELAXED, __HIP_MEMORY_SCOPE_AGENT);
        __syncthreads();
        if (F.lane == 0) { int k = 0; for (int m = row_lo + F.gw; m < NT; m += F.NGW, ++k) { const LAS unsigned* rr = rowrec + (F.wave * 9 + k) * 6; unsigned* rec = WSP(unsigned, WS_REC) + (size_t)m * 8;
            const unsigned e0 = rr[0], e1 = rr[2]; rec[0] = e0; rec[1] = rr[1] + (unsigned)wgbase[e0]; rec[2] = e1; rec[3] = rr[3] + (unsigned)wgbase[e1]; rec[4] = rr[4]; rec[5] = rr[5]; } }
    }
}
__device__ __forceinline__ void moe_scatter(Frame& F, int l) {
    int base[9]; moe_bases((const unsigned*)WSP(unsigned, WS_CTL) + CW_CNT + (l >> 1) * 8 * 64, base);
    const int row_lo = (l == DEPTH - 1) ? NC : 0;
    const bf16* H = WSP(bf16, WS_H); bf16* HS = WSP(bf16, WS_HS);
    for (int it = 2 * row_lo + F.gw; it < 2 * NT; it += F.NGW) { const int m = it >> 1, s = it & 1; const unsigned* rec = WSP(unsigned, WS_REC) + (size_t)m * 8; const int e = rec[2 * s], p = rec[2 * s + 1];
        int r = 0;
#pragma unroll
        for (int q = 0; q < 8; ++q) r = (q == e) ? base[q] + p : r;
        const u32x4* src = (const u32x4*)((const unsigned char*)H + (size_t)m * D); u32x4* dst = (u32x4*)((unsigned char*)HS + (size_t)r * D);
        dst[F.lane] = src[F.lane]; }
}
__device__ __forceinline__ void final_out(Frame& F, int l) {
#if DBG_DUMP == 9
    { const float* xs = WSP(float, WS_XS); for (int m = NC + ((F.gw + 1024 + 3) % F.NGW); m < NT; m += F.NGW) { for (int j = 0; j < 16; ++j) { const int col = j * 64 + F.lane; F.out[(size_t)(m - NC) * D + col] = xs[(size_t)m * D + col]; } } return; }
#elif DBG_DUMP == 10
    { const float* md = WSP(float, WS_MOD); for (int m = NC + F.gw; m < NT; m += F.NGW) { for (int j = 0; j < 16; ++j) { const int col = j * 64 + F.lane; F.out[(size_t)(m - NC) * D + col] = md[((size_t)(m - NC) * D + col) % 49152]; } } return; }
#elif DBG_DUMP
    { const bf16* src = WSP(bf16, DBG_DUMP == 1 ? WS_H : DBG_DUMP == 2 ? WS_G : DBG_DUMP == 3 ? WS_KVRAW : DBG_DUMP == 4 ? WS_OA : DBG_DUMP == 5 ? WS_M1 : DBG_DUMP == 6 ? WS_QF : DBG_DUMP == 7 ? WS_Z : WS_OC);
      const int ld = DBG_DUMP == 2 ? 3072 : (DBG_DUMP == 4 || DBG_DUMP == 7 || DBG_DUMP == 8) ? 512 : DBG_DUMP == 6 ? 96 : 1024;
      for (int m = NC + F.gw; m < NT; m += F.NGW) { for (int j = 0; j < 16; ++j) { const int col = j * 64 + F.lane; F.out[(size_t)(m - NC) * D + col] = bf2f(src[(size_t)m * ld + (col % ld)]); } } return; }
#endif
    if (!(l & 1) || DBG_NOMOE) { const bf16* xs = WSP(bf16, WS_XS); for (int m = NC + F.gw; m < NT; m += F.NGW) {
#pragma unroll
        for (int j = 0; j < 4; ++j) *(f32x4*)(F.out + (size_t)(m - NC) * D + j * 256 + F.lane * 4) = ld4bf(xs + (size_t)m * D + j * 256 + F.lane * 4); } return; }
    int base[9]; moe_bases((const unsigned*)WSP(unsigned, WS_CTL) + CW_CNT + (l >> 1) * 8 * 64, base);
    const bf16* xs = WSP(bf16, WS_XS); const float* ga = WSP(float, WS_MOD) + ((size_t)l * 2 + 0) * 6144 + 5 * D;
    for (int m = NC + F.gw; m < NT; m += F.NGW) { const unsigned* rec = WSP(unsigned, WS_REC) + (size_t)m * 8; const int e0 = rec[0], p0 = rec[1], e1 = rec[2], p1 = rec[3];
#ifndef DBG_NOREC
        const float w0 = __uint_as_float(rec[4]), w1 = __uint_as_float(rec[5]);
#endif
        int r0 = 0, r1 = 0;
#pragma unroll
        for (int e = 0; e < 8; ++e) { r0 = (e == e0) ? base[e] + p0 : r0; r1 = (e == e1) ? base[e] + p1 : r1; }
        const bf16* Y0 = WSP(bf16, DBG_YSRC) + (size_t)r0 * D; const bf16* Y1 = WSP(bf16, DBG_YSRC) + (size_t)r1 * D;
#ifdef DBG_DIRECTH
        Y0 = WSP(bf16, WS_H) + (size_t)m * D; Y1 = Y0;
#endif
#ifdef DBG_NOREC
        const float w0 = DBG_W, w1 = DBG_W;
#endif
#pragma unroll
        for (int j = 0; j < 4; ++j) { const int col = j * 256 + F.lane * 4; constexpr size_t YH = (size_t)(WS_Y2 - WS_Y) / 2; const u32x2 a = *(const u32x2*)(Y0 + col), b = *(const u32x2*)(Y1 + col), a2 = *(const u32x2*)(Y0 + YH + col), b2 = *(const u32x2*)(Y1 + YH + col); const f32x4 g = *(const f32x4*)(ga + col); f32x4 v = ld4bf(xs + (size_t)m * D + col);
            v[0] += g[0] * (w0 * (bflo(a.x) + bflo(a2.x)) + w1 * (bflo(b.x) + bflo(b2.x))); v[1] += g[1] * (w0 * (bfhi(a.x) + bfhi(a2.x)) + w1 * (bfhi(b.x) + bfhi(b2.x))); v[2] += g[2] * (w0 * (bflo(a.y) + bflo(a2.y)) + w1 * (bflo(b.y) + bflo(b2.y))); v[3] += g[3] * (w0 * (bfhi(a.y) + bfhi(a2.y)) + w1 * (bfhi(b.y) + bfhi(b2.y)));
            *(f32x4*)(F.out + (size_t)(m - NC) * D + col) = v; } }
}

__device__ __forceinline__ float sum8(float v) { v += __shfl_xor(v, 1); v += __shfl_xor(v, 2); v += __shfl_xor(v, 4); return v; }
__device__ __forceinline__ void finalize_phase(Frame& F, int l, int wg, int nwg) {
    const bf16* pA = WSP(bf16, WS_PA); const bf16* pN = WSP(bf16, WS_PN); const bf16* QR = WSP(bf16, WS_QRAW); const bf16* KVR = WSP(bf16, WS_KVRAW);
    bf16* QF = WSP(bf16, WS_QF); unsigned char* K8G = WSP(unsigned char, WS_KF); unsigned char* V8G = WSP(unsigned char, WS_VF); bf16* NQ = WSP(bf16, WS_NQ); bf16* NK = WSP(bf16, WS_NK);
    const float* gqn = inp(F, 13) + l * 96; const float* gkn = inp(F, 14) + l * 96; const float* gnq = inp(F, 15) + l * 64; const float* gnk = inp(F, 16) + l * 64;
    const float* COS = WSP(float, WS_ROPE); const float* SIN = COS + NL * 16;
    LAS unsigned char* buf = F.lds; LAS float* stats = (LAS float*)(F.lds + RING_BYTES + 4096); LAS unsigned char* krl = F.lds + RING_BYTES + 4096 + 512;
    const int tid0 = F.tid;
#define SWZ(c, row) (((c) & ~15) | (((c) ^ (row)) & 15))
#define PK8(f) (u32x4){cvtpk(f[0], f[1]), cvtpk(f[2], f[3]), cvtpk(f[4], f[5]), cvtpk(f[6], f[7])}
    for (int tg = wg; tg < NT / 64; tg += nwg) {
        int tid_ = tid0; asm volatile("" : "+v"(tid_));
        const int tid = tid_, lane = tid & 63, wave = __builtin_amdgcn_readfirstlane(tid >> 6), h = tid >> 6, tl = tid & 63;
        const int t0 = tg * 64, t = t0 + tl; const bool lat = t >= NC; const int n = t - NC;
        __syncthreads();
        { u32x4 va[8], vb[8]; float sq[8], skv[8];
#pragma unroll
          for (int i = 0; i < 8; ++i) { const bf16* row = pA + (size_t)(t0 + wave * 8 + i) * 768; va[i] = *(const u32x4*)(row + lane * 8); vb[i] = lane < 20 ? *(const u32x4*)(row + (64 + lane) * 8) : (u32x4){0u, 0u, 0u, 0u}; }
#pragma unroll
          for (int i = 0; i < 8; ++i) { float f[8]; unpack8(va[i], f); float ss = 0.f;
#pragma unroll
              for (int q = 0; q < 8; ++q) ss += f[q] * f[q];
              sq[i] = lane < 48 ? ss : 0.f; skv[i] = lane >= 48 ? ss : 0.f;
              if (lane < 16) { float g[8]; unpack8(vb[i], g);
#pragma unroll
                  for (int q = 0; q < 8; ++q) skv[i] += g[q] * g[q]; }
              else if (lane < 20) *(LAS u32x4*)(krl + (wave * 8 + i) * 64 + (lane - 16) * 16) = vb[i]; }
#pragma unroll
          for (int o = 1; o < 64; o <<= 1) {
#pragma unroll
              for (int i = 0; i < 8; ++i) { sq[i] += __shfl_xor(sq[i], o); skv[i] += __shfl_xor(skv[i], o); } }
          if (lane == 0) {
#pragma unroll
              for (int i = 0; i < 8; ++i) { stats[(wave * 8 + i) * 2] = 1.0f / sqrtf(sq[i] * (1.f / 384.f) + EPS); stats[(wave * 8 + i) * 2 + 1] = 1.0f / sqrtf(skv[i] * (1.f / 256.f) + EPS); } } }
#pragma unroll 8
        for (int i = 0; i < 12; ++i) { const int id = tid + 512 * i, row = id / 96, c = id % 96; *(LAS u32x4*)(buf + row * 1536 + SWZ(c, row) * 16) = *(const u32x4*)(QR + (size_t)(t0 + row) * 768 + c * 8); }
        __syncthreads();
        { LAS unsigned char* pq = buf + tl * 1536; const float rq = stats[tl * 2]; float ss = 0.f;
#define QCH(c) (pq + SWZ(h * 12 + (c), tl) * 16)
#pragma unroll
          for (int c = 0; c < 12; ++c) { float f[8]; unpack8(*(const LAS u32x4*)QCH(c), f);
#pragma unroll
              for (int q = 0; q < 8; ++q) { const float v = f[q] * rq; ss += v * v; } }
          const float sc = rq / sqrtf(ss * (1.f / 96.f) + EPS) * (0.10206207261596575f * 1.4426950408889634f);
#pragma unroll
          for (int c = 0; c < 8; ++c) { float f[8]; unpack8(*(const LAS u32x4*)QCH(c), f);
#pragma unroll
              for (int q = 0; q < 8; ++q) f[q] = f[q] * sc * gqn[c * 8 + q];
              *(LAS u32x4*)QCH(c) = PK8(f); }
#pragma unroll
          for (int cp = 0; cp < 2; ++cp) { float a[8], b[8]; unpack8(*(const LAS u32x4*)QCH(8 + cp), a); unpack8(*(const LAS u32x4*)QCH(10 + cp), b);
#pragma unroll
              for (int q = 0; q < 8; ++q) { a[q] = a[q] * sc * gqn[64 + cp * 8 + q]; b[q] = b[q] * sc * gqn[80 + cp * 8 + q]; }
              if (lat) {
#pragma unroll
                  for (int q = 0; q < 8; ++q) { const float cs = COS[(size_t)n * 16 + cp * 8 + q], sn = SIN[(size_t)n * 16 + cp * 8 + q]; const float ra = a[q] * cs - b[q] * sn, rb = a[q] * sn + b[q] * cs; a[q] = ra; b[q] = rb; } }
              *(LAS u32x4*)QCH(8 + cp) = PK8(a); *(LAS u32x4*)QCH(10 + cp) = PK8(b); } }
#undef QCH
        __syncthreads();
#pragma unroll 8
        for (int i = 0; i < 12; ++i) { const int id = tid + 512 * i, hh = id / 768, rem = id % 768, row = rem / 12, c = rem % 12;
            *(u32x4*)(QF + ((size_t)hh * NT + t0 + row) * 96 + c * 8) = *(const LAS u32x4*)(buf + row * 1536 + SWZ(hh * 12 + c, row) * 16); }
        __syncthreads();
#pragma unroll 8
        for (int i = 0; i < 16; ++i) { const int id = tid + 512 * i, row = id >> 7, c = id & 127; *(LAS u32x4*)(buf + row * 2048 + SWZ(c, row) * 16) = *(const u32x4*)(KVR + (size_t)(t0 + row) * 1024 + c * 8); }
        __syncthreads();
        unsigned v8r[16];
#define F8W(f, o) ((unsigned)__builtin_amdgcn_cvt_pk_fp8_f32(f[(o) + 2], f[(o) + 3], __builtin_amdgcn_cvt_pk_fp8_f32(f[(o)], f[(o) + 1], 0, false), true))
        { LAS unsigned char* pk = buf + tl * 2048; const LAS unsigned char* pr = krl + tl * 64;
#define KCHK(c) (pk + SWZ(h * 16 + (c), tl) * 16)
          const float rkv = stats[tl * 2 + 1]; float ss = 0.f;
#pragma unroll
          for (int c = 0; c < 8; ++c) { float f[8]; unpack8(*(const LAS u32x4*)KCHK(c), f);
#pragma unroll
              for (int q = 0; q < 8; ++q) { const float v = f[q] * rkv; ss += v * v; } }
#pragma unroll
          for (int c = 0; c < 4; ++c) { float f[8]; unpack8(*(const LAS u32x4*)(pr + c * 16), f);
#pragma unroll
              for (int q = 0; q < 8; ++q) ss += f[q] * f[q]; }
          const float rn = 1.0f / sqrtf(ss * (1.f / 96.f) + EPS), sc = rkv * rn; unsigned kw[16];
#pragma unroll
          for (int c = 0; c < 8; ++c) { float f[8]; unpack8(*(const LAS u32x4*)KCHK(c), f);
#pragma unroll
              for (int q = 0; q < 8; ++q) f[q] = f[q] * sc * gkn[c * 8 + q];
              kw[c * 2] = F8W(f, 0); kw[c * 2 + 1] = F8W(f, 4); }
          unsigned kr[8];
#pragma unroll
          for (int c = 8; c < 16; ++c) { float f[8]; unpack8(*(const LAS u32x4*)KCHK(c), f);
#pragma unroll
              for (int q = 0; q < 8; ++q) f[q] *= rkv;
              v8r[(c - 8) * 2] = F8W(f, 0); v8r[(c - 8) * 2 + 1] = F8W(f, 4); }
#pragma unroll
          for (int cp = 0; cp < 2; ++cp) { float a[8], b[8]; unpack8(*(const LAS u32x4*)(pr + cp * 16), a); unpack8(*(const LAS u32x4*)(pr + (2 + cp) * 16), b);
#pragma unroll
              for (int q = 0; q < 8; ++q) { a[q] = a[q] * rn * gkn[64 + cp * 8 + q]; b[q] = b[q] * rn * gkn[80 + cp * 8 + q]; }
              if (lat) {
#pragma unroll
                  for (int q = 0; q < 8; ++q) { const float cs = COS[(size_t)n * 16 + cp * 8 + q], sn = SIN[(size_t)n * 16 + cp * 8 + q]; const float ra = a[q] * cs - b[q] * sn, rb = a[q] * sn + b[q] * cs; a[q] = ra; b[q] = rb; } }
              kr[cp * 2] = F8W(a, 0); kr[cp * 2 + 1] = F8W(a, 4); kr[4 + cp * 2] = F8W(b, 0); kr[4 + cp * 2 + 1] = F8W(b, 4); }
#pragma unroll
          for (int w = 0; w < 4; ++w) *(LAS u32x4*)KCHK(w) = (u32x4){kw[4 * w], kw[4 * w + 1], kw[4 * w + 2], kw[4 * w + 3]};
          *(LAS u32x4*)KCHK(4) = (u32x4){kr[0], kr[1], kr[2], kr[3]}; *(LAS u32x4*)KCHK(5) = (u32x4){kr[4], kr[5], kr[6], kr[7]}; }
#undef F8W
        __syncthreads();
        int tq = tid; asm volatile("" : "+v"(tq));
#pragma unroll
        for (int i = 0; i < 6; ++i) { const int id = tq + 512 * i, hh = id / 384, r = id % 384, row = r / 6, w = r % 6;
            *(u32x4*)(K8G + ((size_t)hh * (NT / 64) + tg) * 7168 + row * 112 + w * 16) = *(const LAS u32x4*)(buf + row * 2048 + SWZ(hh * 16 + w, row) * 16); }
        __syncthreads();
        { int tl2 = tq & 63; const int pos = att::v8_pos(tl2); LAS unsigned char* vt = buf + (tq >> 6) * 4096 + (pos & 15);
          LAS unsigned char* vq[4];
#pragma unroll
          for (int x = 0; x < 4; ++x) vq[x] = vt + ((((pos >> 4) ^ x) & 3) << 4);
#pragma unroll
          for (int w = 0; w < 16; ++w)
#pragma unroll
              for (int b = 0; b < 4; ++b) vq[w & 3][(4 * w + b) * 64] = (unsigned char)(v8r[w] >> (8 * b)); }
        __syncthreads();
#pragma unroll
        for (int i = 0; i < 4; ++i) { const int id = tq + 512 * i, hh = id >> 8, off = (id & 255) * 16;
            *(u32x4*)(V8G + ((size_t)hh * (NT / 64) + tg) * 4096 + off) = *(const LAS u32x4*)(buf + hh * 4096 + off); }
        __syncthreads();
#pragma unroll 8
        for (int i = 0; i < 16; ++i) { const int id = tid + 512 * i, row = id >> 7, c = id & 127; *(LAS u32x4*)(buf + row * 2048 + SWZ(c, row) * 16) = *(const u32x4*)(pN + (size_t)(t0 + row) * 1536 + c * 8); }
        __syncthreads();
#pragma unroll
        for (int which = 0; which < 2; ++which) { LAS unsigned char* pn = buf + tl * 2048; const float* gg = which ? gnk : gnq; float ss = 0.f;
#pragma unroll
            for (int c = 0; c < 8; ++c) { float f[8]; unpack8(*(const LAS u32x4*)(pn + SWZ(which * 64 + h * 8 + c, tl) * 16), f);
#pragma unroll
                for (int q = 0; q < 8; ++q) ss += f[q] * f[q]; }
            const float rn = (which ? 1.0f : 0.125f * 1.4426950408889634f) / sqrtf(ss * (1.f / 64.f) + EPS);
#pragma unroll
            for (int c = 0; c < 8; ++c) { float f[8]; unpack8(*(const LAS u32x4*)(pn + SWZ(which * 64 + h * 8 + c, tl) * 16), f);
#pragma unroll
                for (int q = 0; q < 8; ++q) f[q] = f[q] * rn * gg[c * 8 + q];
                *(LAS u32x4*)(pn + SWZ(which * 64 + h * 8 + c, tl) * 16) = PK8(f); } }
        __syncthreads();
#pragma unroll 8
        for (int i = 0; i < 8; ++i) { const int id = tid + 512 * i, hh = id >> 9, row = (id & 511) >> 3, c = id & 7;
            *(u32x4*)(NQ + ((size_t)hh * NT + t0 + row) * 64 + c * 8) = *(const LAS u32x4*)(buf + row * 2048 + SWZ(hh * 8 + c, row) * 16);
            *(u32x4*)(NK + ((size_t)hh * NT + t0 + row) * 64 + c * 8) = *(const LAS u32x4*)(buf + row * 2048 + SWZ(64 + hh * 8 + c, row) * 16); }
    }
#undef PK8
#undef SWZ
#undef KCHK
}
__device__ __forceinline__ void s5_carry(Frame& F, int l, int cw) {
    const int idx = cw * 512 + F.tid; const int seg = idx & 7, p = (idx >> 3) & 63, g = (idx >> 9) & 31, dir = idx >> 14;
    const float* Pp = WSP(float, WS_S5P) + ((((size_t)l * 2 + dir) * 32 + g) * 64 + p) * 100; const float ar = Pp[64], ai = Pp[65];
    const float* E = WSP(float, WS_E) + (size_t)g * S5ROWS * 256 + dir * 128 + p; bf16* AG = WSP(bf16, WS_AG) + (size_t)g * S5ROWS * S5K + 512 + dir * 128 + p;
#define S5ROW(st) (dir == 0 ? ((st) < 8 ? 512 + (st) : (st) - 8) : 519 - (st))
    float tr = 0.f, ti = 0.f, pr = 1.f, pi = 0.f;
    for (int s0 = 0; s0 < 65; s0 += 5) { float er[5], ei[5];
#pragma unroll
        for (int q = 0; q < 5; ++q) { const int row = S5ROW(seg * 65 + s0 + q); er[q] = E[(size_t)row * 256]; ei[q] = E[(size_t)row * 256 + 64]; }
#pragma unroll
        for (int q = 0; q < 5; ++q) { const float nr = ar * tr - ai * ti + er[q], ni = ar * ti + ai * tr + ei[q]; tr = nr; ti = ni; const float qr = pr * ar - pi * ai, qi = pr * ai + pi * ar; pr = qr; pi = qi; } }
    float cr = 0.f, ci = 0.f, xr = 0.f, xi = 0.f; const int lb = F.lane & ~7;
#pragma unroll
    for (int k = 0; k < 8; ++k) { const float kr = __shfl(tr, lb + k), ki = __shfl(ti, lb + k); if (k == seg) { cr = xr; ci = xi; } const float nr = pr * xr - pi * xi + kr, ni = pr * xi + pi * xr + ki; xr = nr; xi = ni; }
    float sr = cr, si = ci;
    for (int s0 = 0; s0 < 65; s0 += 5) { float er[5], ei[5]; int rows[5];
#pragma unroll
        for (int q = 0; q < 5; ++q) { const int row = S5ROW(seg * 65 + s0 + q); rows[q] = row; er[q] = E[(size_t)row * 256]; ei[q] = E[(size_t)row * 256 + 64]; }
#pragma unroll
        for (int q = 0; q < 5; ++q) { AG[(size_t)rows[q] * S5K] = f2bf(sr); AG[(size_t)rows[q] * S5K + 64] = f2bf(si); const float nr = ar * sr - ai * si + er[q], ni = ar * si + ai * sr + ei[q]; sr = nr; si = ni; } }
#undef S5ROW
}
__device__ __forceinline__ void dbg_thrash(Frame& F) {
    f32x4 a = {0.f, 0.f, 0.f, 0.f};
    for (int w = 36; w < 39; ++w) { const f32x4* src = (const f32x4*)inp(F, w);
        for (size_t i = (size_t)F.vcu * 512 + F.tid; i < (size_t)11534336; i += (size_t)F.G * 512) a += src[i]; }
    if (a[0] + a[1] + a[2] + a[3] == 1.2345e33f) WSP(float, WS_E)[0] = a[0];
}
#define PH_BEGIN if (lo <= ph && ph < hi) { { int t_ = threadIdx.x; asm volatile("" : "+v"(t_)); F.tid = t_; F.lane = t_ & 63; unsigned long long w_ = (unsigned long long)args.ws; asm volatile("" : "+s"(w_)); F.ws = (unsigned char*)(GAS unsigned char*)w_; } DBG_LDSCLR
#define PH_END   if (ph + 1 < hi) xcd_barrier(bar); } ++ph;
template <int l>
__device__ __forceinline__ void layer_body(Frame& F, const Args& args, XcdBarrier& bar, int& ph, const int lo, const int hi, LAS unsigned char* ring, const int c, unsigned* ctl) {
    const int bx = blockIdx.x;
        const bool need_ctx = l < DEPTH - 1, moe = (l & 1) && !DBG_NOMOE;
        const int pm0 = need_ctx ? 0 : 1, nM = need_ctx ? 65 : 64;
        const float* modl = WSP(float, WS_MOD) + ((size_t)l * 2 + 0) * 6144; const float* modc = WSP(float, WS_MOD) + ((size_t)l * 2 + 1) * 6144;
        PH_BEGIN LPH(1) {
#if DBG_THRASH == 3
        if (l == 1) {   } else
#endif
        { for (int ra_ = 0; ra_ < 1 + DBG_REPA; ++ra_) { convert_items(F, l, F.gw, CVT_NONFFN, F.NGW);
        s5_tables(F, l); __syncthreads(); } norm_phase<0>(F, l); } } PH_END
        PH_BEGIN LPH(2) { { pg8::SchedPlain S; S.T.init(65, 23, F.G, bx); S.A = WSP(bf16, WS_H); S.Bt = WSP(bf16, WS_WIN); S.lda = D; S.ldb = D; S.pm0 = 0;
            pg8::EpiWin E{WSP(bf16, WS_PA), WSP(bf16, WS_PN), WSP(bf16, WS_AG), WSP(bf16, WS_G)};
            pg8::gemm_phase(ring, D, D, D, S, E); } } PH_END
        PH_BEGIN LPH(3) {
        { pg8::SchedPlain S; S.T.init(65, 3, F.G, bx); S.A = WSP(bf16, WS_PA); S.Bt = WSP(bf16, WS_WUQ); S.lda = 768; S.ldb = 384; S.pm0 = 0;
          pg8::EpiBf16 E{WSP(bf16, WS_QRAW), 768}; pg8::gemm_phase(ring, 384, 768, 384, S, E); }
        { pg8::SchedPlain S; S.T.init(65, 4, F.G, (bx + 61) & 255); S.A = WSP(bf16, WS_PA) + 384; S.Bt = WSP(bf16, WS_WUKV); S.lda = 768; S.ldb = 256; S.pm0 = 0;
          pg8::EpiBf16 E{WSP(bf16, WS_KVRAW), 1024}; pg8::gemm_phase(ring, 256, 768, 256, S, E); }
        { pg8::SchedS5 S; S.nrt = 3; S.nct = 1; S.G = F.G; S.c = (c + 57) & 255; S.A = WSP(bf16, WS_AG); S.W = WSP(bf16, WS_WEND); S.brows = 256; S.ldb = 512;
          pg8::EpiS5E E{WSP(float, WS_E)}; pg8::gemm_phase(ring, 512, S5K, 512, S, E); }
        } PH_END
        PH_BEGIN LPH(4) { if (c >= F.G - 64) s5_carry(F, l, c - (F.G - 64)); else finalize_phase(F, l, c, F.G - 64); } PH_END
        PH_BEGIN LPH(5) {
        { pg8::SchedS5 S; S.nrt = need_ctx ? 3 : 2; S.nct = 2; S.G = F.G; S.c = c; S.A = WSP(bf16, WS_AG); S.W = WSP(bf16, WS_WY); S.brows = 512; S.ldb = 768;
          pg8::EpiS5Y E{WSP(bf16, WS_Z)}; pg8::gemm_phase(ring, S5K, S5K, 768, S, E); }
        if (need_ctx && c >= 192 && c < 208) { const int u = c - 192, h = u & 7;
            if (u < 8) att::attn_unit<96, false, true>(WSP(bf16, WS_QF) + (size_t)h * NT * 96, 96, (const bf16*)(WSP(unsigned char, WS_KF) + (size_t)h * (NT / 64) * 7168), 96, (const bf16*)(WSP(unsigned char, WS_VF) + (size_t)h * (NT / 64) * 4096), 64, WSP(bf16, WS_OA) + h * 64, 4, 0, 0, 0, nullptr, ring);
            else att::attn_unit<64, false>(WSP(bf16, WS_NQ) + (size_t)h * NT * 64, 64, WSP(bf16, WS_NK) + (size_t)h * NT * 64, 64, WSP(bf16, WS_PN) + 1024 + h * 64, 1536, WSP(bf16, WS_OB) + h * 64, 4, 0, 0, 0, nullptr, ring); }
        for (int i = 0; i < 2; ++i) { const int h = c >> 5, qb = (c & 31) + 32 * i;
            att::attn_unit<96, false, true>(WSP(bf16, WS_QF) + ((size_t)h * NT + NC + qb * 256) * 96, 96, (const bf16*)(WSP(unsigned char, WS_KF) + (size_t)h * (NT / 64) * 7168), 96, (const bf16*)(WSP(unsigned char, WS_VF) + (size_t)h * (NT / 64) * 4096), 64,
                                      WSP(bf16, WS_OA) + (size_t)(NC + qb * 256) * 512 + h * 64, NT / 64, 0, 0, 0, nullptr, ring); }
        for (int i = 0; i < 2; ++i) { const int h = c >> 5, qb = (c & 31) + 32 * i;
            const int glo = 4 * qb - 4 < 0 ? 0 : (4 * qb - 4 > 248 ? 248 : 4 * qb - 4), ghi0 = 4 * qb - 1 < 0 ? 0 : (4 * qb - 1 > 248 ? 248 : 4 * qb - 1), ghi = ghi0 + 7;
            const int ntl = 4 + (ghi - glo + 1), ntp = (ntl + 1) & ~1;
            att::attn_unit<64, true>(WSP(bf16, WS_NQ) + ((size_t)h * NT + NC + qb * 256) * 64, 64, WSP(bf16, WS_NK) + (size_t)h * NT * 64, 64, WSP(bf16, WS_PN) + 1024 + h * 64, 1536,
                                     WSP(bf16, WS_OB) + (size_t)(NC + qb * 256) * 512 + h * 64, ntp, glo, ghi, qb, inp(F, 17) + ((size_t)l * 8 + h) * 465, ring); }
        { volatile LAS unsigned* tk = (volatile LAS unsigned*)(F.lds + MISC_OFF) + 12; const int ntk = (moe ? NEXP : 1) * (CVT_FFN / 64);
          for (;;) { __syncthreads(); if (F.tid == 0) tk[0] = xb_add(ctl + CW_CVT + l * 64, 1u);
              __syncthreads(); const int t = __builtin_amdgcn_readfirstlane((int)tk[0]); if (t >= ntk) break;
              convert_items(F, l, CVT_NONFFN + t * 64 + F.wave, CVT_NONFFN + (t + 1) * 64, 8); } }
        } PH_END
        PH_BEGIN LPH(6) { { pg8::SchedPlain S; S.T.init(nM, 2, F.G, bx); S.A = WSP(bf16, WS_Z); S.Bt = WSP(bf16, WS_WGLU); S.lda = 512; S.ldb = 512; S.pm0 = pm0;
            pg8::EpiGlu E{WSP(bf16, WS_Z), WSP(bf16, WS_OC), inp(F, 27) + l * 512}; pg8::gemm_phase(ring, 512, 512, 512, S, E); } } PH_END
        PH_BEGIN LPH(7) { { pg8::SchedMerge S; S.T.init(64, 4, F.G, bx); S.O = WSP(bf16, WS_OA); S.W = WSP(bf16, WS_WBR); S.pm0 = 1;
            pg8::EpiMerge E{WSP(bf16, WS_G), WSP(bf16, WS_M1)}; pg8::gemm_phase(ring, 512, 512, 512, S, E); }
            if (need_ctx) { pg8::SchedCtxMerge S; S.G = F.G; S.c = (c + 96) & 255; S.O = WSP(bf16, WS_OA); S.W = WSP(bf16, WS_WBR);
            pg8::EpiMergeCtx E{WSP(bf16, WS_G), WSP(bf16, WS_M1C)}; pg8::gemm_phase(ring, 512, 512, 512, S, E); } } PH_END
        PH_BEGIN LPH(8) { { pg8::SchedPlain S; S.T.init(64, 4, F.G, bx); S.A = WSP(bf16, WS_M1); S.Bt = WSP(bf16, WS_WOUT); S.lda = D; S.ldb = D; S.pm0 = 1;
            pg8::EpiResid E{WSP(bf16, WS_XS), modl + 2 * D, modc + 2 * D}; pg8::gemm_phase(ring, D, D, D, S, E); }
            if (need_ctx) { pg8::SchedCtxK S; S.nsl = 12; S.nks = 4; S.G = F.G; S.c = (c + 96) & 255; S.A = WSP(bf16, WS_M1C); S.astride = (size_t)256 * 1024; S.Bt = WSP(bf16, WS_WOUT); S.lda = D; S.ldb = D;
            pg8::EpiResidPart E{WSP(float, WS_PART), modc + 2 * D}; pg8::gemm_phase(ring, 256, D, D, S, E); } } PH_END
        PH_BEGIN LPH(9) { norm_phase<1>(F, l); } PH_END
        if (!moe) {
            PH_BEGIN LPH(10) { { pg8::SchedPlain S; S.T.init(nM, 22, F.G, bx); S.A = WSP(bf16, WS_H); S.Bt = WSP(bf16, WS_WGU); S.lda = D; S.ldb = D; S.pm0 = pm0;
                pg8::EpiUp E{WSP(bf16, WS_ACT)}; pg8::gemm_phase(ring, D, D, D, S, E); } } PH_END
            PH_BEGIN LPH(11) { { pg8::SchedPlain S; S.T.init(64, 4, F.G, bx); S.A = WSP(bf16, WS_ACT); S.Bt = WSP(bf16, WS_WD); S.lda = FF; S.ldb = FF; S.pm0 = 1;
                pg8::EpiResid E{WSP(bf16, WS_XS), modl + 5 * D, modc + 5 * D}; pg8::gemm_phase(ring, FF, FF, FF, S, E); }
                if (need_ctx) { pg8::SchedCtxK S; S.nsl = 11; S.nks = 11; S.G = F.G; S.c = (c + 96) & 255; S.A = WSP(bf16, WS_ACT); S.astride = 0; S.Bt = WSP(bf16, WS_WD); S.lda = FF; S.ldb = FF;
                pg8::EpiResidPart E{WSP(float, WS_PART), modc + 5 * D}; pg8::gemm_phase(ring, 256, FF, FF, S, E); } } PH_END
        } else {
            PH_BEGIN LPH(12) { moe_scatter(F, l); } PH_END
            LAS int* tst = (LAS int*)(F.lds + RING_BYTES + 2048);
            PH_BEGIN LPH(13) { { int base[9]; moe_bases((const unsigned*)ctl + CW_CNT + (l >> 1) * 8 * 64, base); __syncthreads();
                if (F.tid < 160) { int e = 0;
#pragma unroll
                    for (int j = 1; j < 8; ++j) e += (F.tid >= (base[j] >> 8)) ? 1 : 0;
                    tst[F.tid] = e; } __syncthreads();
                pg8::SchedMoe S; S.T.init(base[8] >> 8, 22, F.G, bx); S.A = WSP(bf16, WS_HS); S.W = WSP(bf16, WS_WGU); S.lda = D / 2; S.ldb = D / 2; S.wstride = (size_t)FF2 * D / 2; S.tstart = tst;
                pg8::EpiUp8 E{WSP(unsigned char, WS_ACT)}; pg8::gemm_phase<true>(ring, D / 2, D / 2, D / 2, S, E); } } PH_END
            PH_BEGIN LPH(14) { { int base[9]; moe_bases((const unsigned*)ctl + CW_CNT + (l >> 1) * 8 * 64, base); __syncthreads();
                if (F.tid < 160) { int e = 0;
#pragma unroll
                    for (int j = 1; j < 8; ++j) e += (F.tid >= (base[j] >> 8)) ? 1 : 0;
                    tst[F.tid] = e; } __syncthreads();
                pg8::SchedMoeDown8 S; S.T.init(base[8] >> 8, 8, F.G, bx); S.A = WSP(bf16, WS_ACT); S.W = WSP(bf16, WS_WD); S.tstart = tst;
                pg8::EpiMoeY E{WSP(bf16, WS_Y), WSP(bf16, WS_Y2)}; pg8::gemm_phase<true, true, 125>(ring, 768, FF / 2, FF / 2, S, E); } } PH_END
        }
    }
__global__ void __launch_bounds__(512, 2) mega(Args args) {
    extern __shared__ __attribute__((aligned(16))) unsigned char lds_raw[];
    Frame F; F.lds = (LAS unsigned char*)lds_raw; F.ws = (unsigned char*)(GAS unsigned char*)(unsigned long long)args.ws; F.out = (float*)(GAS float*)(unsigned long long)args.out;
    F.tid = threadIdx.x; F.lane = F.tid & 63; F.wave = __builtin_amdgcn_readfirstlane(F.tid >> 6);
    F.G = gridDim.x; { const int bx = blockIdx.x; F.vcu = (F.G % 8 == 0) ? (bx % 8) * (F.G / 8) + bx / 8 : bx; }
    F.gw = F.vcu * 8 + F.wave; F.NGW = F.G * 8;
    volatile LAS unsigned* MISC = (volatile LAS unsigned*)(F.lds + MISC_OFF);
    for (int u = F.tid; u < (LDS_BYTES - RING_BYTES) / 4; u += 512) ((LAS unsigned*)(F.lds + RING_BYTES))[u] = 0u;
    __syncthreads();
    if (F.tid < 39) { const unsigned long long pv = (unsigned long long)args.in[F.tid]; LAS unsigned* t = (LAS unsigned*)(F.lds + INTAB_OFF) + 2 * F.tid; t[0] = (unsigned)pv; t[1] = (unsigned)(pv >> 32); }
    __syncthreads();
    unsigned* ctl = WSP(unsigned, WS_CTL);
    XcdBarrier bar; bar.bar = ctl + CW_BAR; bar.x = 0; bar.st = nullptr;
    if (ONE_LAUNCH) bar = xcd_barrier_post(ctl + CW_BAR, MISC + 8);
    int ph = 0; const int lo = args.ph_lo, hi = args.ph_hi;
    LAS unsigned char* ring = F.lds;
    const int c = F.vcu;

    PH_BEGIN
#if DBG_THRASH == 1
    dbg_thrash(F);
#endif
    prologue0(F); PH_END
    PH_BEGIN prologue1(F); PH_END

    layer_body<0>(F, args, bar, ph, lo, hi, ring, c, ctl);
    if (DBG_NLAYERS > 1) layer_body<1>(F, args, bar, ph, lo, hi, ring, c, ctl);
    if (DBG_NLAYERS > 2) layer_body<2>(F, args, bar, ph, lo, hi, ring, c, ctl);
    if (DBG_NLAYERS > 3) layer_body<3>(F, args, bar, ph, lo, hi, ring, c, ctl);
    for (int xb_ = 0; xb_ < DBG_XB; ++xb_) { PH_BEGIN PH_END }
    PH_BEGIN
#if DBG_THRASH == 2
    dbg_thrash(F); __syncthreads();
#endif
    final_out(F, DBG_NLAYERS - 1);
    if (ONE_LAUNCH && xb_ld(ctl + CW_BAR + XB_TMO) != 0u) {
        const float qn = __builtin_nanf(""); for (size_t i = (size_t)blockIdx.x * 512 + F.tid; i < (size_t)NL * D; i += (size_t)F.G * 512) F.out[i] = qn; }
    PH_END
}

static int count_phases() { int n = 2; for (int l = 0; l < DBG_NLAYERS; ++l) n += 9 + (((l & 1) && !DBG_NOMOE) ? 3 : 2); return n + 1 + DBG_XB; }
extern "C" void kernel_launch(void* const* d_in, const int* in_sizes, int n_in, void* d_out, int out_size, void* d_ws, size_t ws_size, hipStream_t stream) {
    static int grid = 0;
    if (grid == 0) {
        if (n_in != 39 || out_size != NL * D || ws_size < WS_END) { fprintf(stderr, "kernel_launch: unexpected shapes: n_in %d out %d ws %zu (need %zu)\n", n_in, out_size, ws_size, (size_t)WS_END); grid = -1; return; }
        int dev = 0, cus = 0, per_cu = 0;
        if (hipGetDevice(&dev) != hipSuccess || hipDeviceGetAttribute(&cus, hipDeviceAttributeMultiprocessorCount, dev) != hipSuccess) { grid = -1; return; }
        if (hipFuncSetAttribute((const void*)mega, hipFuncAttributeMaxDynamicSharedMemorySize, LDS_BYTES) != hipSuccess) { fprintf(stderr, "kernel_launch: hipFuncSetAttribute failed\n"); grid = -1; return; }
        if (hipOccupancyMaxActiveBlocksPerMultiprocessor(&per_cu, (const void*)mega, 512, LDS_BYTES) != hipSuccess || per_cu < 1) fprintf(stderr, "kernel_launch: occupancy query reports %d\n", per_cu);
        (void)hipGetLastError();
        grid = cus;
    }
    if (grid < 0) return;
    (void)hipMemsetAsync((char*)d_ws + WS_CTL, 0, CTL_BYTES, stream);
#ifdef DBG_MEMSET_LO
    (void)hipMemsetAsync((char*)d_ws + (size_t)DBG_MEMSET_LO * MiB, 0, (size_t)(DBG_MEMSET_HI - DBG_MEMSET_LO) * MiB, stream);
#endif
    Args a{};
    for (int i = 0; i < 39; ++i) a.in[i] = (const float*)d_in[i];
    a.out = (float*)d_out; a.ws = (unsigned char*)d_ws;
    const int nph = count_phases();
#if ONE_LAUNCH
    a.ph_lo = 0; a.ph_hi = nph;
    hipLaunchKernelGGL(mega, dim3(grid), dim3(512), LDS_BYTES, stream, a);
#else
    for (int p = 0; p < nph; ++p) { a.ph_lo = p; a.ph_hi = p + 1; hipLaunchKernelGGL(mega, dim3(grid), dim3(512), LDS_BYTES, stream, a); }
#endif
    const hipError_t le = hipPeekAtLastError();
    if (le != hipSuccess) fprintf(stderr, "kernel_launch: launch failed: %s\n", hipGetErrorName(le));
}
```

```cpp
#include <hip/hip_runtime.h>
#include <cstdio>
#include <cstdint>

#define DBG_REPA 0
#ifndef DBG_THRASH
#define DBG_THRASH 0
#endif
#ifdef DBG_LDSZERO
#define DBG_LDSCLR { for (int u_ = threadIdx.x; u_ < RING_BYTES / 16; u_ += 512) ((LAS u32x4*)F.lds)[u_] = (u32x4){0u, 0u, 0u, 0u}; __syncthreads(); }
#else
#define DBG_LDSCLR
#endif
#ifndef DBG_XB
#define DBG_XB 0
#endif
#ifndef DBG_SP
#define DBG_SP 99
#endif
#ifndef DBG_DUMP
#define DBG_DUMP 0
#endif
#ifndef DBG_REPMASK
#define DBG_REPMASK 0
#endif
#define LPH(k) for (int rep_ = 0; rep_ < 1 + ((DBG_REPMASK >> (k)) & 1); ++rep_)
#ifndef DBG_YSRC
#define DBG_YSRC WS_Y
#endif
#ifndef DBG_NOMOE
#define DBG_NOMOE 0
#endif
#ifndef DBG_NLAYERS
#define DBG_NLAYERS 4
#endif
#ifndef ONE_LAUNCH
#define ONE_LAUNCH 1
#endif

#define GAS __attribute__((address_space(1)))
#define LAS __attribute__((address_space(3)))
typedef unsigned short bf16;
typedef short bf16x8 __attribute__((ext_vector_type(8)));
typedef short s16x4 __attribute__((ext_vector_type(4)));
typedef float f32x4 __attribute__((ext_vector_type(4)));
typedef float f32x16 __attribute__((ext_vector_type(16)));
typedef unsigned u32x4 __attribute__((ext_vector_type(4)));
typedef unsigned u32x2 __attribute__((ext_vector_type(2)));
typedef int i32x8 __attribute__((ext_vector_type(8)));

constexpr int D = 1024, NL = 16384, NC = 256, NT = NL + NC, DEPTH = 4;
constexpr int DINP = 5888;
constexpr int FF = 2816, FF2 = 5632, NEXP = 8;
constexpr float EPS = 1e-6f;
constexpr int S5T = 32, S5ROWS = 768, S5K = 768;
constexpr int MOE_ROWS = 35328;

constexpr size_t MiB = 1u << 20;
constexpr size_t WS_CTL = 0, CTL_BYTES = 1 * MiB;
constexpr size_t WS_MOD = 1 * MiB;
constexpr size_t WS_ROPE = 2 * MiB;
constexpr size_t WS_S5P = 4 * MiB;
constexpr size_t WS_KTAB = 11 * MiB;
constexpr size_t WS_REC = 19 * MiB;
constexpr size_t WS_WIN = 20 * MiB;
constexpr size_t WS_WUQ = 32 * MiB;
constexpr size_t WS_WUKV = 33 * MiB;
constexpr size_t WS_WGLU = 34 * MiB;
constexpr size_t WS_WBR = 35 * MiB;
constexpr size_t WS_WOUT = 38 * MiB;
constexpr size_t WS_WGU = 40 * MiB;
constexpr size_t WS_WD = 128 * MiB;
constexpr size_t WS_WY = 172 * MiB;
constexpr size_t WS_WEND = 196 * MiB;
constexpr size_t WS_AG = 204 * MiB;
constexpr size_t WS_E = 240 * MiB;
constexpr size_t WS_Z = 264 * MiB;
constexpr size_t WS_M1 = 240 * MiB;
constexpr size_t WS_XS = 281 * MiB;
constexpr size_t WS_OA = 346 * MiB;
constexpr size_t WS_OB = WS_OA + (size_t)NT * 512 * 2;
constexpr size_t WS_OC = WS_OB + (size_t)NT * 512 * 2;
constexpr size_t WS_H = 346 * MiB;
constexpr size_t WS_R1 = 395 * MiB;
constexpr size_t WS_G = WS_R1;
constexpr size_t WS_PN = WS_G + (size_t)NT * 3072 * 2;
constexpr size_t WS_PA = WS_PN + (size_t)NT * 1536 * 2;
constexpr size_t WS_QRAW = WS_PA + (size_t)NT * 768 * 2;
constexpr size_t WS_KVRAW = WS_QRAW + (size_t)NT * 768 * 2;
constexpr size_t WS_ACT = WS_R1;
constexpr size_t WS_R2 = 623 * MiB;
constexpr size_t WS_QF = WS_R2;
constexpr size_t WS_KF = WS_QF + (size_t)8 * NT * 96 * 2;
constexpr size_t WS_VF = WS_KF + (size_t)8 * NT * 96 * 2;
constexpr size_t WS_NQ = WS_VF + (size_t)8 * NT * 64 * 2;
constexpr size_t WS_NK = WS_NQ + (size_t)8 * NT * 64 * 2;
constexpr size_t WS_HS = WS_R2;
constexpr size_t WS_Y = WS_HS + (size_t)MOE_ROWS * 1024 * 2;
constexpr size_t WS_PART = 762 * MiB;
constexpr size_t WS_Y2 = 774 * MiB;
constexpr size_t WS_M1C = 843 * MiB;
constexpr size_t WS_END = 845 * MiB;
static_assert(WS_KVRAW + (size_t)NT * 1024 * 2 <= WS_R2 && WS_ACT + (size_t)MOE_ROWS * 2816 * 2 <= WS_R2, "region 1");
static_assert(WS_NK + (size_t)8 * NT * 64 * 2 <= WS_END && WS_Y + (size_t)MOE_ROWS * 1024 * 2 <= WS_END, "region 2");
static_assert(WS_OC + (size_t)NT * 512 * 2 <= WS_R1 && WS_Z + (size_t)NT * 512 * 2 <= WS_XS && WS_M1 + (size_t)NT * 1024 * 2 <= WS_XS, "map");
constexpr int CW_BAR = 4096;
constexpr int CW_CNT = 16384;

constexpr int RING_BYTES = 131072, MISC_OFF = RING_BYTES + 320, LDS_BYTES = 147456;

#define LDS_WAIT() asm volatile("s_waitcnt lgkmcnt(0)" ::: "memory")
#define VM_WAIT() asm volatile("s_waitcnt vmcnt(0)" ::: "memory")
#define SBAR() __builtin_amdgcn_sched_barrier(0)
__device__ __forceinline__ unsigned cvtpk(float lo, float hi) { unsigned r; asm volatile("v_cvt_pk_bf16_f32 %0, %1, %2" : "=v"(r) : "v"(lo), "v"(hi)); return r; }
__device__ __forceinline__ float bflo(unsigned w) { return __uint_as_float(w << 16); }
__device__ __forceinline__ float bfhi(unsigned w) { return __uint_as_float(w & 0xffff0000u); }
__device__ __forceinline__ bf16 f2bf(float f) { return (bf16)(cvtpk(f, 0.f) & 0xffffu); }
__device__ __forceinline__ float bf2f(bf16 b) { return __uint_as_float(((unsigned)b) << 16); }
__device__ __forceinline__ void unpack8(const u32x4 w, float (&f)[8]) { f[0] = bflo(w.x); f[1] = bfhi(w.x); f[2] = bflo(w.y); f[3] = bfhi(w.y); f[4] = bflo(w.z); f[5] = bfhi(w.z); f[6] = bflo(w.w); f[7] = bfhi(w.w); }
__device__ __forceinline__ u32x4 pack8(const f32x4 a, const f32x4 b) { u32x4 w; w.x = cvtpk(a[0], a[1]); w.y = cvtpk(a[2], a[3]); w.z = cvtpk(b[0], b[1]); w.w = cvtpk(b[2], b[3]); return w; }
__device__ __forceinline__ f32x4 ld4bf(const bf16* p) { const u32x2 w = *(const u32x2*)p; return (f32x4){bflo(w.x), bfhi(w.x), bflo(w.y), bfhi(w.y)}; }
__device__ __forceinline__ void st4bf(bf16* p, const f32x4 v) { u32x2 w; w.x = cvtpk(v[0], v[1]); w.y = cvtpk(v[2], v[3]); *(u32x2*)p = w; }
__device__ __forceinline__ float fsigmoid(float x) { return __builtin_amdgcn_rcpf(1.f + __builtin_amdgcn_exp2f(-1.4426950408889634f * x)); }
__device__ __forceinline__ float fsilu(float x) { return x * fsigmoid(x); }
__device__ __forceinline__ float fgelu_tanh(float x) { return x * fsigmoid(1.5957691216057308f * (x + 0.044715f * x * x * x)); }
__device__ __forceinline__ float wave_sum(float v) {
#pragma unroll
    for (int o = 1; o < 64; o <<= 1) v += __shfl_xor(v, o);
    return v;
}
__device__ __forceinline__ void sincos_rad(float a, float& s, float& c) {
    float rev = a * 0.15915494309189535f; rev = rev - floorf(rev);
    s = __builtin_amdgcn_sinf(rev); c = __builtin_amdgcn_cosf(rev);
}

#define XB_TMO      128
#define XB_XCNT(j)  (256  + 64 * (j))
#define XB_XSUB(j)  (1280 + 64 * (j))
#define XB_XGEN(j)  (2304 + 64 * (j))
#define XB_TOP      3328
#define XB_TOPGEN   3392
#define XCD_BAR_WORDS 3456
#define XB_SPIN_CAP (1u << 22)

__device__ __forceinline__ unsigned xb_ld(unsigned* p)              { return __hip_atomic_load(p, __ATOMIC_RELAXED, __HIP_MEMORY_SCOPE_AGENT); }
__device__ __forceinline__ unsigned xb_add(unsigned* p, unsigned v) { return __hip_atomic_fetch_add(p, v, __ATOMIC_RELAXED, __HIP_MEMORY_SCOPE_AGENT); }
__device__ __forceinline__ unsigned xb_xcc_id() { return (unsigned)__builtin_amdgcn_s_getreg((3 << 11) | 20) & 0xFu; }
#define XB_SPIN(cond, bar) do { unsigned _sp = 0; while (cond) { __builtin_amdgcn_s_sleep(1); \
    if ((++_sp & 255u) == 0u) { if (xb_ld(&(bar)[XB_TMO])) break; if (_sp > XB_SPIN_CAP) { atomicAdd(&(bar)[XB_TMO], 1u); break; } } } } while (0)

struct XcdBarrier { unsigned* bar; unsigned x; volatile LAS unsigned* st; };
__device__ __forceinline__ XcdBarrier xcd_barrier_post(unsigned* bar, volatile LAS unsigned* st) {
    XcdBarrier b; b.bar = bar; b.x = xb_xcc_id(); b.st = st;
    if (threadIdx.x == 0) (void)xb_add(&bar[XB_XCNT(b.x)], 1u);
    return b;
}
__device__ __forceinline__ void xcd_barrier_complete(unsigned* bar, unsigned x, unsigned& nloc, unsigned& nx) {
    const unsigned G = gridDim.x * gridDim.y * gridDim.z;
    unsigned sum, cnt, mine, sp = 0u;
    for (;;) {
        sum = 0u; cnt = 0u; mine = 0u;
#pragma unroll
        for (unsigned j = 0; j < 16; ++j) { const unsigned c = xb_ld(&bar[XB_XCNT(j)]); sum += c; cnt += (c > 0u) ? 1u : 0u; mine = (j == x) ? c : mine; }
        if (sum == G) break;
        __builtin_amdgcn_s_sleep(1);
        if ((++sp & 255u) == 0u) { if (xb_ld(&bar[XB_TMO])) break; if (sp > XB_SPIN_CAP) { atomicAdd(&bar[XB_TMO], 1u); break; } }
    }
    nloc = mine > 0u ? mine : 1u; nx = cnt > 0u ? cnt : 1u;
}
__device__ __forceinline__ void xcd_barrier(const XcdBarrier& b) {
    asm volatile("s_waitcnt vmcnt(0)" ::: "memory");
    __syncthreads();
    if (threadIdx.x == 0) {
        unsigned* bar = b.bar;
        __builtin_amdgcn_s_waitcnt(0);
        unsigned nloc = b.st[0], nx = b.st[1];
        if (nloc == 0u) { xcd_barrier_complete(bar, b.x, nloc, nx); b.st[0] = nloc; b.st[1] = nx; }
        const unsigned old = xb_add(&bar[XB_XSUB(b.x)], 1u);
        const unsigned gen = old / nloc;
        if (old + 1u == (gen + 1u) * nloc) {
            __builtin_amdgcn_fence(__ATOMIC_RELEASE, "agent");
            asm volatile("s_waitcnt vmcnt(0)" ::: "memory");
            const unsigned og = xb_add(&bar[XB_TOP], 1u);
            const unsigned tg = og / nx;
            if (og + 1u == (tg + 1u) * nx) xb_add(&bar[XB_TOPGEN], 1u);
            else XB_SPIN(xb_ld(&bar[XB_TOPGEN]) == tg, bar);
            __builtin_amdgcn_fence(__ATOMIC_ACQUIRE, "agent");
            xb_add(&bar[XB_XGEN(b.x)], 1u);
            asm volatile("s_waitcnt vmcnt(0)" ::: "memory");
        } else {
            XB_SPIN(xb_ld(&bar[XB_XGEN(b.x)]) == gen, bar);
            __builtin_amdgcn_fence(__ATOMIC_ACQUIRE, "agent");
            asm volatile("s_waitcnt vmcnt(0)" ::: "memory");
        }
    }
    __syncthreads();
}

namespace pg8 {
constexpr int BM = 256, BK = 64, HALF = 128, HTB = HALF * BK * 2, NXCD = 8, WGM = 8;
__host__ __device__ __forceinline__ int lds_byte(int r, int c) { const int st = (r >> 4) * 2 + (c >> 5), rr = r & 15, cc = c & 31, ob = rr * 64 + cc * 2; return st * 1024 + (ob ^ (((ob >> 9) & 1) << 5)); }
__host__ __device__ __forceinline__ void stage_rc(int b, int& R, int& C) { const int st = b / 1024, sb = b % 1024, swz = sb ^ (((sb >> 9) & 1) << 5); R = (st >> 1) * 16 + swz / 64; C = (st & 1) * 32 + (swz % 64) / 2; }
__host__ __device__ __forceinline__ int perm32(int rho) { const int n = rho >> 4, i = rho & 15; return 8 * (i >> 2) + 4 * n + (i & 3); }
struct Unit { int pm, pn, aux; };

struct TileOrder {
    int nM, nN, nwg, G, c;
    __device__ __forceinline__ void init(int nM_, int nN_, int G_, int c_) { nM = nM_; nN = nN_; nwg = nM * nN; G = G_; c = c_; }
    __device__ __forceinline__ bool tile(int i, int& pm, int& pn) const {
        const long L = (long)i * G + c; if (L >= nwg) return false;
        int wgid = (int)L; { const int q = nwg / NXCD, r = nwg % NXCD, xcd = wgid % NXCD, off = wgid / NXCD; wgid = (xcd < r ? xcd * (q + 1) : r * (q + 1) + (xcd - r) * q) + off; }
        const int nig = WGM * nN, gid = wgid / nig, fm = gid * WGM, gsz = (nM - fm) < WGM ? (nM - fm) : WGM;
        pm = fm + ((wgid % nig) % gsz); pn = (wgid % nig) / gsz; return true;
    }
};

typedef int i32x4_ __attribute__((ext_vector_type(4)));
__device__ __forceinline__ i32x8 cat8(const bf16x8 a, const bf16x8 b) { const i32x4_ x = __builtin_bit_cast(i32x4_, a), y = __builtin_bit_cast(i32x4_, b);
    return __builtin_shufflevector(x, y, 0, 1, 2, 3, 4, 5, 6, 7); }
__device__ __forceinline__ void mfma8_acc(f32x4& acc, const i32x8 a, const i32x8 b, const int sa, const int sb) {
    asm volatile("v_mfma_scale_f32_16x16x128_f8f6f4 %0, %1, %2, %0, %3, %4 op_sel_hi:[0,0,0]" : "+v"(acc) : "v"(a), "v"(b), "v"(sa), "v"(sb));
}
template <bool F8 = false, bool VK = false, int SACT = 127, class Epi, class Sched>
__device__ __forceinline__ void gemm_phase(LAS unsigned char* lds, const int K, const int lda, const int ldb, const Sched& S, const Epi& E) {
    int tid_ = threadIdx.x; asm volatile("" : "+v"(tid_));
    const int tid = tid_, wid = __builtin_amdgcn_readfirstlane(tid >> 6), lane = tid & 63, wr = wid >> 2, wc = wid & 3, fr = lane & 15, fq = lane >> 4;
    int nt = K / BK;
    unsigned voffA[2], voffB[2];
#pragma unroll
    for (int i = 0; i < 2; ++i) { int R, C; stage_rc(tid * 16 + i * 8192, R, C); const int Rb = (R & ~31) + perm32(R & 31);
        voffA[i] = (unsigned)(R * lda + C) * 2u; voffB[i] = (unsigned)(Rb * ldb + C) * 2u; }
    const size_t kstep = (size_t)(BK * 2);
    const size_t hstepA = (size_t)HALF * lda * 2, hstepB = (size_t)HALF * ldb * 2;
    const unsigned ldsw = (unsigned)wid * 1024u;
    const int aoff = lds_byte(wr * 64 + fr, fq * 8), boff = lds_byte(wc * 32 + fr, fq * 8);
#define PG8_SA(b, h) (((b) * 2 + (h)) * HTB)
#define PG8_SB(b, h) ((4 + (b) * 2 + (h)) * HTB)
#define PG8_STAGE(bufoff, gbase, voff) do { _Pragma("unroll") for (int _i = 0; _i < 2; ++_i) \
        __builtin_amdgcn_global_load_lds((const unsigned*)((const char*)(gbase) + (voff)[_i]), (LAS unsigned*)(lds + (bufoff) + ldsw + _i * 8192), 16, 0, 0); } while (0)
#define PG8_LDA(dst, b, h) do { _Pragma("unroll") for (int m = 0; m < 4; ++m) _Pragma("unroll") for (int k = 0; k < 2; ++k) dst[m][k] = *(const LAS bf16x8*)(lds + PG8_SA(b, h) + aoff + m * 2048 + k * 1024); } while (0)
#define PG8_LDB(dst, b, h) do { _Pragma("unroll") for (int n = 0; n < 2; ++n) _Pragma("unroll") for (int k = 0; k < 2; ++k) dst[n][k] = *(const LAS bf16x8*)(lds + PG8_SB(b, h) + boff + n * 2048 + k * 1024); } while (0)
#define PG8_MMA(ai, bj, At, Bt) do { __builtin_amdgcn_s_setprio(1); _Pragma("unroll") for (int m = 0; m < 4; ++m) _Pragma("unroll") for (int n = 0; n < 2; ++n) { \
        if constexpr (F8) mfma8_acc(acc[ai][bj][m][n], cat8(Bt[n][0], Bt[n][1]), cat8(At[m][0], At[m][1]), 122, SACT); \
        else { _Pragma("unroll") for (int k = 0; k < 2; ++k) acc[ai][bj][m][n] = __builtin_amdgcn_mfma_f32_16x16x32_bf16(Bt[n][k], At[m][k], acc[ai][bj][m][n], 0, 0, 0); } } __builtin_amdgcn_s_setprio(0); } while (0)
#define PG8_LDA2(dst, b, h, m0) do { _Pragma("unroll") for (int mm = 0; mm < 2; ++mm) _Pragma("unroll") for (int k = 0; k < 2; ++k) dst[mm][k] = *(const LAS bf16x8*)(lds + PG8_SA(b, h) + aoff + ((m0) + mm) * 2048 + k * 1024); } while (0)
#define PG8_MMA2(ai, bj, m0, A2, Bt) do { __builtin_amdgcn_s_setprio(1); _Pragma("unroll") for (int mm = 0; mm < 2; ++mm) _Pragma("unroll") for (int n = 0; n < 2; ++n) \
        mfma8_acc(acc[ai][bj][(m0) + mm][n], cat8(Bt[n][0], Bt[n][1]), cat8(A2[mm][0], A2[mm][1]), 122, 127); __builtin_amdgcn_s_setprio(0); } while (0)
#define PG8_LDAX(b, h) do { PG8_LDA(At, b, h); } while (0)
#define PG8_MMAX(ai, b, h) do { PG8_MMA(ai, 0, At, B0); PG8_MMA(ai, 1, At, B1); } while (0)
#define PG8_WAIT_V(n) asm volatile("s_waitcnt vmcnt(" #n ")" ::: "memory")
#define PG8_WAIT_L(n) asm volatile("s_waitcnt lgkmcnt(" #n ")" ::: "memory")
#define PG8_BAR __builtin_amdgcn_s_barrier()
#define PG8_SCHED __builtin_amdgcn_sched_barrier(0)
    Unit cur, nxt; int ui = 0;
    if (!S.next(0, cur)) return;
    f32x4 acc[2][2][4][2];
#pragma unroll
    for (int a = 0; a < 2; ++a)
#pragma unroll
        for (int b = 0; b < 2; ++b)
#pragma unroll
            for (int m = 0; m < 4; ++m)
#pragma unroll
                for (int n = 0; n < 2; ++n) { acc[a][b][m][n] = (f32x4){0.f, 0.f, 0.f, 0.f}; }
    bf16x8 At[4][2], B0[2][2], B1[2][2];
    const char* cA = S.abase(cur); const char* cB = S.bbase(cur);
    PG8_STAGE(PG8_SB(0, 0), cB, voffB); PG8_STAGE(PG8_SB(0, 1), cB + hstepB, voffB); PG8_STAGE(PG8_SA(0, 0), cA, voffA); PG8_STAGE(PG8_SA(0, 1), cA + hstepA, voffA);
    if (wr == 1) PG8_BAR;
    PG8_WAIT_V(2); PG8_BAR;
    PG8_STAGE(PG8_SB(1, 0), cB + kstep, voffB); PG8_STAGE(PG8_SA(1, 0), cA + kstep, voffA); PG8_STAGE(PG8_SB(1, 1), cB + hstepB + kstep, voffB);
    PG8_WAIT_V(6); PG8_BAR;
    for (;;) {
        if constexpr (VK) nt = S.knt(cur);
        const bool has_next = S.next(ui + 1, nxt);
        const char* nA = has_next ? S.abase(nxt) : cA; const char* nB = has_next ? S.bbase(nxt) : cB;
#pragma clang loop unroll(disable)
        for (int t = 0; t < nt; t += 2) {
            const bool last = (t == nt - 2);
            const char* a1 = cA + (size_t)(t + 1) * kstep;
            const char* a2 = last ? nA : cA + (size_t)(t + 2) * kstep; const char* b2 = last ? nB : cB + (size_t)(t + 2) * kstep;
            const char* a3 = a2 + kstep; const char* b3 = b2 + kstep;
            PG8_LDB(B0, 0, 0); PG8_LDB(B1, 0, 1); PG8_SCHED; PG8_LDAX(0, 0); PG8_STAGE(PG8_SA(1, 1), a1 + hstepA, voffA);
            PG8_WAIT_V(8); PG8_WAIT_L(0); PG8_BAR; PG8_MMAX(0, 0, 0); PG8_BAR; PG8_SCHED;
            PG8_LDAX(0, 1); PG8_STAGE(PG8_SB(0, 0), b2, voffB); PG8_STAGE(PG8_SB(0, 1), b2 + hstepB, voffB); PG8_STAGE(PG8_SA(0, 0), a2, voffA);
            PG8_WAIT_V(8); PG8_WAIT_L(0); PG8_BAR; PG8_MMAX(1, 0, 1); PG8_BAR; PG8_SCHED;
            PG8_LDB(B0, 1, 0); PG8_LDB(B1, 1, 1); PG8_SCHED; PG8_LDAX(1, 0); PG8_STAGE(PG8_SA(0, 1), a2 + hstepA, voffA);
            PG8_WAIT_V(8); PG8_WAIT_L(0); PG8_BAR; PG8_MMAX(0, 1, 0); PG8_BAR; PG8_SCHED;
            PG8_LDAX(1, 1); PG8_STAGE(PG8_SB(1, 0), b3, voffB); PG8_STAGE(PG8_SB(1, 1), b3 + hstepB, voffB); PG8_STAGE(PG8_SA(1, 0), a3, voffA);
            PG8_WAIT_V(8); PG8_WAIT_L(0); PG8_BAR; PG8_MMAX(1, 1, 1); PG8_BAR; PG8_SCHED;
        }
        if (wr == 0) PG8_BAR;
        if constexpr (F8) { asm volatile("s_nop 15\n\ts_nop 15" ::: "memory");
#pragma unroll
            for (int a = 0; a < 2; ++a)
#pragma unroll
                for (int b = 0; b < 2; ++b)
#pragma unroll
                    for (int m = 0; m < 4; ++m)
#pragma unroll
                        for (int n = 0; n < 2; ++n) asm volatile("" : "+v"(acc[a][b][m][n])); }
        E(acc, cur, wr, wc, fr, fq);
        if (!has_next) break;
#pragma unroll
        for (int a = 0; a < 2; ++a)
#pragma unroll
            for (int b = 0; b < 2; ++b)
#pragma unroll
                for (int m = 0; m < 4; ++m)
#pragma unroll
                    for (int n = 0; n < 2; ++n) { acc[a][b][m][n] = (f32x4){0.f, 0.f, 0.f, 0.f}; }
        cur = nxt; cA = nA; cB = nB; ++ui;
        if (wr == 1) PG8_BAR;
    }
    PG8_WAIT_V(0);
    PG8_BAR;
#undef PG8_SA
#undef PG8_SB
#undef PG8_STAGE
#undef PG8_LDA
#undef PG8_LDB
#undef PG8_MMAX
#undef PG8_LDAX
#undef PG8_MMA2
#undef PG8_LDA2
#undef PG8_MMA
#undef PG8_WAIT_V
#undef PG8_WAIT_L
#undef PG8_BAR
#undef PG8_SCHED
}

struct SchedPlain {
    TileOrder T; const bf16* A; const bf16* Bt; int lda, ldb, pm0;
    __device__ __forceinline__ bool next(int i, Unit& u) const { int pm, pn; if (!T.tile(i, pm, pn)) return false; u.pm = pm + pm0; u.pn = pn; u.aux = 0; return true; }
    __device__ __forceinline__ const char* abase(const Unit& u) const { return (const char*)(A + (size_t)u.pm * 256 * lda); }
    __device__ __forceinline__ const char* bbase(const Unit& u) const { return (const char*)(Bt + (size_t)u.pn * 256 * ldb); }
};
struct SchedMerge {
    TileOrder T; const bf16* O; const bf16* W; int pm0;
    __device__ __forceinline__ bool next(int i, Unit& u) const { int pm, pn; if (!T.tile(i / 3, pm, pn)) return false; u.pm = pm + pm0; u.pn = pn; u.aux = i % 3; return true; }
    __device__ __forceinline__ const char* abase(const Unit& u) const { return (const char*)(O + ((size_t)u.aux * NT + (size_t)u.pm * 256) * 512); }
    __device__ __forceinline__ const char* bbase(const Unit& u) const { return (const char*)(W + ((size_t)u.aux * 1024 + (size_t)u.pn * 256) * 512); }
};
struct SchedS5 {
    int nrt, nct, G, c; const bf16* A; const bf16* W; int brows, ldb;
    __device__ __forceinline__ bool next(int i, Unit& u) const { const int L = i * G + c; if (L >= 32 * nrt * nct) return false; u.aux = L / (nrt * nct); const int r = L % (nrt * nct); u.pm = r / nct; u.pn = r % nct; return true; }
    __device__ __forceinline__ const char* abase(const Unit& u) const { return (const char*)(A + ((size_t)u.aux * S5ROWS + (size_t)u.pm * 256) * S5K); }
    __device__ __forceinline__ const char* bbase(const Unit& u) const { return (const char*)(W + ((size_t)u.aux * brows + (size_t)u.pn * 256) * ldb); }
};
struct SchedMoe {
    TileOrder T; const bf16* A; const bf16* W; int lda, ldb; size_t wstride; const LAS int* tstart;
    __device__ __forceinline__ bool next(int i, Unit& u) const { int pm, pn; if (!T.tile(i, pm, pn)) return false; u.pm = pm; u.pn = pn; u.aux = __builtin_amdgcn_readfirstlane(tstart[pm]); return true; }
    __device__ __forceinline__ const char* abase(const Unit& u) const { return (const char*)(A + (size_t)u.pm * 256 * lda); }
    __device__ __forceinline__ const char* bbase(const Unit& u) const { return (const char*)(W + (size_t)u.aux * wstride + (size_t)u.pn * 256 * ldb); }
};

#define EPI_ROWS(u) const int row0 = (u).pm * 256 + wr * 64 + fr; const int cw0 = wc * 32 + 8 * fq;
struct EpiWin {
    bf16 *pA, *pN, *AG, *Gt;
    __device__ __forceinline__ void operator()(const f32x4 (&acc)[2][2][4][2], const Unit& u, int wr, int wc, int fr, int fq) const {
        EPI_ROWS(u) const int pn = u.pn;
#pragma unroll
        for (int ai = 0; ai < 2; ++ai)
#pragma unroll
            for (int m = 0; m < 4; ++m) { const int row = row0 + ai * 128 + m * 16;
#pragma unroll
                for (int bj = 0; bj < 2; ++bj) { const int cw = cw0 + bj * 128; const f32x4 v0 = acc[ai][bj][m][0], v1 = acc[ai][bj][m][1];
                    if (pn < 3) *(u32x4*)(pA + (size_t)row * 768 + pn * 256 + cw) = pack8(v0, v1);
                    else if (pn < 9) *(u32x4*)(pN + (size_t)row * 1536 + (pn - 3) * 256 + cw) = pack8(v0, v1);
                    else if (pn < 11) { const int ucol = (pn - 9) * 256 + cw, g = ucol >> 4, c = ucol & 15;
                        const int tk = row < NC ? row : row - NC; const int cr = (row < NC ? 512 : 0) + (tk >> 5), j = tk & 31;
                        *(u32x4*)(AG + ((size_t)g * S5ROWS + cr) * S5K + j * 16 + c) = pack8(v0, v1); }
                    else { f32x4 s0, s1;
#pragma unroll
                        for (int q = 0; q < 4; ++q) { s0[q] = fsigmoid(v0[q]); s1[q] = fsigmoid(v1[q]); }
                        *(u32x4*)(Gt + (size_t)row * 3072 + (pn - 11) * 256 + cw) = pack8(s0, s1); } } }
    }
};
struct EpiBf16 {
    bf16* O; int ldc;
    __device__ __forceinline__ void operator()(const f32x4 (&acc)[2][2][4][2], const Unit& u, int wr, int wc, int fr, int fq) const {
        EPI_ROWS(u)
#pragma unroll
        for (int ai = 0; ai < 2; ++ai)
#pragma unroll
            for (int m = 0; m < 4; ++m) { const int row = row0 + ai * 128 + m * 16;
#pragma unroll
                for (int bj = 0; bj < 2; ++bj) *(u32x4*)(O + (size_t)row * ldc + u.pn * 256 + cw0 + bj * 128) = pack8(acc[ai][bj][m][0], acc[ai][bj][m][1]); }
    }
};
struct EpiS5E {
    float* Eo;
    __device__ __forceinline__ void operator()(const f32x4 (&acc)[2][2][4][2], const Unit& u, int wr, int wc, int fr, int fq) const {
        EPI_ROWS(u)
#pragma unroll
        for (int ai = 0; ai < 2; ++ai)
#pragma unroll
            for (int m = 0; m < 4; ++m) { const int row = row0 + ai * 128 + m * 16;
#pragma unroll
                for (int bj = 0; bj < 2; ++bj) { float* p = Eo + ((size_t)u.aux * S5ROWS + row) * 256 + cw0 + bj * 128; *(f32x4*)p = acc[ai][bj][m][0]; *(f32x4*)(p + 4) = acc[ai][bj][m][1]; } }
    }
};
struct EpiS5Y {
    bf16* Z;
    __device__ __forceinline__ void operator()(const f32x4 (&acc)[2][2][4][2], const Unit& u, int wr, int wc, int fr, int fq) const {
        EPI_ROWS(u)
#pragma unroll
        for (int ai = 0; ai < 2; ++ai)
#pragma unroll
            for (int m = 0; m < 4; ++m) { const int cr = row0 + ai * 128 + m * 16;
                if (cr < 520) {
#pragma unroll
                for (int bj = 0; bj < 2; ++bj) { const int n = u.pn * 256 + cw0 + bj * 128, t = n >> 4, c = n & 15;
                    const int tok = cr < 512 ? NC + cr * 32 + t : (cr - 512) * 32 + t; f32x4 a, b;
#pragma unroll
                    for (int q = 0; q < 4; ++q) { a[q] = fgelu_tanh(acc[ai][bj][m][0][q]); b[q] = fgelu_tanh(acc[ai][bj][m][1][q]); }
                    *(u32x4*)(Z + (size_t)tok * 512 + u.aux * 16 + c) = pack8(a, b); } } }
    }
};
struct EpiGlu {
    const bf16* Z; bf16* O; const float* bias;
    __device__ __forceinline__ void operator()(const f32x4 (&acc)[2][2][4][2], const Unit& u, int wr, int wc, int fr, int fq) const {
        EPI_ROWS(u)
#pragma unroll
        for (int bj = 0; bj < 2; ++bj) { const int col = u.pn * 256 + cw0 + bj * 128; const f32x4 b0 = *(const f32x4*)(bias + col), b1 = *(const f32x4*)(bias + col + 4);
#pragma unroll
            for (int ai = 0; ai < 2; ++ai)
#pragma unroll
                for (int m = 0; m < 4; ++m) { const int row = row0 + ai * 128 + m * 16; float z[8]; unpack8(*(const u32x4*)(Z + (size_t)row * 512 + col), z); f32x4 a, b;
#pragma unroll
                    for (int q = 0; q < 4; ++q) { a[q] = z[q] * fsigmoid(acc[ai][bj][m][0][q] + b0[q]); b[q] = z[4 + q] * fsigmoid(acc[ai][bj][m][1][q] + b1[q]); }
                    *(u32x4*)(O + (size_t)row * 512 + col) = pack8(a, b); } }
    }
};
struct EpiMerge {
    const bf16* Gt; bf16* M1;
    __device__ __forceinline__ void operator()(const f32x4 (&acc)[2][2][4][2], const Unit& u, int wr, int wc, int fr, int fq) const {
        EPI_ROWS(u) const int br = u.aux;
#pragma unroll
        for (int ai = 0; ai < 2; ++ai)
#pragma unroll
            for (int m = 0; m < 4; ++m) { const int row = row0 + ai * 128 + m * 16;
#pragma unroll
                for (int bj = 0; bj < 2; ++bj) { const int col = u.pn * 256 + cw0 + bj * 128; float g[8]; unpack8(*(const u32x4*)(Gt + (size_t)row * 3072 + br * 1024 + col), g);
                    f32x4 a, b;
#pragma unroll
                    for (int q = 0; q < 4; ++q) { a[q] = g[q] * acc[ai][bj][m][0][q]; b[q] = g[4 + q] * acc[ai][bj][m][1][q]; }
                    bf16* mp = M1 + (size_t)row * 1024 + col;
                    if (br) { float o[8]; unpack8(*(const u32x4*)mp, o);
#pragma unroll
                        for (int q = 0; q < 4; ++q) { a[q] += o[q]; b[q] += o[4 + q]; } }
                    *(u32x4*)mp = pack8(a, b); } }
    }
};
struct EpiResid {
    bf16* xs; const float* ga_l; const float* ga_c;
    __device__ __forceinline__ void operator()(const f32x4 (&acc)[2][2][4][2], const Unit& u, int wr, int wc, int fr, int fq) const {
        EPI_ROWS(u) const float* ga = u.pm == 0 ? ga_c : ga_l;
#pragma unroll
        for (int bj = 0; bj < 2; ++bj) { const int col = u.pn * 256 + cw0 + bj * 128; const f32x4 g0 = *(const f32x4*)(ga + col), g1 = *(const f32x4*)(ga + col + 4);
#pragma unroll
            for (int ai = 0; ai < 2; ++ai)
#pragma unroll
                for (int m = 0; m < 4; ++m) { const int row = row0 + ai * 128 + m * 16; bf16* p = xs + (size_t)row * 1024 + col;
                    float x[8]; unpack8(*(const u32x4*)p, x); const f32x4 x0 = {x[0], x[1], x[2], x[3]}, x1 = {x[4], x[5], x[6], x[7]};
                    *(u32x4*)p = pack8(x0 + g0 * acc[ai][bj][m][0], x1 + g1 * acc[ai][bj][m][1]); } }
    }
};
struct SchedMoeDown {
    TileOrder T; const bf16* A; const bf16* W; const LAS int* tstart;
    __device__ __forceinline__ bool next(int i, Unit& u) const { int pm, pn; if (!T.tile(i, pm, pn)) return false; u.pm = pm; u.pn = pn; u.aux = __builtin_amdgcn_readfirstlane(tstart[pm]); return true; }
    __device__ __forceinline__ const char* abase(const Unit& u) const { return (const char*)(A + (size_t)u.pm * 256 * FF + (u.pn >> 2) * 1408); }
    __device__ __forceinline__ const char* bbase(const Unit& u) const { return (const char*)(W + (size_t)u.aux * D * FF + (size_t)(u.pn & 3) * 256 * FF + (u.pn >> 2) * 1408); }
};
struct SchedMoeDown8 {
    TileOrder T; const bf16* A; const bf16* W; const LAS int* tstart;
    __device__ __forceinline__ bool next(int i, Unit& u) const { int pm, pn; if (!T.tile(i, pm, pn)) return false; u.pm = pm; u.pn = pn; u.aux = __builtin_amdgcn_readfirstlane(tstart[pm]); return true; }
    __device__ __forceinline__ int knt(const Unit& u) const { return (u.pn >> 2) ? 10 : 12; }
    __device__ __forceinline__ const char* abase(const Unit& u) const { return (const char*)(A + (size_t)u.pm * 256 * (FF / 2) + (u.pn >> 2) * 768); }
    __device__ __forceinline__ const char* bbase(const Unit& u) const { return (const char*)(W + (size_t)u.aux * D * (FF / 2) + (size_t)(u.pn & 3) * 256 * (FF / 2) + (u.pn >> 2) * 768); }
};
struct EpiMoeY {
    bf16* Y0; bf16* Y1;
    __device__ __forceinline__ void operator()(const f32x4 (&acc)[2][2][4][2], const Unit& u, int wr, int wc, int fr, int fq) const {
        EPI_ROWS(u) bf16* O = (u.pn >> 2) ? Y1 : Y0; const int colt = (u.pn & 3) * 256;
#pragma unroll
        for (int ai = 0; ai < 2; ++ai)
#pragma unroll
            for (int m = 0; m < 4; ++m) { const int row = row0 + ai * 128 + m * 16;
#pragma unroll
                for (int bj = 0; bj < 2; ++bj) *(u32x4*)(O + (size_t)row * D + colt + cw0 + bj * 128) = pack8(acc[ai][bj][m][0], acc[ai][bj][m][1]); }
    }
};
struct SchedCtxK {
    int nsl, nks, G, c; const bf16* A; size_t astride; const bf16* Bt; int lda, ldb;
    __device__ __forceinline__ bool next(int i, Unit& u) const { const int L = i * G + c; if (L >= 4 * nsl) return false; u.pm = 0; u.pn = L & 3; u.aux = L >> 2; return true; }
    __device__ __forceinline__ const char* abase(const Unit& u) const { return (const char*)(A + (size_t)(u.aux / nks) * astride + (size_t)(u.aux % nks) * 256); }
    __device__ __forceinline__ const char* bbase(const Unit& u) const { return (const char*)(Bt + (size_t)u.pn * 256 * ldb + (size_t)(u.aux % nks) * 256); }
};
struct SchedCtxMerge {
    int G, c; const bf16* O; const bf16* W;
    __device__ __forceinline__ bool next(int i, Unit& u) const { const int L = i * G + c; if (L >= 12) return false; u.pm = 0; u.pn = L & 3; u.aux = L >> 2; return true; }
    __device__ __forceinline__ const char* abase(const Unit& u) const { return (const char*)(O + (size_t)u.aux * NT * 512); }
    __device__ __forceinline__ const char* bbase(const Unit& u) const { return (const char*)(W + ((size_t)u.aux * 1024 + (size_t)u.pn * 256) * 512); }
};
struct EpiMergeCtx {
    const bf16* Gt; bf16* M1C;
    __device__ __forceinline__ void operator()(const f32x4 (&acc)[2][2][4][2], const Unit& u, int wr, int wc, int fr, int fq) const {
        EPI_ROWS(u) const int br = u.aux;
#pragma unroll
        for (int ai = 0; ai < 2; ++ai)
#pragma unroll
            for (int m = 0; m < 4; ++m) { const int row = row0 + ai * 128 + m * 16;
#pragma unroll
                for (int bj = 0; bj < 2; ++bj) { const int col = u.pn * 256 + cw0 + bj * 128; float g[8]; unpack8(*(const u32x4*)(Gt + (size_t)row * 3072 + br * 1024 + col), g);
                    f32x4 a, b;
#pragma unroll
                    for (int q = 0; q < 4; ++q) { a[q] = g[q] * acc[ai][bj][m][0][q]; b[q] = g[4 + q] * acc[ai][bj][m][1][q]; }
                    *(u32x4*)(M1C + ((size_t)br * 256 + row) * 1024 + col) = pack8(a, b); } }
    }
};
struct EpiResidPart {
    float* part; const float* ga;
    __device__ __forceinline__ void operator()(const f32x4 (&acc)[2][2][4][2], const Unit& u, int wr, int wc, int fr, int fq) const {
        EPI_ROWS(u)
#pragma unroll
        for (int bj = 0; bj < 2; ++bj) { const int col = u.pn * 256 + cw0 + bj * 128; const f32x4 g0 = *(const f32x4*)(ga + col), g1 = *(const f32x4*)(ga + col + 4);
#pragma unroll
            for (int ai = 0; ai < 2; ++ai)
#pragma unroll
                for (int m = 0; m < 4; ++m) { const int row = row0 + ai * 128 + m * 16; float* p = part + ((size_t)u.aux * 256 + row) * 1024 + col;
                    *(f32x4*)p = g0 * acc[ai][bj][m][0]; *(f32x4*)(p + 4) = g1 * acc[ai][bj][m][1]; } }
    }
};
struct EpiUp8 {
    unsigned char* Act;
    __device__ __forceinline__ void operator()(const f32x4 (&acc)[2][2][4][2], const Unit& u, int wr, int wc, int fr, int fq) const {
        EPI_ROWS(u)
#pragma unroll
        for (int ai = 0; ai < 2; ++ai)
#pragma unroll
            for (int m = 0; m < 4; ++m) { const int row = row0 + ai * 128 + m * 16; f32x4 a, b;
#pragma unroll
                for (int q = 0; q < 4; ++q) { a[q] = 4.f * fsilu(acc[ai][0][m][0][q]) * acc[ai][1][m][0][q]; b[q] = 4.f * fsilu(acc[ai][0][m][1][q]) * acc[ai][1][m][1][q]; }
                u32x2 w; w.x = (unsigned)__builtin_amdgcn_cvt_pk_fp8_f32(a[2], a[3], __builtin_amdgcn_cvt_pk_fp8_f32(a[0], a[1], 0, false), true);
                w.y = (unsigned)__builtin_amdgcn_cvt_pk_fp8_f32(b[2], b[3], __builtin_amdgcn_cvt_pk_fp8_f32(b[0], b[1], 0, false), true);
                *(u32x2*)(Act + (size_t)row * FF + u.pn * 128 + cw0) = w; }
    }
};
struct EpiUp {
    bf16* Act;
    __device__ __forceinline__ void operator()(const f32x4 (&acc)[2][2][4][2], const Unit& u, int wr, int wc, int fr, int fq) const {
        EPI_ROWS(u)
#pragma unroll
        for (int ai = 0; ai < 2; ++ai)
#pragma unroll
            for (int m = 0; m < 4; ++m) { const int row = row0 + ai * 128 + m * 16; f32x4 a, b;
#pragma unroll
                for (int q = 0; q < 4; ++q) { a[q] = fsilu(acc[ai][0][m][0][q]) * acc[ai][1][m][0][q]; b[q] = fsilu(acc[ai][0][m][1][q]) * acc[ai][1][m][1][q]; }
                *(u32x4*)(Act + (size_t)row * FF + u.pn * 128 + cw0) = pack8(a, b); }
    }
};
}

namespace att {
constexpr float THR = 8.f;
__device__ __forceinline__ int crow(int r, int hi) { return (r & 3) + 8 * (r >> 2) + 4 * hi; }
template <int DQK> struct Cst { static constexpr float SCALE = DQK == 96 ? 0.10206207261596575f : 0.125f; static constexpr float C = SCALE * 1.4426950408889634f; };

__device__ __forceinline__ void partialSM(f32x16& p0) {
#pragma unroll
    for (int r = 0; r < 16; ++r) p0[r] = __builtin_amdgcn_exp2f(p0[r]);
}
__device__ __forceinline__ void finishSM(f32x16& p0, f32x16& p1, float& l_reg, bf16x8& pa0, bf16x8& pa1, bf16x8& pa2, bf16x8& pa3) {
#pragma unroll
    for (int r = 0; r < 16; ++r) p1[r] = __builtin_amdgcn_exp2f(p1[r]);
    float ps = 0;
#pragma unroll
    for (int r = 0; r < 16; ++r) ps += p0[r];
#pragma unroll
    for (int r = 0; r < 16; ++r) ps += p1[r];
    { auto rr = __builtin_amdgcn_permlane32_swap(__float_as_uint(ps), __float_as_uint(ps), false, false);
      ps = __uint_as_float(rr[0]) + __uint_as_float(rr[1]); }
    l_reg += ps;
#define PK4(P, BASE, OUT) do { unsigned a0 = cvtpk(P[BASE + 0], P[BASE + 1]), a1 = cvtpk(P[BASE + 2], P[BASE + 3]);   \
    unsigned b0 = cvtpk(P[BASE + 4], P[BASE + 5]), b1 = cvtpk(P[BASE + 6], P[BASE + 7]);                              \
    auto r0 = __builtin_amdgcn_permlane32_swap(a0, b0, false, false); auto r1 = __builtin_amdgcn_permlane32_swap(a1, b1, false, false); \
    u32x4 w = {r0[0], r1[0], r0[1], r1[1]}; OUT = *reinterpret_cast<bf16x8*>(&w); } while (0)
    PK4(p0, 0, pa0); PK4(p0, 8, pa1); PK4(p1, 0, pa2); PK4(p1, 8, pa3);
#undef PK4
}
__device__ __forceinline__ int v_st(int k, int c) { const int kk = (k & ~0xC) | ((k & 4) << 1) | ((k & 8) >> 1); return ((kk >> 3) * 2 + (c >> 5)) * 512 + ((kk & 7) * 32 + (c & 31)) * 2; }
__device__ __forceinline__ int v_rd_base(int lane) { return ((lane & 3) << 3) | (((lane >> 2) & 3) << 6) | (((lane >> 4) & 1) << 5) | (((lane >> 5) & 1) << 8); }
constexpr int v_rd_off(int d0, int ks, int half) { return d0 * 512 + ks * 2048 + half * 1024; }
template <int OFF> __device__ __forceinline__ s16x4 tr_read(int vb) {
    s16x4 r; asm volatile("ds_read_b64_tr_b16 %0, %1 offset:%2" : "=&v"(r) : "v"(vb), "i"(OFF) : "memory"); return r;
}
template <int D0> __device__ __forceinline__ void pv_one(f32x16& od, int vb, bf16x8 pa0, bf16x8 pa1, bf16x8 pa2, bf16x8 pa3) {
    const s16x4 l0 = tr_read<v_rd_off(D0, 0, 0)>(vb), h0 = tr_read<v_rd_off(D0, 0, 1)>(vb), l1 = tr_read<v_rd_off(D0, 1, 0)>(vb), h1 = tr_read<v_rd_off(D0, 1, 1)>(vb);
    const s16x4 l2 = tr_read<v_rd_off(D0, 2, 0)>(vb), h2 = tr_read<v_rd_off(D0, 2, 1)>(vb), l3 = tr_read<v_rd_off(D0, 3, 0)>(vb), h3 = tr_read<v_rd_off(D0, 3, 1)>(vb);
    asm volatile("s_waitcnt lgkmcnt(0)" ::: "memory"); SBAR();
#define PK(L, H) (bf16x8){L[0], L[1], L[2], L[3], H[0], H[1], H[2], H[3]}
    od = __builtin_amdgcn_mfma_f32_32x32x16_bf16(pa0, PK(l0, h0), od, 0, 0, 0);
    od = __builtin_amdgcn_mfma_f32_32x32x16_bf16(pa1, PK(l1, h1), od, 0, 0, 0);
    od = __builtin_amdgcn_mfma_f32_32x32x16_bf16(pa2, PK(l2, h2), od, 0, 0, 0);
    od = __builtin_amdgcn_mfma_f32_32x32x16_bf16(pa3, PK(l3, h3), od, 0, 0, 0);
#undef PK
}

constexpr float V8_OFF = -3.0f;
__device__ __forceinline__ int v8_pos(int k) { const int kb = k >> 5, kk = k & 31; return 32 * ((kk >> 2) & 1) + 16 * kb + 4 * (kk >> 3) + (kk & 3); }
__device__ __forceinline__ int v8_byte(int dim, int pos) { return dim * 64 + ((((pos >> 4) ^ (dim >> 2)) & 3) << 4) + (pos & 15); }
__device__ __forceinline__ void finishSM8(f32x16& p0, f32x16& p1, i32x8& pk) {
#pragma unroll
    for (int r = 0; r < 16; ++r) p1[r] = __builtin_amdgcn_exp2f(p1[r]);
#pragma unroll
    for (int w = 0; w < 4; ++w) { int a = __builtin_amdgcn_cvt_pk_fp8_f32(p0[4 * w], p0[4 * w + 1], 0, false); pk[w] = __builtin_amdgcn_cvt_pk_fp8_f32(p0[4 * w + 2], p0[4 * w + 3], a, true);
                                  int b = __builtin_amdgcn_cvt_pk_fp8_f32(p1[4 * w], p1[4 * w + 1], 0, false); pk[4 + w] = __builtin_amdgcn_cvt_pk_fp8_f32(p1[4 * w + 2], p1[4 * w + 3], b, true); }
}
__device__ __forceinline__ i32x8 ld32(const LAS unsigned char* p) { const u32x4 lo = *(const LAS u32x4*)p, hi4 = *(const LAS u32x4*)(p + 16);
    return (i32x8){(int)lo[0], (int)lo[1], (int)lo[2], (int)lo[3], (int)hi4[0], (int)hi4[1], (int)hi4[2], (int)hi4[3]}; }
__device__ __forceinline__ void pv8_sum(f32x16& os, const i32x8 pk) {
    const i32x8 ones = {0x38383838, 0x38383838, 0x38383838, 0x38383838, 0x38383838, 0x38383838, 0x38383838, 0x38383838};
    os = __builtin_amdgcn_mfma_scale_f32_32x32x64_f8f6f4(pk, ones, os, 0, 0, 0, 0x7F7F7F7F, 0, 0x7F7F7F7F);
}
template <int D0> __device__ __forceinline__ void pv8_one(f32x16& od, const LAS unsigned char* vt, int r32, int hi, const i32x8 pk) {
    const LAS unsigned char* row = vt + (32 * D0 + r32) * 64; const int sw = (r32 >> 2) & 3;
    const u32x4 lo = *(const LAS u32x4*)(row + (((2 * hi) ^ sw) << 4)), hi4 = *(const LAS u32x4*)(row + (((2 * hi + 1) ^ sw) << 4));
    const i32x8 vb = {(int)lo[0], (int)lo[1], (int)lo[2], (int)lo[3], (int)hi4[0], (int)hi4[1], (int)hi4[2], (int)hi4[3]};
    od = __builtin_amdgcn_mfma_scale_f32_32x32x64_f8f6f4(pk, vb, od, 0, 0, 0, 0x7F7F7F7F, 0, 0x7F7F7F7F);
}

template <int DQK, bool NA, bool V8 = false>
__device__ __forceinline__ void attn_unit(const bf16* __restrict__ Qb, const int ldq, const bf16* __restrict__ Kh, const int ldk, const bf16* __restrict__ Vh, const int ldv,
                                          bf16* __restrict__ Ob, const int NT_, const int gr_lo, const int gr_hi, const int qb, const float* __restrict__ rpb, LAS unsigned char* lds) {
    constexpr int ND = DQK / 16, KST = DQK * 2 + 16, KCH = DQK / 8, SHK = 64 * KST, SHV = 64 * 64 * 2;
    constexpr float SCALE = Cst<DQK>::SCALE;
    int tid_ = threadIdx.x; asm volatile("" : "+v"(tid_));
    const int tid = tid_, wid = __builtin_amdgcn_readfirstlane(tid >> 6), lane = tid & 63, r32 = lane & 31, hi = lane >> 5;
    constexpr int NSLOT = V8 ? 4 : 2;
    LAS unsigned char* K_lds = lds; LAS unsigned char* V_lds = lds + NSLOT * SHK;
    LAS float* wsf = (LAS float*)(lds + NSLOT * SHK + NSLOT * SHV) + wid * 64; LAS float* li_l = wsf;
    LAS float* btab = (LAS float*)(lds + NSLOT * SHK + NSLOT * SHV + 2048 + 256);
    float l_reg = 0.f; f32x16 o[2] = {}, osum = {}; bf16x8 qr[ND]; i32x8 q8[2];
    if constexpr (V8) {
        const bf16* Qw = Qb + (size_t)(wid * 32 + r32) * ldq;
#pragma unroll
        for (int m = 0; m < 2; ++m)
#pragma unroll
            for (int c = 0; c < 4; ++c) { float f[8]; unpack8(*(const u32x4*)(Qw + (m == 0 ? 32 * hi : 64) + c * 8), f);
                const int w0 = __builtin_amdgcn_cvt_pk_fp8_f32(f[2], f[3], __builtin_amdgcn_cvt_pk_fp8_f32(f[0], f[1], 0, false), true), w1 = __builtin_amdgcn_cvt_pk_fp8_f32(f[6], f[7], __builtin_amdgcn_cvt_pk_fp8_f32(f[4], f[5], 0, false), true);
                q8[m][2 * c] = (m == 1 && hi) ? 0 : w0; q8[m][2 * c + 1] = (m == 1 && hi) ? 0 : w1; }
    } else { const bf16* Qw = Qb + (size_t)(wid * 32 + r32) * ldq + hi * 8;
#pragma unroll
      for (int d0 = 0; d0 < ND; ++d0) qr[d0] = *(const bf16x8*)(Qw + d0 * 16); }
    const int kc8 = tid < 448 ? tid : tid - 64;
    const int ka0 = r32 * 112 + 32 * hi, ka1 = hi ? 7168 : r32 * 112 + 64, ka1b = hi ? 7168 : (32 + r32) * 112 + 64;
    if constexpr (V8) { if (tid < 8) { *(LAS u32x4*)(lds + (tid >> 1) * SHK + 7168 + (tid & 1) * 16) = (u32x4){0u, 0u, 0u, 0u}; } }
    const int id0 = tid, rk0 = id0 / KCH, ck0 = id0 % KCH;
    const int id1 = 512 + (tid & 255), rk1 = id1 / KCH, ck1 = id1 % KCH;
    const int rv = tid >> 3, cv = tid & 7;
    const int kst0 = rk0 * KST + ck0 * 16, kst1 = rk1 * KST + ck1 * 16, vst = v_st(rv, cv * 8);
    const int vb0 = (int)(uintptr_t)V_lds + v_rd_base(lane);
    struct { bf16x8 k0, k1, v; u32x2 v8; } sr_[2];
    const int rqw = 4 * qb + (wid >> 1), cq = 32 * (wid & 1) + r32;
    const int r0w = rqw - 4 < 0 ? 0 : (rqw - 4 > 248 ? 248 : rqw - 4);
    const int c0 = cq - 8 < 0 ? 0 : (cq - 8 > 48 ? 48 : cq - 8);
    if constexpr (NA) { for (int i = tid; i < 465; i += 512) btab[i] = rpb[i] * 1.4426950408889634f; }
#define KB_OF(j) (NA ? ((j) < 4 ? 64 * (j) : NC + 64 * (gr_lo + (j) - 4 > gr_hi ? gr_hi : gr_lo + (j) - 4)) : 64 * (j))
#define SLOAD(i, j) do { const int kb_ = KB_OF(j); if constexpr (V8) sr_[i].k0 = *(const bf16x8*)((const unsigned char*)Kh + (size_t)(kb_ >> 6) * 7168 + kc8 * 16); else { sr_[i].k0 = *(const bf16x8*)(Kh + (size_t)(kb_ + rk0) * ldk + ck0 * 8); \
        if constexpr (DQK == 96) sr_[i].k1 = *(const bf16x8*)(Kh + (size_t)(kb_ + rk1) * ldk + ck1 * 8); } \
        if constexpr (V8) sr_[i].v8 = *(const u32x2*)((const unsigned char*)Vh + (size_t)(kb_ >> 6) * 4096 + tid * 8); else sr_[i].v = *(const bf16x8*)(Vh + (size_t)(kb_ + rv) * ldv + cv * 8); } while (0)
#define SWRITE(b, i) do { if constexpr (V8) *(LAS bf16x8*)(K_lds + (b) * SHK + kc8 * 16) = sr_[i].k0; else { *(LAS bf16x8*)(K_lds + (b) * SHK + kst0) = sr_[i].k0; if constexpr (DQK == 96) *(LAS bf16x8*)(K_lds + (b) * SHK + kst1) = sr_[i].k1; } \
        if constexpr (V8) *(LAS u32x2*)(V_lds + (b) * SHV + tid * 8) = sr_[i].v8; else *(LAS bf16x8*)(V_lds + (b) * SHV + vst) = sr_[i].v; } while (0)
#define SWAIT() do { if constexpr (DQK == 96 && !V8) asm volatile("s_waitcnt vmcnt(3)" ::: "memory"); else asm volatile("s_waitcnt vmcnt(2)" ::: "memory"); } while (0)
#define QKT(P0, P1, V, b, j) do { V = true; int gk_ = 0; if constexpr (NA) { if ((j) >= 4) { gk_ = gr_lo + (j) - 4; V = (gk_ <= gr_hi) && (gk_ >= r0w) && (gk_ <= r0w + 7); } } \
        if (V) { if constexpr (V8) { _Pragma("unroll") for (int r_ = 0; r_ < 16; ++r_) { P0[r_] = V8_OFF; P1[r_] = V8_OFF; } } else { P0 = f32x16{}; P1 = f32x16{}; } const LAS unsigned char* Ks_ = K_lds + (b) * SHK; \
            if constexpr (V8) { const i32x8 a00 = ld32(Ks_ + ka0), a01 = ld32(Ks_ + ka1), a10 = ld32(Ks_ + 3584 + ka0), a11 = ld32(Ks_ + ka1b); \
                P0 = __builtin_amdgcn_mfma_scale_f32_32x32x64_f8f6f4(a00, q8[0], P0, 0, 0, 0, 0x7F7F7F7F, 0, 0x7F7F7F7F); P1 = __builtin_amdgcn_mfma_scale_f32_32x32x64_f8f6f4(a10, q8[0], P1, 0, 0, 0, 0x7F7F7F7F, 0, 0x7F7F7F7F); \
                P0 = __builtin_amdgcn_mfma_scale_f32_32x32x64_f8f6f4(a01, q8[1], P0, 0, 0, 0, 0x7F7F7F7F, 0, 0x7F7F7F7F); P1 = __builtin_amdgcn_mfma_scale_f32_32x32x64_f8f6f4(a11, q8[1], P1, 0, 0, 0, 0x7F7F7F7F, 0, 0x7F7F7F7F); } else \
            _Pragma("unroll") for (int d0 = 0; d0 < ND; ++d0) { const int cb = (d0 * 16 + hi * 8) * 2; \
                const bf16x8 b0 = *(const LAS bf16x8*)(Ks_ + r32 * KST + cb); const bf16x8 b1 = *(const LAS bf16x8*)(Ks_ + (32 + r32) * KST + cb); \
                P0 = __builtin_amdgcn_mfma_f32_32x32x16_bf16(b0, qr[d0], P0, 0, 0, 0); P1 = __builtin_amdgcn_mfma_f32_32x32x16_bf16(b1, qr[d0], P1, 0, 0, 0); } \
            if constexpr (NA) { if ((j) >= 4) { const LAS float* bb_ = btab + (gk_ - rqw + 7) * 31 + (15 - cq) + 4 * hi; \
                _Pragma("unroll") for (int r = 0; r < 16; ++r) { const int ckc = (r & 3) + 8 * (r >> 2); const int ck = ckc + 4 * hi; \
                    P0[r] = (ck >= c0 && ck <= c0 + 15) ? P0[r] + bb_[ckc] : -1e30f; P1[r] = (ck + 32 >= c0 && ck + 32 <= c0 + 15) ? P1[r] + bb_[ckc + 32] : -1e30f; } } } } } while (0)
#define PSM(P0, V) do { if (V) partialSM(P0); } while (0)
#define FSM(P0, P1) do { if constexpr (V8) finishSM8(P0, P1, pk8); else finishSM(P0, P1, l_reg, pa0, pa1, pa2, pa3); } while (0)
#define PV(vbuf) do { if constexpr (V8) { pv8_one<0>(o[0], V_lds + (vbuf) * SHV, r32, hi, pk8); pv8_one<1>(o[1], V_lds + (vbuf) * SHV, r32, hi, pk8); pv8_sum(osum, pk8); } \
        else { pv_one<0>(o[0], vb0 + (vbuf) * SHV, pa0, pa1, pa2, pa3); pv_one<1>(o[1], vb0 + (vbuf) * SHV, pa0, pa1, pa2, pa3); } } while (0)
#define FSM_PV(P0, P1, V, vbuf) do { if (V) { FSM(P0, P1); SBAR(); PV(vbuf); } } while (0)
    f32x16 pA0, pA1, pB0, pB1; bf16x8 pa0, pa1, pa2, pa3; i32x8 pk8; bool vA, vB; const int NTl = NT_;
    if constexpr (V8) {
        const int NP = NTl >> 1;
        SLOAD(0, 0); SLOAD(1, 1); VM_WAIT(); SWRITE(0, 0); SWRITE(1, 1); __syncthreads();
#define PAIR(sb, nb, pp) do { const int jn_ = ((pp) + 1 < NP ? (pp) + 1 : (pp)) * 2; SLOAD(0, jn_); SLOAD(1, jn_ + 1); SBAR(); \
            QKT(pA0, pA1, vA, sb, 0); PSM(pA0, vA); SBAR(); \
            QKT(pB0, pB1, vB, (sb) + 1, 0); FSM(pA0, pA1); SBAR(); \
            PV(sb); PSM(pB0, vB); SBAR(); \
            FSM(pB0, pB1); SBAR(); PV((sb) + 1); \
            asm volatile("s_waitcnt vmcnt(0)" ::: "memory"); SWRITE(nb, 0); SWRITE((nb) + 1, 1); __syncthreads(); } while (0)
        for (int p = 0; p < NP; p += 2) { PAIR(0, 2, p); PAIR(2, 0, p + 1); }
#undef PAIR
    } else {
    SLOAD(0, 0); VM_WAIT(); SWRITE(0, 0); __syncthreads();
    QKT(pA0, pA1, vA, 0, 0); PSM(pA0, vA);
    SLOAD(1, 1); SLOAD(0, (2 < NTl ? 2 : NTl - 1));
    SWAIT(); SWRITE(1, 1); __syncthreads();
    for (int j = 1; j + 1 < NTl; j += 2) {
        SBAR(); QKT(pB0, pB1, vB, 1, j);
        if (vA) { FSM(pA0, pA1); } SBAR();
        SLOAD(1, j + 2); SBAR();
        if (vA) { PV(0); }
        PSM(pB0, vB);
        __syncthreads(); SWAIT(); SWRITE(0, 0);
        __syncthreads();
        SBAR(); QKT(pA0, pA1, vA, 0, j + 1);
        if (vB) { FSM(pB0, pB1); } SBAR();
        SLOAD(0, (j + 3 < NTl ? j + 3 : NTl - 1)); SBAR();
        if (vB) { PV(1); }
        PSM(pA0, vA);
        __syncthreads(); SWAIT(); SWRITE(1, 1);
        __syncthreads();
    }
    SBAR(); QKT(pB0, pB1, vB, 1, NTl - 1);
    FSM_PV(pA0, pA1, vA, 0); PSM(pB0, vB);
    FSM_PV(pB0, pB1, vB, 1);
    }
    if constexpr (!V8) { if (hi == 0) li_l[r32] = l_reg; asm volatile("s_waitcnt lgkmcnt(0)" ::: "memory"); }
    bf16* Ow = Ob + (size_t)(wid * 32) * 512;
#pragma unroll
    for (int r = 0; r < 16; ++r) { const int orow = crow(r, hi); float rl; if constexpr (V8) rl = __builtin_amdgcn_rcpf(osum[r]); else rl = __builtin_amdgcn_rcpf(li_l[orow]);
#pragma unroll
        for (int d0 = 0; d0 < 2; ++d0) Ow[(size_t)orow * 512 + d0 * 32 + r32] = f2bf(o[d0][r] * rl); }
    __syncthreads();
#undef KB_OF
#undef SLOAD
#undef SWRITE
#undef SWAIT
#undef QKT
#undef PSM
#undef FSM_PV
#undef FSM
#undef PV
}
}

struct Args { const float* in[39]; float* out; unsigned char* ws; int ph_lo, ph_hi; };
struct Frame {
    LAS unsigned char* lds; unsigned char* ws; float* out;
    int tid, lane, wave, vcu, G, gw, NGW;
};
#define WSP(T, off) ((T*)(F.ws + (off)))
constexpr int INTAB_OFF = RING_BYTES + 1024;
__device__ __forceinline__ const float* inp(const Frame& F, int i) {
    const LAS unsigned* t = (const LAS unsigned*)(F.lds + INTAB_OFF) + 2 * i;
    const unsigned lo = __builtin_amdgcn_readfirstlane(t[0]), hi = __builtin_amdgcn_readfirstlane(t[1]);
    return (const float*)(const GAS float*)(((unsigned long long)hi << 32) | lo);
}

#ifndef WIN8_FROM
#define WIN8_FROM 4
#endif
struct CvtItem { const float* src; bf16* dst; const float* kscale; int ldw, ldt, k0; bool zero; bool f8; };
__device__ __forceinline__ void cvt_load(const CvtItem& d, f32x4 (&v)[8], int lane) {
#pragma unroll
    for (int i = 0; i < 8; ++i) { const int kk = 8 * i + (lane >> 3), n4 = (lane & 7) * 4; v[i] = d.zero ? (f32x4){0.f, 0.f, 0.f, 0.f} : __builtin_nontemporal_load((const f32x4*)(d.src + (size_t)kk * d.ldw + n4)); }
}
__device__ __forceinline__ void cvt_store(const CvtItem& d, f32x4 (&v)[8], LAS float* scr, int lane) {
#pragma unroll
    for (int i = 0; i < 8; ++i) { const int kk = 8 * i + (lane >> 3), n4 = (lane & 7) * 4; f32x4 x = v[i]; if (d.kscale) x *= d.kscale[d.k0 + kk];
        scr[kk * 33 + n4] = x[0]; scr[kk * 33 + n4 + 1] = x[1]; scr[kk * 33 + n4 + 2] = x[2]; scr[kk * 33 + n4 + 3] = x[3]; }
    LDS_WAIT(); asm volatile("" ::: "memory");
    const int c = lane & 7;
#pragma unroll
    for (int j = 0; j < 4; ++j) { const int n = (lane >> 3) + 8 * j; const LAS float* s = scr + (8 * c) * 33 + n;
        if (d.f8) { u32x2 o;
            o.x = (unsigned)__builtin_amdgcn_cvt_pk_fp8_f32(32.f * s[2 * 33], 32.f * s[3 * 33], __builtin_amdgcn_cvt_pk_fp8_f32(32.f * s[0 * 33], 32.f * s[1 * 33], 0, false), true);
            o.y = (unsigned)__builtin_amdgcn_cvt_pk_fp8_f32(32.f * s[6 * 33], 32.f * s[7 * 33], __builtin_amdgcn_cvt_pk_fp8_f32(32.f * s[4 * 33], 32.f * s[5 * 33], 0, false), true);
            *(u32x2*)(d.dst + (size_t)n * d.ldt + 4 * c) = o; }
        else { u32x4 o; o.x = cvtpk(s[0 * 33], s[1 * 33]); o.y = cvtpk(s[2 * 33], s[3 * 33]); o.z = cvtpk(s[4 * 33], s[5 * 33]); o.w = cvtpk(s[6 * 33], s[7 * 33]);
        *(u32x4*)(d.dst + (size_t)n * d.ldt + 8 * c) = o; } }
    LDS_WAIT(); asm volatile("" ::: "memory");
}
__device__ __forceinline__ CvtItem cvt_decode(Frame& F, int l, int it) {
#ifdef DBG_CONV8
    const int j = 0; const bool moe = (l & 1);
#else
    const int j = l >> 1; const bool moe = (l & 1) && !DBG_NOMOE;
#endif
    constexpr int I_WIN = (DINP / 32) * (D / 64), I_UQ = (768 / 32) * (384 / 64), I_UKV = (1024 / 32) * (256 / 64), I_GLU = (512 / 32) * (512 / 64), I_BR = (1024 / 32) * (512 / 64), I_OUT = (1024 / 32) * (1024 / 64);
    constexpr int I_GU = (FF2 / 32) * (D / 64), I_DN = (1024 / 32) * (FF / 64);
    CvtItem d; d.kscale = nullptr; d.zero = false; d.f8 = false; int r = it;
#define CVT_SET(W, LDW, C0, K0, WT, R0, LDT) do { d.ldw = (LDW); d.ldt = (LDT); d.k0 = (K0); d.src = (W) + (size_t)(K0) * (LDW) + (C0); d.dst = (WT) + (size_t)(R0) * (LDT) + (K0); } while (0)
    if (r < I_WIN) { const int nb = r % (DINP / 32), kb = r / (DINP / 32); const int n0 = nb * 32; const bool z = (n0 >= 672 && n0 < 768); const int c0 = n0 < 672 ? n0 : n0 - 96;
        CVT_SET(inp(F, 8) + (size_t)l * D * 5792, 5792, z ? 0 : c0, kb * 64, WSP(bf16, WS_WIN), n0, D); d.zero = z;
        if (l >= WIN8_FROM) { d.f8 = true; d.ldt = D / 2; d.dst = WSP(bf16, WS_WIN) + (size_t)n0 * (D / 2) + (kb * 64) / 2; }
        return d; } r -= I_WIN;
    if (r < I_UQ) { const int nb = r % 24, kb = r / 24; CVT_SET(inp(F, 11) + (size_t)l * 384 * 768, 768, nb * 32, kb * 64, WSP(bf16, WS_WUQ), nb * 32, 384); d.kscale = inp(F, 9) + l * 384; return d; } r -= I_UQ;
    if (r < I_UKV) { const int nb = r % 32, kb = r / 32; CVT_SET(inp(F, 12) + (size_t)l * 256 * 1024, 1024, nb * 32, kb * 64, WSP(bf16, WS_WUKV), nb * 32, 256); d.kscale = inp(F, 10) + l * 256; return d; } r -= I_UKV;
    if (r < I_GLU) { const int nb = r % 16, kb = r / 16; CVT_SET(inp(F, 26) + (size_t)l * 512 * 512, 512, nb * 32, kb * 64, WSP(bf16, WS_WGLU), nb * 32, 512); return d; } r -= I_GLU;
    if (r < 3 * I_BR) { const int br = r / I_BR, q = r % I_BR, nb = q % 32, kb = q / 32; CVT_SET(inp(F, 28 + br) + (size_t)l * 512 * 1024, 1024, nb * 32, kb * 64, WSP(bf16, WS_WBR) + (size_t)br * 1024 * 512, nb * 32, 512); return d; } r -= 3 * I_BR;
    if (r < I_OUT) { const int nb = r % 32, kb = r / 32; CVT_SET(inp(F, 31) + (size_t)l * D * D, D, nb * 32, kb * 64, WSP(bf16, WS_WOUT), nb * 32, D); return d; } r -= I_OUT;
    const int e = r / (I_GU + I_DN); r = r % (I_GU + I_DN);
    const size_t eo = moe ? ((size_t)j * NEXP + e) : (size_t)j;
    if (r < I_GU) { const int nb = r % (FF2 / 32), kb = r / (FF2 / 32); const int n0 = nb * 32, t = n0 >> 8, i = n0 & 255; const bool up = i >= 128; const int c0 = t * 128 + (i & 127);
        const float* src = (moe ? (up ? inp(F, 37) : inp(F, 36)) : (up ? inp(F, 33) : inp(F, 32))) + eo * (size_t)D * FF;
        CVT_SET(src, FF, c0, kb * 64, WSP(bf16, WS_WGU) + (size_t)e * FF2 * D, n0, D);
        if (moe) { d.f8 = true; d.ldt = D / 2; d.dst = WSP(bf16, WS_WGU) + (size_t)e * FF2 * D / 2 + (size_t)n0 * (D / 2) + (kb * 64) / 2; }
        return d; } r -= I_GU;
    { const int nb = r % 32, kb = r / 32; const float* src = (moe ? inp(F, 38) : inp(F, 34)) + eo * (size_t)FF * D;
      CVT_SET(src, D, nb * 32, kb * 64, WSP(bf16, WS_WD) + (size_t)e * D * FF, nb * 32, FF);
      if (moe) { d.f8 = true; d.ldt = FF / 2; d.dst = WSP(bf16, WS_WD) + (size_t)e * D * (FF / 2) + (size_t)(nb * 32) * (FF / 2) + (kb * 64) / 2; }
      return d; }
#undef CVT_SET
}
constexpr int CVT_NONFFN = (DINP / 32) * (D / 64) + (768 / 32) * (384 / 64) + (1024 / 32) * (256 / 64) + (512 / 32) * (512 / 64) + 3 * (1024 / 32) * (512 / 64) + (1024 / 32) * (1024 / 64);
constexpr int CVT_FFN = (FF2 / 32) * (D / 64) + (1024 / 32) * (FF / 64);
#define CW_CVT 24576
__device__ __forceinline__ void convert_items(Frame& F, int l, int first, int end, int step) {
    LAS float* scr = (LAS float*)(F.lds + F.wave * 16384);
    const int total = end;
    int it = first; if (it >= total) return;
    CvtItem cur = cvt_decode(F, l, it); f32x4 va[8], vb[8]; cvt_load(cur, va, F.lane);
    for (;;) {
        const int itn = it + step; const bool more = itn < total; CvtItem nxt = cur;
        if (more) { nxt = cvt_decode(F, l, itn); cvt_load(nxt, vb, F.lane); }
        cvt_store(cur, va, scr, F.lane);
        if (!more) break;
#pragma unroll
        for (int i = 0; i < 8; ++i) va[i] = vb[i];
        cur = nxt; it = itn;
    }
}

__device__ __forceinline__ void prologue0(Frame& F) {
    if (F.vcu == 0 && F.tid < 16) WSP(unsigned, WS_CTL)[CW_CNT + (F.tid >> 3) * 8 * 64 + (F.tid & 7) * 64] = 0u;
    LAS float* red = (LAS float*)F.lds;
    LAS float* sv = (LAS float*)(F.lds + 16384);
    for (int i = F.tid; i < D; i += 512) { sv[i] = fsilu(inp(F, 1)[i]); sv[D + i] = fsilu(inp(F, 3)[i]); }
    __syncthreads();
    for (int it = F.vcu; it < DEPTH * 48; it += F.G) {
        const int l = it / 48, jb = it % 48, cq = F.lane & 31, kh = F.lane >> 5; const int j0 = jb * 128 + cq * 4;
        const float* W = inp(F, 4) + (size_t)l * D * 6144;
        f32x4 accl = {0.f, 0.f, 0.f, 0.f}, accc = {0.f, 0.f, 0.f, 0.f};
#pragma unroll 8
        for (int i = 0; i < 64; ++i) { const int k = F.wave * 128 + 2 * i + kh; const f32x4 w = *(const f32x4*)(W + (size_t)k * 6144 + j0); accl += w * sv[k]; accc += w * sv[D + k]; }
#pragma unroll
        for (int q = 0; q < 4; ++q) { accl[q] += __shfl_xor(accl[q], 32); accc[q] += __shfl_xor(accc[q], 32); }
        if (kh == 0) { *(LAS f32x4*)(red + (F.wave * 2 + 0) * 128 + cq * 4) = accl; *(LAS f32x4*)(red + (F.wave * 2 + 1) * 128 + cq * 4) = accc; }
        __syncthreads();
        if (F.tid < 256) { const int w = F.tid >> 7, jj = F.tid & 127; float sacc = 0.f;
#pragma unroll
          for (int q = 0; q < 8; ++q) sacc += red[(q * 2 + w) * 128 + jj];
          WSP(float, WS_MOD)[((size_t)l * 2 + w) * 6144 + jb * 128 + jj] = sacc + inp(F, 5)[l * 6144 + jb * 128 + jj]; }
        __syncthreads();
    }
    for (int idx = F.vcu * 512 + F.tid; idx < NL * 16; idx += F.G * 512) { const int n = idx >> 4, i = idx & 15; const float pos = (float)(i < 8 ? (n >> 6) : (n & 63));
        const float inv = __expf(-(float)(i & 7) * (9.210340371976184f / 8.f)); float s, c; sincos_rad(pos * inv, s, c);
        WSP(float, WS_ROPE)[idx] = c; WSP(float, WS_ROPE)[NL * 16 + idx] = s; }
    for (int idx = F.vcu * 512 + F.tid; idx < DEPTH * 2 * 32 * 64; idx += F.G * 512) {
        const int g = (idx >> 6) & 31, ld = idx >> 11;
        const float are = inp(F, 18)[idx], aim = inp(F, 19)[idx], dt = __expf(inp(F, 20)[ld * 32 + g]);
        const float er = __expf(are * dt); float sn, cs; sincos_rad(aim * dt, sn, cs);
        const float abr = er * cs, abi = er * sn;
        const float x = abr - 1.f, y = abi, den = 1.f / (are * are + aim * aim);
        const float cr = (x * are + y * aim) * den, ci = (y * are - x * aim) * den;
        float* P = WSP(float, WS_S5P) + (size_t)idx * 100;
        float pr = 1.f, pi = 0.f;
        for (int t = 0; t <= 32; ++t) { P[2 * t] = pr; P[2 * t + 1] = pi; const float nr = pr * abr - pi * abi, ni = pr * abi + pi * abr; pr = nr; pi = ni; }
        const float* bre = inp(F, 21) + (size_t)idx * 16; const float* bim = inp(F, 22) + (size_t)idx * 16;
        for (int c = 0; c < 16; ++c) { const float br = bre[c], bi = bim[c]; P[66 + 2 * c] = cr * br - ci * bi; P[67 + 2 * c] = cr * bi + ci * br; }
    }
}
__device__ __forceinline__ void prologue1(Frame& F) {
    LAS float* Pl = (LAS float*)F.lds;
    LAS float* Cr = Pl + 6400; LAS float* Ci = Cr + 1024;
    for (int ldg = F.vcu; ldg < DEPTH * 2 * 32; ldg += F.G) {
        __syncthreads();
        const float* P = WSP(float, WS_S5P) + (size_t)ldg * 6400; const float* cre = inp(F, 23) + (size_t)ldg * 1024; const float* cim = inp(F, 24) + (size_t)ldg * 1024;
        for (int i = F.tid; i < 6400; i += 512) Pl[i] = P[i];
        for (int i = F.tid; i < 1024; i += 512) { Cr[i] = cre[i]; Ci[i] = cim[i]; }
        __syncthreads();
        for (int e = F.tid; e < 32 * 256; e += 512) { const int cp = e & 15, c = (e >> 4) & 15, tau = e >> 8; float s = 0.f;
#pragma unroll 8
            for (int p = 0; p < 64; ++p) { const LAS float* Pp = Pl + p * 100; const float ar = Pp[2 * tau], ai = Pp[2 * tau + 1], br = Pp[66 + 2 * cp], bi = Pp[67 + 2 * cp];
                const float tr = ar * br - ai * bi, ti = ar * bi + ai * br; s += Cr[c * 64 + p] * tr - Ci[c * 64 + p] * ti; }
            WSP(float, WS_KTAB)[(size_t)ldg * 8192 + e] = s; }
    }
}
__device__ __forceinline__ void s5_tables(Frame& F, int l) {
    const float* KT = WSP(float, WS_KTAB) + (size_t)l * 2 * 32 * 32 * 256;
    const float* SP = WSP(float, WS_S5P) + (size_t)l * 2 * 32 * 64 * 100;
    bf16* WY = WSP(bf16, WS_WY); bf16* WE = WSP(bf16, WS_WEND);
    for (int idx = F.vcu * 512 + F.tid; idx < 32 * 512 * 96; idx += F.G * 512) {
        const int k8 = idx % 96, n = (idx / 96) & 511, g = idx / (96 * 512); const int t = n >> 4, c = n & 15;
        float v[8];
        if (k8 < 64) { const int j = k8 >> 1, c0 = (k8 & 1) * 8, dtj = t - j;
            if (dtj > 0) { const float* s = KT + ((((size_t)0 * 32 + g) * 32 + dtj) * 16 + c) * 16 + c0;
#pragma unroll
                for (int q = 0; q < 8; ++q) v[q] = s[q]; }
            else if (dtj < 0) { const float* s = KT + ((((size_t)1 * 32 + g) * 32 - dtj) * 16 + c) * 16 + c0;
#pragma unroll
                for (int q = 0; q < 8; ++q) v[q] = s[q]; }
            else { const float* s0 = KT + ((((size_t)0 * 32 + g) * 32) * 16 + c) * 16 + c0; const float* s1 = KT + ((((size_t)1 * 32 + g) * 32) * 16 + c) * 16 + c0; const float dsk = inp(F, 25)[l * 512 + g * 16 + c];
#pragma unroll
                for (int q = 0; q < 8; ++q) v[q] = s0[q] + s1[q] + ((c0 + q == c) ? dsk : 0.f); } }
        else { const int part = (k8 - 64) >> 3, dir = part >> 1, im = part & 1, p0 = ((k8 - 64) & 7) * 8; const int e = dir ? 32 - t : t + 1;
            const size_t ldg = ((size_t)(l * 2 + dir) * 32 + g);
            const float* cre = inp(F, 23) + (ldg * 16 + c) * 64 + p0; const float* cim = inp(F, 24) + (ldg * 16 + c) * 64 + p0;
#pragma unroll
            for (int q = 0; q < 8; ++q) { const float* Pp = SP + (((size_t)dir * 32 + g) * 64 + p0 + q) * 100; const float ar = Pp[2 * e], ai = Pp[2 * e + 1];
                v[q] = im ? -(cre[q] * ai + cim[q] * ar) : (cre[q] * ar - cim[q] * ai); } }
        u32x4 w; w.x = cvtpk(v[0], v[1]); w.y = cvtpk(v[2], v[3]); w.z = cvtpk(v[4], v[5]); w.w = cvtpk(v[6], v[7]);
        *(u32x4*)(WY + ((size_t)g * 512 + n) * 768 + k8 * 8) = w;
    }
    for (int idx = F.vcu * 512 + F.tid; idx < 32 * 256 * 64; idx += F.G * 512) {
        const int k8 = idx & 63, q_ = (idx >> 6) & 255, g = idx >> 14; const int j = k8 >> 1, c0 = (k8 & 1) * 8;
        const int dir = q_ >> 7, im = (q_ >> 6) & 1, p = q_ & 63; const int e = dir ? j : 31 - j;
        const float* Pp = SP + (((size_t)dir * 32 + g) * 64 + p) * 100; const float ar = Pp[2 * e], ai = Pp[2 * e + 1]; float v[8];
#pragma unroll
        for (int q = 0; q < 8; ++q) { const float br = Pp[66 + 2 * (c0 + q)], bi = Pp[67 + 2 * (c0 + q)]; v[q] = im ? (ar * bi + ai * br) : (ar * br - ai * bi); }
        u32x4 w; w.x = cvtpk(v[0], v[1]); w.y = cvtpk(v[2], v[3]); w.z = cvtpk(v[4], v[5]); w.w = cvtpk(v[6], v[7]);
        *(u32x4*)(WE + ((size_t)g * 256 + q_) * 512 + k8 * 8) = w;
    }
}

__device__ __forceinline__ void moe_bases(const unsigned* cnt, int (&base)[9]) {
    int b = 0;
#pragma unroll
    for (int e = 0; e < 8; ++e) { base[e] = b; const int c = (int)__hip_atomic_load(cnt + 64 * e, __ATOMIC_RELAXED, __HIP_MEMORY_SCOPE_AGENT); b += ((c + 255) >> 8) << 8; }
    base[8] = b;
}

template <int MODE>
__device__ __forceinline__ void norm_phase(Frame& F, int l) {
    bf16* xs = WSP(bf16, WS_XS); bf16* H = WSP(bf16, WS_H);
    const float* gn = inp(F, MODE == 0 ? 6 : 7) + l * D;
    const float* modl = WSP(float, WS_MOD) + ((size_t)l * 2 + 0) * 6144 + (MODE == 0 ? 0 : 3 * D);
    const float* modc = WSP(float, WS_MOD) + ((size_t)l * 2 + 1) * 6144 + (MODE == 0 ? 0 : 3 * D);
    const bool moe = (MODE == 1) && (l & 1) && !DBG_NOMOE;
    const bool comb = (MODE == 0) && l > 0 && ((l - 1) & 1) && !DBG_NOMOE;
    const int row_lo = (MODE == 1 && l == DEPTH - 1) ? NC : 0;
    int base[9];
    const unsigned* cntp = (const unsigned*)WSP(unsigned, WS_CTL) + CW_CNT + ((l - 1) >> 1) * 8 * 64;
    if (comb) moe_bases(cntp, base);
    LAS float* wr_l = (LAS float*)F.lds;
    LAS int* lcnt = (LAS int*)(F.lds + 32768); LAS int* wgbase = lcnt + 8; LAS unsigned* rowrec = (LAS unsigned*)(F.lds + 32768 + 256);
    if (moe) { const float* wrt = inp(F, 35) + (size_t)(l >> 1) * D * 8; for (int i = F.tid; i < D * 8; i += 512) wr_l[i] = wrt[i]; if (F.tid < 8) lcnt[F.tid] = 0; __syncthreads(); }
    int krow = 0;
    unsigned* cnt = WSP(unsigned, WS_CTL) + CW_CNT + (l >> 1) * 8 * 64;
    const float* ga2p_l = WSP(float, WS_MOD) + ((size_t)(l - 1) * 2 + 0) * 6144 + 5 * D; const float* ga2p_c = WSP(float, WS_MOD) + ((size_t)(l - 1) * 2 + 1) * 6144 + 5 * D;
    for (int m = row_lo + F.gw; m < NT; m += F.NGW) {
        f32x4 v[4];
        if (MODE == 0 && l == 0) { const float* src = m < NC ? inp(F, 2) + (size_t)m * D : inp(F, 0) + (size_t)(m - NC) * D;
#pragma unroll
            for (int j = 0; j < 4; ++j) v[j] = *(const f32x4*)(src + j * 256 + F.lane * 4); }
        else {
#ifdef DBG_SC1
#pragma unroll
            for (int j = 0; j < 4; ++j) {
#pragma unroll
                for (int q = 0; q < 4; ++q) v[j][q] = __hip_atomic_load(xs + (size_t)m * D + j * 256 + F.lane * 4 + q, __ATOMIC_RELAXED, __HIP_MEMORY_SCOPE_AGENT); }
#else
#pragma unroll
            for (int j = 0; j < 4; ++j) v[j] = ld4bf(xs + (size_t)m * D + j * 256 + F.lane * 4);
#endif
        }
        if (comb) { const unsigned* rec = WSP(unsigned, WS_REC) + (size_t)m * 8; const int e0 = rec[0], p0 = rec[1], e1 = rec[2], p1 = rec[3]; const float w0 = __uint_as_float(rec[4]), w1 = __uint_as_float(rec[5]);
            int r0 = 0, r1 = 0;
#pragma unroll
            for (int e = 0; e < 8; ++e) { r0 = (e == e0) ? base[e] + p0 : r0; r1 = (e == e1) ? base[e] + p1 : r1; }
            const bf16* Y0 = WSP(bf16, WS_Y) + (size_t)r0 * D; const bf16* Y1 = WSP(bf16, WS_Y) + (size_t)r1 * D; const float* ga = m < NC ? ga2p_c : ga2p_l; constexpr size_t YH = (size_t)(WS_Y2 - WS_Y) / 2;
#pragma unroll
            for (int j = 0; j < 4; ++j) { const int col = j * 256 + F.lane * 4; const u32x2 a = *(const u32x2*)(Y0 + col), b = *(const u32x2*)(Y1 + col), a2 = *(const u32x2*)(Y0 + YH + col), b2 = *(const u32x2*)(Y1 + YH + col); const f32x4 g = *(const f32x4*)(ga + col);
                v[j][0] += g[0] * (w0 * (bflo(a.x) + bflo(a2.x)) + w1 * (bflo(b.x) + bflo(b2.x))); v[j][1] += g[1] * (w0 * (bfhi(a.x) + bfhi(a2.x)) + w1 * (bfhi(b.x) + bfhi(b2.x)));
                v[j][2] += g[2] * (w0 * (bflo(a.y) + bflo(a2.y)) + w1 * (bflo(b.y) + bflo(b2.y))); v[j][3] += g[3] * (w0 * (bfhi(a.y) + bfhi(a2.y)) + w1 * (bfhi(b.y) + bfhi(b2.y))); } }
        const int npart = (m < NC) ? ((MODE == 1) ? (l < DEPTH - 1 ? 12 : 0) : ((l > 0 && !((l - 1) & 1)) ? 11 : 0)) : 0;
        if (npart) { const float* pp = WSP(float, WS_PART) + (size_t)m * D;
            for (int k = 0; k < npart; ++k) {
#pragma unroll
                for (int j = 0; j < 4; ++j) v[j] += *(const f32x4*)(pp + (size_t)k * 256 * D + j * 256 + F.lane * 4); } }
        if ((MODE == 0 && l == 0) || comb || npart) {
#pragma unroll
            for (int j = 0; j < 4; ++j) st4bf(xs + (size_t)m * D + j * 256 + F.lane * 4, v[j]); }
        float ss = 0.f;
#pragma unroll
        for (int j = 0; j < 4; ++j) ss += (v[j][0] * v[j][0] + v[j][1] * v[j][1]) + (v[j][2] * v[j][2] + v[j][3] * v[j][3]);
        const float r = 1.0f / sqrtf(wave_sum(ss) * (1.f / D) + EPS);
        const float* md = m < NC ? modc : modl;
        float lg[8] = {0.f, 0.f, 0.f, 0.f, 0.f, 0.f, 0.f, 0.f};
#pragma unroll
        for (int j = 0; j < 4; ++j) { const int col = j * 256 + F.lane * 4; const f32x4 g = *(const f32x4*)(gn + col), sh = *(const f32x4*)(md + col), sc = *(const f32x4*)(md + D + col);
            f32x4 h;
#pragma unroll
            for (int q = 0; q < 4; ++q) h[q] = (v[j][q] * r * g[q]) * (1.f + sc[q]) + sh[q];
            if ((MODE == 1 && moe) || (MODE == 0 && l >= WIN8_FROM)) *(unsigned*)((unsigned char*)H + (size_t)m * D + col) = (unsigned)__builtin_amdgcn_cvt_pk_fp8_f32(h[2], h[3], __builtin_amdgcn_cvt_pk_fp8_f32(h[0], h[1], 0, false), true);
            else { u32x2 w; w.x = cvtpk(h[0], h[1]); w.y = cvtpk(h[2], h[3]); *(u32x2*)(H + (size_t)m * D + col) = w; }
            if (moe) {
#pragma unroll
                for (int q = 0; q < 4; ++q) { const f32x4 wa = *(const LAS f32x4*)(wr_l + (col + q) * 8), wb = *(const LAS f32x4*)(wr_l + (col + q) * 8 + 4);
                    lg[0] += h[q] * wa[0]; lg[1] += h[q] * wa[1]; lg[2] += h[q] * wa[2]; lg[3] += h[q] * wa[3]; lg[4] += h[q] * wb[0]; lg[5] += h[q] * wb[1]; lg[6] += h[q] * wb[2]; lg[7] += h[q] * wb[3]; } } }
        if (moe) {
#pragma unroll
            for (int e = 0; e < 8; ++e) lg[e] = wave_sum(lg[e]);
            int i0 = 0; float v0 = lg[0];
#pragma unroll
            for (int e = 1; e < 8; ++e) if (lg[e] > v0) { v0 = lg[e]; i0 = e; }
            int i1 = -1; float v1 = -3.0e38f;
#pragma unroll
            for (int e = 0; e < 8; ++e) if (e != i0 && lg[e] > v1) { v1 = lg[e]; i1 = e; }
#ifdef DBG_FIXROUTE
            i0 = m & 7; i1 = (m + 1) & 7; v0 = 0.f; v1 = 0.f;
#endif
            if (F.lane == 0) { const float w1 = 1.f / (1.f + __expf(v0 - v1)), w0 = 1.f - w1;
                const unsigned p0 = (unsigned)__hip_atomic_fetch_add(lcnt + i0, 1, __ATOMIC_RELAXED, __HIP_MEMORY_SCOPE_WORKGROUP), p1 = (unsigned)__hip_atomic_fetch_add(lcnt + i1, 1, __ATOMIC_RELAXED, __HIP_MEMORY_SCOPE_WORKGROUP);
                LAS unsigned* rr = rowrec + (F.wave * 9 + krow) * 6; rr[0] = i0; rr[1] = p0; rr[2] = i1; rr[3] = p1; rr[4] = __float_as_uint(w0); rr[5] = __float_as_uint(w1); }
            ++krow;
        }
    }
    if (moe) {
        __syncthreads();
        if (F.tid < 8) wgbase[F.tid] = (int)__hip_atomic_fetch_add(cnt + 64 * F.tid, (unsigned)lcnt[F.tid], __ATOMIC_RELAXED, __HIP_MEMORY_SCOPE_AGENT);
        __syncthreads();
        if (F.lane == 0) { int k = 0; for (int m = row_lo + F.gw; m < NT; m += F.NGW, ++k) { const LAS unsigned* rr = rowrec + (F.wave * 9 + k) * 6; unsigned* rec = WSP(unsigned, WS_REC) + (size_t)m * 8;
            const unsigned e0 = rr[0], e1 = rr[2]; rec[0] = e0; rec[1] = rr[1] + (unsigned)wgbase[e0]; rec[2] = e1; rec[3] = rr[3] + (unsigned)wgbase[e1]; rec[4] = rr[4]; rec[5] = rr[5]; } }
    }
}
__device__ __forceinline__ void moe_scatter(Frame& F, int l) {
    int base[9]; moe_bases((const unsigned*)WSP(unsigned, WS_CTL) + CW_CNT + (l >> 1) * 8 * 64, base);
    const int row_lo = (l == DEPTH - 1) ? NC : 0;
    const bf16* H = WSP(bf16, WS_H); bf16* HS = WSP(bf16, WS_HS);
    for (int it = 2 * row_lo + F.gw; it < 2 * NT; it += F.NGW) { const int m = it >> 1, s = it & 1; const unsigned* rec = WSP(unsigned, WS_REC) + (size_t)m * 8; const int e = rec[2 * s], p = rec[2 * s + 1];
        int r = 0;
#pragma unroll
        for (int q = 0; q < 8; ++q) r = (q == e) ? base[q] + p : r;
        const u32x4* src = (const u32x4*)((const unsigned char*)H + (size_t)m * D); u32x4* dst = (u32x4*)((unsigned char*)HS + (size_t)r * D);
        dst[F.lane] = src[F.lane]; }
}
__device__ __forceinline__ void final_out(Frame& F, int l) {
#if DBG_DUMP == 9
    { const float* xs = WSP(float, WS_XS); for (int m = NC + ((F.gw + 1024 + 3) % F.NGW); m < NT; m += F.NGW) { for (int j = 0; j < 16; ++j) { const int col = j * 64 + F.lane; F.out[(size_t)(m - NC) * D + col] = xs[(size_t)m * D + col]; } } return; }
#elif DBG_DUMP == 10
    { const float* md = WSP(float, WS_MOD); for (int m = NC + F.gw; m < NT; m += F.NGW) { for (int j = 0; j < 16; ++j) { const int col = j * 64 + F.lane; F.out[(size_t)(m - NC) * D + col] = md[((size_t)(m - NC) * D + col) % 49152]; } } return; }
#elif DBG_DUMP
    { const bf16* src = WSP(bf16, DBG_DUMP == 1 ? WS_H : DBG_DUMP == 2 ? WS_G : DBG_DUMP == 3 ? WS_KVRAW : DBG_DUMP == 4 ? WS_OA : DBG_DUMP == 5 ? WS_M1 : DBG_DUMP == 6 ? WS_QF : DBG_DUMP == 7 ? WS_Z : WS_OC);
      const int ld = DBG_DUMP == 2 ? 3072 : (DBG_DUMP == 4 || DBG_DUMP == 7 || DBG_DUMP == 8) ? 512 : DBG_DUMP == 6 ? 96 : 1024;
      for (int m = NC + F.gw; m < NT; m += F.NGW) { for (int j = 0; j < 16; ++j) { const int col = j * 64 + F.lane; F.out[(size_t)(m - NC) * D + col] = bf2f(src[(size_t)m * ld + (col % ld)]); } } return; }
#endif
    if (!(l & 1) || DBG_NOMOE) { const bf16* xs = WSP(bf16, WS_XS); for (int m = NC + F.gw; m < NT; m += F.NGW) {
#pragma unroll
        for (int j = 0; j < 4; ++j) *(f32x4*)(F.out + (size_t)(m - NC) * D + j * 256 + F.lane * 4) = ld4bf(xs + (size_t)m * D + j * 256 + F.lane * 4); } return; }
    int base[9]; moe_bases((const unsigned*)WSP(unsigned, WS_CTL) + CW_CNT + (l >> 1) * 8 * 64, base);
    const bf16* xs = WSP(bf16, WS_XS); const float* ga = WSP(float, WS_MOD) + ((size_t)l * 2 + 0) * 6144 + 5 * D;
    for (int m = NC + F.gw; m < NT; m += F.NGW) { const unsigned* rec = WSP(unsigned, WS_REC) + (size_t)m * 8; const int e0 = rec[0], p0 = rec[1], e1 = rec[2], p1 = rec[3];
#ifndef DBG_NOREC
        const float w0 = __uint_as_float(rec[4]), w1 = __uint_as_float(rec[5]);
#endif
        int r0 = 0, r1 = 0;
#pragma unroll
        for (int e = 0; e < 8; ++e) { r0 = (e == e0) ? base[e] + p0 : r0; r1 = (e == e1) ? base[e] + p1 : r1; }
        const bf16* Y0 = WSP(bf16, DBG_YSRC) + (size_t)r0 * D; const bf16* Y1 = WSP(bf16, DBG_YSRC) + (size_t)r1 * D;
#ifdef DBG_DIRECTH
        Y0 = WSP(bf16, WS_H) + (size_t)m * D; Y1 = Y0;
#endif
#ifdef DBG_NOREC
        const float w0 = DBG_W, w1 = DBG_W;
#endif
#pragma unroll
        for (int j = 0; j < 4; ++j) { const int col = j * 256 + F.lane * 4; constexpr size_t YH = (size_t)(WS_Y2 - WS_Y) / 2; const u32x2 a = *(const u32x2*)(Y0 + col), b = *(const u32x2*)(Y1 + col), a2 = *(const u32x2*)(Y0 + YH + col), b2 = *(const u32x2*)(Y1 + YH + col); const f32x4 g = *(const f32x4*)(ga + col); f32x4 v = ld4bf(xs + (size_t)m * D + col);
            v[0] += g[0] * (w0 * (bflo(a.x) + bflo(a2.x)) + w1 * (bflo(b.x) + bflo(b2.x))); v[1] += g[1] * (w0 * (bfhi(a.x) + bfhi(a2.x)) + w1 * (bfhi(b.x) + bfhi(b2.x))); v[2] += g[2] * (w0 * (bflo(a.y) + bflo(a2.y)) + w1 * (bflo(b.y) + bflo(b2.y))); v[3] += g[3] * (w0 * (bfhi(a.y) + bfhi(a2.y)) + w1 * (bfhi(b.y) + bfhi(b2.y)));
            *(f32x4*)(F.out + (size_t)(m - NC) * D + col) = v; } }
}

__device__ __forceinline__ float sum8(float v) { v += __shfl_xor(v, 1); v += __shfl_xor(v, 2); v += __shfl_xor(v, 4); return v; }
__device__ __forceinline__ void finalize_phase(Frame& F, int l, int wg, int nwg) {
    const bf16* pA = WSP(bf16, WS_PA); const bf16* pN = WSP(bf16, WS_PN); const bf16* QR = WSP(bf16, WS_QRAW); const bf16* KVR = WSP(bf16, WS_KVRAW);
    bf16* QF = WSP(bf16, WS_QF); unsigned char* K8G = WSP(unsigned char, WS_KF); unsigned char* V8G = WSP(unsigned char, WS_VF); bf16* NQ = WSP(bf16, WS_NQ); bf16* NK = WSP(bf16, WS_NK);
    const float* gqn = inp(F, 13) + l * 96; const float* gkn = inp(F, 14) + l * 96; const float* gnq = inp(F, 15) + l * 64; const float* gnk = inp(F, 16) + l * 64;
    const float* COS = WSP(float, WS_ROPE); const float* SIN = COS + NL * 16;
    LAS unsigned char* buf = F.lds; LAS float* stats = (LAS float*)(F.lds + RING_BYTES + 4096); LAS unsigned char* krl = F.lds + RING_BYTES + 4096 + 512;
    const int tid0 = F.tid;
#define SWZ(c, row) (((c) & ~15) | (((c) ^ (row)) & 15))
#define PK8(f) (u32x4){cvtpk(f[0], f[1]), cvtpk(f[2], f[3]), cvtpk(f[4], f[5]), cvtpk(f[6], f[7])}
    for (int tg = wg; tg < NT / 64; tg += nwg) {
        int tid_ = tid0; asm volatile("" : "+v"(tid_));
        const int tid = tid_, lane = tid & 63, wave = __builtin_amdgcn_readfirstlane(tid >> 6), h = tid >> 6, tl = tid & 63;
        const int t0 = tg * 64, t = t0 + tl; const bool lat = t >= NC; const int n = t - NC;
        __syncthreads();
        { u32x4 va[8], vb[8]; float sq[8], skv[8];
#pragma unroll
          for (int i = 0; i < 8; ++i) { const bf16* row = pA + (size_t)(t0 + wave * 8 + i) * 768; va[i] = *(const u32x4*)(row + lane * 8); vb[i] = lane < 20 ? *(const u32x4*)(row + (64 + lane) * 8) : (u32x4){0u, 0u, 0u, 0u}; }
#pragma unroll
          for (int i = 0; i < 8; ++i) { float f[8]; unpack8(va[i], f); float ss = 0.f;
#pragma unroll
              for (int q = 0; q < 8; ++q) ss += f[q] * f[q];
              sq[i] = lane < 48 ? ss : 0.f; skv[i] = lane >= 48 ? ss : 0.f;
              if (lane < 16) { float g[8]; unpack8(vb[i], g);
#pragma unroll
                  for (int q = 0; q < 8; ++q) skv[i] += g[q] * g[q]; }
              else if (lane < 20) *(LAS u32x4*)(krl + (wave * 8 + i) * 64 + (lane - 16) * 16) = vb[i]; }
#pragma unroll
          for (int o = 1; o < 64; o <<= 1) {
#pragma unroll
              for (int i = 0; i < 8; ++i) { sq[i] += __shfl_xor(sq[i], o); skv[i] += __shfl_xor(skv[i], o); } }
          if (lane == 0) {
#pragma unroll
              for (int i = 0; i < 8; ++i) { stats[(wave * 8 + i) * 2] = 1.0f / sqrtf(sq[i] * (1.f / 384.f) + EPS); stats[(wave * 8 + i) * 2 + 1] = 1.0f / sqrtf(skv[i] * (1.f / 256.f) + EPS); } } }
#pragma unroll 8
        for (int i = 0; i < 12; ++i) { const int id = tid + 512 * i, row = id / 96, c = id % 96; *(LAS u32x4*)(buf + row * 1536 + SWZ(c, row) * 16) = *(const u32x4*)(QR + (size_t)(t0 + row) * 768 + c * 8); }
        __syncthreads();
        { LAS unsigned char* pq = buf + tl * 1536; const float rq = stats[tl * 2]; float ss = 0.f;
#define QCH(c) (pq + SWZ(h * 12 + (c), tl) * 16)
#pragma unroll
          for (int c = 0; c < 12; ++c) { float f[8]; unpack8(*(const LAS u32x4*)QCH(c), f);
#pragma unroll
              for (int q = 0; q < 8; ++q) { const float v = f[q] * rq; ss += v * v; } }
          const float sc = rq / sqrtf(ss * (1.f / 96.f) + EPS) * (0.10206207261596575f * 1.4426950408889634f);
#pragma unroll
          for (int c = 0; c < 8; ++c) { float f[8]; unpack8(*(const LAS u32x4*)QCH(c), f);
#pragma unroll
              for (int q = 0; q < 8; ++q) f[q] = f[q] * sc * gqn[c * 8 + q];
              *(LAS u32x4*)QCH(c) = PK8(f); }
#pragma unroll
          for (int cp = 0; cp < 2; ++cp) { float a[8], b[8]; unpack8(*(const LAS u32x4*)QCH(8 + cp), a); unpack8(*(const LAS u32x4*)QCH(10 + cp), b);
#pragma unroll
              for (int q = 0; q < 8; ++q) { a[q] = a[q] * sc * gqn[64 + cp * 8 + q]; b[q] = b[q] * sc * gqn[80 + cp * 8 + q]; }
              if (lat) {
#pragma unroll
                  for (int q = 0; q < 8; ++q) { const float cs = COS[(size_t)n * 16 + cp * 8 + q], sn = SIN[(size_t)n * 16 + cp * 8 + q]; const float ra = a[q] * cs - b[q] * sn, rb = a[q] * sn + b[q] * cs; a[q] = ra; b[q] = rb; } }
              *(LAS u32x4*)QCH(8 + cp) = PK8(a); *(LAS u32x4*)QCH(10 + cp) = PK8(b); } }
#undef QCH
        __syncthreads();
#pragma unroll 8
        for (int i = 0; i < 12; ++i) { const int id = tid + 512 * i, hh = id / 768, rem = id % 768, row = rem / 12, c = rem % 12;
            *(u32x4*)(QF + ((size_t)hh * NT + t0 + row) * 96 + c * 8) = *(const LAS u32x4*)(buf + row * 1536 + SWZ(hh * 12 + c, row) * 16); }
        __syncthreads();
#pragma unroll 8
        for (int i = 0; i < 16; ++i) { const int id = tid + 512 * i, row = id >> 7, c = id & 127; *(LAS u32x4*)(buf + row * 2048 + SWZ(c, row) * 16) = *(const u32x4*)(KVR + (size_t)(t0 + row) * 1024 + c * 8); }
        __syncthreads();
        unsigned v8r[16];
#define F8W(f, o) ((unsigned)__builtin_amdgcn_cvt_pk_fp8_f32(f[(o) + 2], f[(o) + 3], __builtin_amdgcn_cvt_pk_fp8_f32(f[(o)], f[(o) + 1], 0, false), true))
        { LAS unsigned char* pk = buf + tl * 2048; const LAS unsigned char* pr = krl + tl * 64;
#define KCHK(c) (pk + SWZ(h * 16 + (c), tl) * 16)
          const float rkv = stats[tl * 2 + 1]; float ss = 0.f;
#pragma unroll
          for (int c = 0; c < 8; ++c) { float f[8]; unpack8(*(const LAS u32x4*)KCHK(c), f);
#pragma unroll
              for (int q = 0; q < 8; ++q) { const float v = f[q] * rkv; ss += v * v; } }
#pragma unroll
          for (int c = 0; c < 4; ++c) { float f[8]; unpack8(*(const LAS u32x4*)(pr + c * 16), f);
#pragma unroll
              for (int q = 0; q < 8; ++q) ss += f[q] * f[q]; }
          const float rn = 1.0f / sqrtf(ss * (1.f / 96.f) + EPS), sc = rkv * rn; unsigned kw[16];
#pragma unroll
          for (int c = 0; c < 8; ++c) { float f[8]; unpack8(*(const LAS u32x4*)KCHK(c), f);
#pragma unroll
              for (int q = 0; q < 8; ++q) f[q] = f[q] * sc * gkn[c * 8 + q];
              kw[c * 2] = F8W(f, 0); kw[c * 2 + 1] = F8W(f, 4); }
          unsigned kr[8];
#pragma unroll
          for (int c = 8; c < 16; ++c) { float f[8]; unpack8(*(const LAS u32x4*)KCHK(c), f);
#pragma unroll
              for (int q = 0; q < 8; ++q) f[q] *= rkv;
              v8r[(c - 8) * 2] = F8W(f, 0); v8r[(c - 8) * 2 + 1] = F8W(f, 4); }
#pragma unroll
          for (int cp = 0; cp < 2; ++cp) { float a[8], b[8]; unpack8(*(const LAS u32x4*)(pr + cp * 16), a); unpack8(*(const LAS u32x4*)(pr + (2 + cp) * 16), b);
#pragma unroll
              for (int q = 0; q < 8; ++q) { a[q] = a[q] * rn * gkn[64 + cp * 8 + q]; b[q] = b[q] * rn * gkn[80 + cp * 8 + q]; }
              if (lat) {
#pragma unroll
                  for (int q = 0; q < 8; ++q) { const float cs = COS[(size_t)n * 16 + cp * 8 + q], sn = SIN[(size_t)n * 16 + cp * 8 + q]; const float ra = a[q] * cs - b[q] * sn, rb = a[q] * sn + b[q] * cs; a[q] = ra; b[q] = rb; } }
              kr[cp * 2] = F8W(a, 0); kr[cp * 2 + 1] = F8W(a, 4); kr[4 + cp * 2] = F8W(b, 0); kr[4 + cp * 2 + 1] = F8W(b, 4); }
#pragma unroll
          for (int w = 0; w < 4; ++w) *(LAS u32x4*)KCHK(w) = (u32x4){kw[4 * w], kw[4 * w + 1], kw[4 * w + 2], kw[4 * w + 3]};
          *(LAS u32x4*)KCHK(4) = (u32x4){kr[0], kr[1], kr[2], kr[3]}; *(LAS u32x4*)KCHK(5) = (u32x4){kr[4], kr[5], kr[6], kr[7]}; }
#undef F8W
        __syncthreads();
        int tq = tid; asm volatile("" : "+v"(tq));
#pragma unroll
        for (int i = 0; i < 6; ++i) { const int id = tq + 512 * i, hh = id / 384, r = id % 384, row = r / 6, w = r % 6;
            *(u32x4*)(K8G + ((size_t)hh * (NT / 64) + tg) * 7168 + row * 112 + w * 16) = *(const LAS u32x4*)(buf + row * 2048 + SWZ(hh * 16 + w, row) * 16); }
        __syncthreads();
        { int tl2 = tq & 63; const int pos = att::v8_pos(tl2); LAS unsigned char* vt = buf + (tq >> 6) * 4096 + (pos & 15);
          LAS unsigned char* vq[4];
#pragma unroll
          for (int x = 0; x < 4; ++x) vq[x] = vt + ((((pos >> 4) ^ x) & 3) << 4);
#pragma unroll
          for (int w = 0; w < 16; ++w)
#pragma unroll
              for (int b = 0; b < 4; ++b) vq[w & 3][(4 * w + b) * 64] = (unsigned char)(v8r[w] >> (8 * b)); }
        __syncthreads();
#pragma unroll
        for (int i = 0; i < 4; ++i) { const int id = tq + 512 * i, hh = id >> 8, off = (id & 255) * 16;
            *(u32x4*)(V8G + ((size_t)hh * (NT / 64) + tg) * 4096 + off) = *(const LAS u32x4*)(buf + hh * 4096 + off); }
        __syncthreads();
#pragma unroll 8
        for (int i = 0; i < 16; ++i) { const int id = tid + 512 * i, row = id >> 7, c = id & 127; *(LAS u32x4*)(buf + row * 2048 + SWZ(c, row) * 16) = *(const u32x4*)(pN + (size_t)(t0 + row) * 1536 + c * 8); }
        __syncthreads();
#pragma unroll
        for (int which = 0; which < 2; ++which) { LAS unsigned char* pn = buf + tl * 2048; const float* gg = which ? gnk : gnq; float ss = 0.f;
#pragma unroll
            for (int c = 0; c < 8; ++c) { float f[8]; unpack8(*(const LAS u32x4*)(pn + SWZ(which * 64 + h * 8 + c, tl) * 16), f);
#pragma unroll
                for (int q = 0; q < 8; ++q) ss += f[q] * f[q]; }
            const float rn = (which ? 1.0f : 0.125f * 1.4426950408889634f) / sqrtf(ss * (1.f / 64.f) + EPS);
#pragma unroll
            for (int c = 0; c < 8; ++c) { float f[8]; unpack8(*(const LAS u32x4*)(pn + SWZ(which * 64 + h * 8 + c, tl) * 16), f);
#pragma unroll
                for (int q = 0; q < 8; ++q) f[q] = f[q] * rn * gg[c * 8 + q];
                *(LAS u32x4*)(pn + SWZ(which * 64 + h * 8 + c, tl) * 16) = PK8(f); } }
        __syncthreads();
#pragma unroll 8
        for (int i = 0; i < 8; ++i) { const int id = tid + 512 * i, hh = id >> 9, row = (id & 511) >> 3, c = id & 7;
            *(u32x4*)(NQ + ((size_t)hh * NT + t0 + row) * 64 + c * 8) = *(const LAS u32x4*)(buf + row * 2048 + SWZ(hh * 8 + c, row) * 16);
            *(u32x4*)(NK + ((size_t)hh * NT + t0 + row) * 64 + c * 8) = *(const LAS u32x4*)(buf + row * 2048 + SWZ(64 + hh * 8 + c, row) * 16); }
    }
#undef PK8
#undef SWZ
#undef KCHK
}
__device__ __forceinline__ void s5_carry(Frame& F, int l, int cw) {
    const int idx = cw * 512 + F.tid; const int seg = idx & 7, p = (idx >> 3) & 63, g = (idx >> 9) & 31, dir = idx >> 14;
    const float* Pp = WSP(float, WS_S5P) + ((((size_t)l * 2 + dir) * 32 + g) * 64 + p) * 100; const float ar = Pp[64], ai = Pp[65];
    const float* E = WSP(float, WS_E) + (size_t)g * S5ROWS * 256 + dir * 128 + p; bf16* AG = WSP(bf16, WS_AG) + (size_t)g * S5ROWS * S5K + 512 + dir * 128 + p;
#define S5ROW(st) (dir == 0 ? ((st) < 8 ? 512 + (st) : (st) - 8) : 519 - (st))
    float tr = 0.f, ti = 0.f, pr = 1.f, pi = 0.f;
    for (int s0 = 0; s0 < 65; s0 += 5) { float er[5], ei[5];
#pragma unroll
        for (int q = 0; q < 5; ++q) { const int row = S5ROW(seg * 65 + s0 + q); er[q] = E[(size_t)row * 256]; ei[q] = E[(size_t)row * 256 + 64]; }
#pragma unroll
        for (int q = 0; q < 5; ++q) { const float nr = ar * tr - ai * ti + er[q], ni = ar * ti + ai * tr + ei[q]; tr = nr; ti = ni; const float qr = pr * ar - pi * ai, qi = pr * ai + pi * ar; pr = qr; pi = qi; } }
    float cr = 0.f, ci = 0.f, xr = 0.f, xi = 0.f; const int lb = F.lane & ~7;
#pragma unroll
    for (int k = 0; k < 8; ++k) { const float kr = __shfl(tr, lb + k), ki = __shfl(ti, lb + k); if (k == seg) { cr = xr; ci = xi; } const float nr = pr * xr - pi * xi + kr, ni = pr * xi + pi * xr + ki; xr = nr; xi = ni; }
    float sr = cr, si = ci;
    for (int s0 = 0; s0 < 65; s0 += 5) { float er[5], ei[5]; int rows[5];
#pragma unroll
        for (int q = 0; q < 5; ++q) { const int row = S5ROW(seg * 65 + s0 + q); rows[q] = row; er[q] = E[(size_t)row * 256]; ei[q] = E[(size_t)row * 256 + 64]; }
#pragma unroll
        for (int q = 0; q < 5; ++q) { AG[(size_t)rows[q] * S5K] = f2bf(sr); AG[(size_t)rows[q] * S5K + 64] = f2bf(si); const float nr = ar * sr - ai * si + er[q], ni = ar * si + ai * sr + ei[q]; sr = nr; si = ni; } }
#undef S5ROW
}
__device__ __forceinline__ void dbg_thrash(Frame& F) {
    f32x4 a = {0.f, 0.f, 0.f, 0.f};
    for (int w = 36; w < 39; ++w) { const f32x4* src = (const f32x4*)inp(F, w);
        for (size_t i = (size_t)F.vcu * 512 + F.tid; i < (size_t)11534336; i += (size_t)F.G * 512) a += src[i]; }
    if (a[0] + a[1] + a[2] + a[3] == 1.2345e33f) WSP(float, WS_E)[0] = a[0];
}
#define PH_BEGIN if (lo <= ph && ph < hi) { { int t_ = threadIdx.x; asm volatile("" : "+v"(t_)); F.tid = t_; F.lane = t_ & 63; unsigned long long w_ = (unsigned long long)args.ws; asm volatile("" : "+s"(w_)); F.ws = (unsigned char*)(GAS unsigned char*)w_; } DBG_LDSCLR
#define PH_END   if (ph + 1 < hi) xcd_barrier(bar); } ++ph;
template <int l>
__device__ __forceinline__ void layer_body(Frame& F, const Args& args, XcdBarrier& bar, int& ph, const int lo, const int hi, LAS unsigned char* ring, const int c, unsigned* ctl) {
    const int bx = blockIdx.x;
        const bool need_ctx = l < DEPTH - 1, moe = (l & 1) && !DBG_NOMOE;
        const int pm0 = need_ctx ? 0 : 1, nM = need_ctx ? 65 : 64;
        const float* modl = WSP(float, WS_MOD) + ((size_t)l * 2 + 0) * 6144; const float* modc = WSP(float, WS_MOD) + ((size_t)l * 2 + 1) * 6144;
        PH_BEGIN LPH(1) {
#if DBG_THRASH == 3
        if (l == 1) {   } else
#endif
        { for (int ra_ = 0; ra_ < 1 + DBG_REPA; ++ra_) { convert_items(F, l, F.gw, CVT_NONFFN, F.NGW);
        s5_tables(F, l); __syncthreads(); } norm_phase<0>(F, l); } } PH_END
        PH_BEGIN LPH(2) { { constexpr int KD = (l >= WIN8_FROM) ? D / 2 : D;
            pg8::SchedPlain S; S.T.init(65, 23, F.G, bx); S.A = WSP(bf16, WS_H); S.Bt = WSP(bf16, WS_WIN); S.lda = KD; S.ldb = KD; S.pm0 = 0;
            pg8::EpiWin E{WSP(bf16, WS_PA), WSP(bf16, WS_PN), WSP(bf16, WS_AG), WSP(bf16, WS_G)};
            pg8::gemm_phase<(l >= WIN8_FROM)>(ring, KD, KD, KD, S, E); } } PH_END
        PH_BEGIN LPH(3) {
        { pg8::SchedPlain S; S.T.init(65, 3, F.G, bx); S.A = WSP(bf16, WS_PA); S.Bt = WSP(bf16, WS_WUQ); S.lda = 768; S.ldb = 384; S.pm0 = 0;
          pg8::EpiBf16 E{WSP(bf16, WS_QRAW), 768}; pg8::gemm_phase(ring, 384, 768, 384, S, E); }
        { pg8::SchedPlain S; S.T.init(65, 4, F.G, (bx + 61) & 255); S.A = WSP(bf16, WS_PA) + 384; S.Bt = WSP(bf16, WS_WUKV); S.lda = 768; S.ldb = 256; S.pm0 = 0;
          pg8::EpiBf16 E{WSP(bf16, WS_KVRAW), 1024}; pg8::gemm_phase(ring, 256, 768, 256, S, E); }
        { pg8::SchedS5 S; S.nrt = 3; S.nct = 1; S.G = F.G; S.c = (c + 57) & 255; S.A = WSP(bf16, WS_AG); S.W = WSP(bf16, WS_WEND); S.brows = 256; S.ldb = 512;
          pg8::EpiS5E E{WSP(float, WS_E)}; pg8::gemm_phase(ring, 512, S5K, 512, S, E); }
        } PH_END
        PH_BEGIN LPH(4) { if (c >= F.G - 64) s5_carry(F, l, c - (F.G - 64)); else finalize_phase(F, l, c, F.G - 64); } PH_END
        PH_BEGIN LPH(5) {
        { pg8::SchedS5 S; S.nrt = need_ctx ? 3 : 2; S.nct = 2; S.G = F.G; S.c = c; S.A = WSP(bf16, WS_AG); S.W = WSP(bf16, WS_WY); S.brows = 512; S.ldb = 768;
          pg8::EpiS5Y E{WSP(bf16, WS_Z)}; pg8::gemm_phase(ring, S5K, S5K, 768, S, E); }
        if (need_ctx && c >= 192 && c < 208) { const int u = c - 192, h = u & 7;
            if (u < 8) att::attn_unit<96, false, true>(WSP(bf16, WS_QF) + (size_t)h * NT * 96, 96, (const bf16*)(WSP(unsigned char, WS_KF) + (size_t)h * (NT / 64) * 7168), 96, (const bf16*)(WSP(unsigned char, WS_VF) + (size_t)h * (NT / 64) * 4096), 64, WSP(bf16, WS_OA) + h * 64, 4, 0, 0, 0, nullptr, ring);
            else att::attn_unit<64, false>(WSP(bf16, WS_NQ) + (size_t)h * NT * 64, 64, WSP(bf16, WS_NK) + (size_t)h * NT * 64, 64, WSP(bf16, WS_PN) + 1024 + h * 64, 1536, WSP(bf16, WS_OB) + h * 64, 4, 0, 0, 0, nullptr, ring); }
        for (int i = 0; i < 2; ++i) { const int h = c >> 5, qb = (c & 31) + 32 * i;
            att::attn_unit<96, false, true>(WSP(bf16, WS_QF) + ((size_t)h * NT + NC + qb * 256) * 96, 96, (const bf16*)(WSP(unsigned char, WS_KF) + (size_t)h * (NT / 64) * 7168), 96, (const bf16*)(WSP(unsigned char, WS_VF) + (size_t)h * (NT / 64) * 4096), 64,
                                      WSP(bf16, WS_OA) + (size_t)(NC + qb * 256) * 512 + h * 64, NT / 64, 0, 0, 0, nullptr, ring); }
        for (int i = 0; i < 2; ++i) { const int h = c >> 5, qb = (c & 31) + 32 * i;
            const int glo = 4 * qb - 4 < 0 ? 0 : (4 * qb - 4 > 248 ? 248 : 4 * qb - 4), ghi0 = 4 * qb - 1 < 0 ? 0 : (4 * qb - 1 > 248 ? 248 : 4 * qb - 1), ghi = ghi0 + 7;
            const int ntl = 4 + (ghi - glo + 1), ntp = (ntl + 1) & ~1;
            att::attn_unit<64, true>(WSP(bf16, WS_NQ) + ((size_t)h * NT + NC + qb * 256) * 64, 64, WSP(bf16, WS_NK) + (size_t)h * NT * 64, 64, WSP(bf16, WS_PN) + 1024 + h * 64, 1536,
                                     WSP(bf16, WS_OB) + (size_t)(NC + qb * 256) * 512 + h * 64, ntp, glo, ghi, qb, inp(F, 17) + ((size_t)l * 8 + h) * 465, ring); }
        { volatile LAS unsigned* tk = (volatile LAS unsigned*)(F.lds + MISC_OFF) + 12; const int ntk = (moe ? NEXP : 1) * (CVT_FFN / 64);
          for (;;) { __syncthreads(); if (F.tid == 0) tk[0] = xb_add(ctl + CW_CVT + l * 64, 1u);
              __syncthreads(); const int t = __builtin_amdgcn_readfirstlane((int)tk[0]); if (t >= ntk) break;
              convert_items(F, l, CVT_NONFFN + t * 64 + F.wave, CVT_NONFFN + (t + 1) * 64, 8); } }
        } PH_END
        PH_BEGIN LPH(6) { { pg8::SchedPlain S; S.T.init(nM, 2, F.G, bx); S.A = WSP(bf16, WS_Z); S.Bt = WSP(bf16, WS_WGLU); S.lda = 512; S.ldb = 512; S.pm0 = pm0;
            pg8::EpiGlu E{WSP(bf16, WS_Z), WSP(bf16, WS_OC), inp(F, 27) + l * 512}; pg8::gemm_phase(ring, 512, 512, 512, S, E); } } PH_END
        PH_BEGIN LPH(7) { { pg8::SchedMerge S; S.T.init(64, 4, F.G, bx); S.O = WSP(bf16, WS_OA); S.W = WSP(bf16, WS_WBR); S.pm0 = 1;
            pg8::EpiMerge E{WSP(bf16, WS_G), WSP(bf16, WS_M1)}; pg8::gemm_phase(ring, 512, 512, 512, S, E); }
            if (need_ctx) { pg8::SchedCtxMerge S; S.G = F.G; S.c = (c + 96) & 255; S.O = WSP(bf16, WS_OA); S.W = WSP(bf16, WS_WBR);
            pg8::EpiMergeCtx E{WSP(bf16, WS_G), WSP(bf16, WS_M1C)}; pg8::gemm_phase(ring, 512, 512, 512, S, E); } } PH_END
        PH_BEGIN LPH(8) { { pg8::SchedPlain S; S.T.init(64, 4, F.G, bx); S.A = WSP(bf16, WS_M1); S.Bt = WSP(bf16, WS_WOUT); S.lda = D; S.ldb = D; S.pm0 = 1;
            pg8::EpiResid E{WSP(bf16, WS_XS), modl + 2 * D, modc + 2 * D}; pg8::gemm_phase(ring, D, D, D, S, E); }
            if (need_ctx) { pg8::SchedCtxK S; S.nsl = 12; S.nks = 4; S.G = F.G; S.c = (c + 96) & 255; S.A = WSP(bf16, WS_M1C); S.astride = (size_t)256 * 1024; S.Bt = WSP(bf16, WS_WOUT); S.lda = D; S.ldb = D;
            pg8::EpiResidPart E{WSP(float, WS_PART), modc + 2 * D}; pg8::gemm_phase(ring, 256, D, D, S, E); } } PH_END
        PH_BEGIN LPH(9) { norm_phase<1>(F, l); } PH_END
        if (!moe) {
            PH_BEGIN LPH(10) { { pg8::SchedPlain S; S.T.init(nM, 22, F.G, bx); S.A = WSP(bf16, WS_H); S.Bt = WSP(bf16, WS_WGU); S.lda = D; S.ldb = D; S.pm0 = pm0;
                pg8::EpiUp E{WSP(bf16, WS_ACT)}; pg8::gemm_phase(ring, D, D, D, S, E); } } PH_END
            PH_BEGIN LPH(11) { { pg8::SchedPlain S; S.T.init(64, 4, F.G, bx); S.A = WSP(bf16, WS_ACT); S.Bt = WSP(bf16, WS_WD); S.lda = FF; S.ldb = FF; S.pm0 = 1;
                pg8::EpiResid E{WSP(bf16, WS_XS), modl + 5 * D, modc + 5 * D}; pg8::gemm_phase(ring, FF, FF, FF, S, E); }
                if (need_ctx) { pg8::SchedCtxK S; S.nsl = 11; S.nks = 11; S.G = F.G; S.c = (c + 96) & 255; S.A = WSP(bf16, WS_ACT); S.astride = 0; S.Bt = WSP(bf16, WS_WD); S.lda = FF; S.ldb = FF;
                pg8::EpiResidPart E{WSP(float, WS_PART), modc + 5 * D}; pg8::gemm_phase(ring, 256, FF, FF, S, E); } } PH_END
        } else {
            PH_BEGIN LPH(12) { moe_scatter(F, l); } PH_END
            LAS int* tst = (LAS int*)(F.lds + RING_BYTES + 2048);
            PH_BEGIN LPH(13) { { int base[9]; moe_bases((const unsigned*)ctl + CW_CNT + (l >> 1) * 8 * 64, base); __syncthreads();
                if (F.tid < 160) { int e = 0;
#pragma unroll
                    for (int j = 1; j < 8; ++j) e += (F.tid >= (base[j] >> 8)) ? 1 : 0;
                    tst[F.tid] = e; } __syncthreads();
                pg8::SchedMoe S; S.T.init(base[8] >> 8, 22, F.G, bx); S.A = WSP(bf16, WS_HS); S.W = WSP(bf16, WS_WGU); S.lda = D / 2; S.ldb = D / 2; S.wstride = (size_t)FF2 * D / 2; S.tstart = tst;
                pg8::EpiUp8 E{WSP(unsigned char, WS_ACT)}; pg8::gemm_phase<true>(ring, D / 2, D / 2, D / 2, S, E); } } PH_END
            PH_BEGIN LPH(14) { { int base[9]; moe_bases((const unsigned*)ctl + CW_CNT + (l >> 1) * 8 * 64, base); __syncthreads();
                if (F.tid < 160) { int e = 0;
#pragma unroll
                    for (int j = 1; j < 8; ++j) e += (F.tid >= (base[j] >> 8)) ? 1 : 0;
                    tst[F.tid] = e; } __syncthreads();
                pg8::SchedMoeDown8 S; S.T.init(base[8] >> 8, 8, F.G, bx); S.A = WSP(bf16, WS_ACT); S.W = WSP(bf16, WS_WD); S.tstart = tst;
                pg8::EpiMoeY E{WSP(bf16, WS_Y), WSP(bf16, WS_Y2)}; pg8::gemm_phase<true, true, 125>(ring, 768, FF / 2, FF / 2, S, E); } } PH_END
        }
    }
__global__ void __launch_bounds__(512, 2) mega(Args args) {
    extern __shared__ __attribute__((aligned(16))) unsigned char lds_raw[];
    Frame F; F.lds = (LAS unsigned char*)lds_raw; F.ws = (unsigned char*)(GAS unsigned char*)(unsigned long long)args.ws; F.out = (float*)(GAS float*)(unsigned long long)args.out;
    F.tid = threadIdx.x; F.lane = F.tid & 63; F.wave = __builtin_amdgcn_readfirstlane(F.tid >> 6);
    F.G = gridDim.x; { const int bx = blockIdx.x; F.vcu = (F.G % 8 == 0) ? (bx % 8) * (F.G / 8) + bx / 8 : bx; }
    F.gw = F.vcu * 8 + F.wave; F.NGW = F.G * 8;
    volatile LAS unsigned* MISC = (volatile LAS unsigned*)(F.lds + MISC_OFF);
    for (int u = F.tid; u < (LDS_BYTES - RING_BYTES) / 4; u += 512) ((LAS unsigned*)(F.lds + RING_BYTES))[u] = 0u;
    __syncthreads();
    if (F.tid < 39) { const unsigned long long pv = (unsigned long long)args.in[F.tid]; LAS unsigned* t = (LAS unsigned*)(F.lds + INTAB_OFF) + 2 * F.tid; t[0] = (unsigned)pv; t[1] = (unsigned)(pv >> 32); }
    __syncthreads();
    unsigned* ctl = WSP(unsigned, WS_CTL);
    XcdBarrier bar; bar.bar = ctl + CW_BAR; bar.x = 0; bar.st = nullptr;
    if (ONE_LAUNCH) bar = xcd_barrier_post(ctl + CW_BAR, MISC + 8);
    int ph = 0; const int lo = args.ph_lo, hi = args.ph_hi;
    LAS unsigned char* ring = F.lds;
    const int c = F.vcu;

    PH_BEGIN
#if DBG_THRASH == 1
    dbg_thrash(F);
#endif
    prologue0(F); PH_END
    PH_BEGIN prologue1(F); PH_END

    layer_body<0>(F, args, bar, ph, lo, hi, ring, c, ctl);
    if (DBG_NLAYERS > 1) layer_body<1>(F, args, bar, ph, lo, hi, ring, c, ctl);
    if (DBG_NLAYERS > 2) layer_body<2>(F, args, bar, ph, lo, hi, ring, c, ctl);
    if (DBG_NLAYERS > 3) layer_body<3>(F, args, bar, ph, lo, hi, ring, c, ctl);
    for (int xb_ = 0; xb_ < DBG_XB; ++xb_) { PH_BEGIN PH_END }
    PH_BEGIN
#if DBG_THRASH == 2
    dbg_thrash(F); __syncthreads();
#endif
    final_out(F, DBG_NLAYERS - 1);
    if (ONE_LAUNCH && xb_ld(ctl + CW_BAR + XB_TMO) != 0u) {
        const float qn = __builtin_nanf(""); for (size_t i = (size_t)blockIdx.x * 512 + F.tid; i < (size_t)NL * D; i += (size_t)F.G * 512) F.out[i] = qn; }
    PH_END
}

static int count_phases() { int n = 2; for (int l = 0; l < DBG_NLAYERS; ++l) n += 9 + (((l & 1) && !DBG_NOMOE) ? 3 : 2); return n + 1 + DBG_XB; }
extern "C" void kernel_launch(void* const* d_in, const int* in_sizes, int n_in, void* d_out, int out_size, void* d_ws, size_t ws_size, hipStream_t stream) {
    static int grid = 0;
    if (grid == 0) {
        if (n_in != 39 || out_size != NL * D || ws_size < WS_END) { fprintf(stderr, "kernel_launch: unexpected shapes: n_in %d out %d ws %zu (need %zu)\n", n_in, out_size, ws_size, (size_t)WS_END); grid = -1; return; }
        int dev = 0, cus = 0, per_cu = 0;
        if (hipGetDevice(&dev) != hipSuccess || hipDeviceGetAttribute(&cus, hipDeviceAttributeMultiprocessorCount, dev) != hipSuccess) { grid = -1; return; }
        if (hipFuncSetAttribute((const void*)mega, hipFuncAttributeMaxDynamicSharedMemorySize, LDS_BYTES) != hipSuccess) { fprintf(stderr, "kernel_launch: hipFuncSetAttribute failed\n"); grid = -1; return; }
        if (hipOccupancyMaxActiveBlocksPerMultiprocessor(&per_cu, (const void*)mega, 512, LDS_BYTES) != hipSuccess || per_cu < 1) fprintf(stderr, "kernel_launch: occupancy query reports %d\n", per_cu);
        (void)hipGetLastError();
        grid = cus;
    }
    if (grid < 0) return;
    (void)hipMemsetAsync((char*)d_ws + WS_CTL, 0, CTL_BYTES, stream);
#ifdef DBG_MEMSET_LO
    (void)hipMemsetAsync((char*)d_ws + (size_t)DBG_MEMSET_LO * MiB, 0, (size_t)(DBG_MEMSET_HI - DBG_MEMSET_LO) * MiB, stream);
#endif
    Args a{};
    for (int i = 0; i < 39; ++i) a.in[i] = (const float*)d_in[i];
    a.out = (float*)d_out; a.ws = (unsigned char*)d_ws;
    const int nph = count_phases();
#if ONE_LAUNCH
    a.ph_lo = 0; a.ph_hi = nph;
    hipLaunchKernelGGL(mega, dim3(grid), dim3(512), LDS_BYTES, stream, a);
#else
    for (int p = 0; p < nph; ++p) { a.ph_lo = p; a.ph_hi = p + 1; hipLaunchKernelGGL(mega, dim3(grid), dim3(512), LDS_BYTES, stream, a); }
#endif
    const hipError_t le = hipPeekAtLastError();
    if (le != hipSuccess) fprintf(stderr, "kernel_launch: launch failed: %s\n", hipGetErrorName(le));
}
```
